# Optimizing an MI355X kernel written in HIP

```python
import jax, jax.numpy as jnp
from jax import lax
import numpy as np

D_MODEL = 1024
BATCH = 8
SEQ = 2048
DEPTH = 2
DEC_BATCH = 128
DEC_SEQ = 8
PAST_LEN = 8192
PAGE_SIZE = 128

N_MIXERS = 2
POOL_WINDOWS = (2, 4, 8, 16)
N_POOL_GROUPS = 4
POOL_GROUP_DIM = D_MODEL // N_POOL_GROUPS
POOL_PREFIX = max(POOL_WINDOWS) - 1
N_HEADS = 16
N_KV_HEADS = 4
HEAD_DIM = 64
GROUP = N_HEADS // N_KV_HEADS
WINDOW = 128
ROPE_THETA = 10000.0
D_FF = 2816
Q_DIM = N_HEADS * HEAD_DIM
KV_DIM = N_KV_HEADS * HEAD_DIM
QKV_DIM = Q_DIM + 2 * KV_DIM
RMS_EPS = 1e-6
NEG_INF = -1e30

kernel_name = "hybrid_pool_swa_sink_macaron_step"


def rmsnorm(x, g):
    xf = x.astype(jnp.float32)
    y = xf * lax.rsqrt(jnp.mean(xf * xf, axis=-1, keepdims=True) + RMS_EPS)
    return (y * g.astype(jnp.float32)).astype(x.dtype)


def half_ffn(x, g, w_in, w_out):
    h = rmsnorm(x, g) @ w_in
    gate, up = h[..., :D_FF], h[..., D_FF:]
    return x + 0.5 * ((jax.nn.silu(gate) * up) @ w_out)


def pool_mix(u, prefix, start_pos, w, scale):
    T = u.shape[1]
    P = POOL_PREFIX
    ext = jnp.concatenate([prefix.astype(u.dtype), u], axis=1)
    c = jnp.cumsum(ext.astype(jnp.float32), axis=1)
    c = jnp.pad(c, ((0, 0), (1, 0), (0, 0)))
    n_seen = start_pos + jnp.arange(T) + 1
    outs = []
    for gi, wg in enumerate(POOL_WINDOWS):
        sl = slice(gi * POOL_GROUP_DIM, (gi + 1) * POOL_GROUP_DIM)
        s = c[:, P + 1:P + T + 1, sl] - c[:, P + 1 - wg:P + T + 1 - wg, sl]
        cnt = jnp.minimum(n_seen, wg).astype(jnp.float32)[:, None]
        p = s / cnt - u[..., sl].astype(jnp.float32)
        outs.append(jnp.einsum("btc,cd->btd", p, w[gi].astype(jnp.float32)))
    y = jnp.concatenate(outs, axis=-1) * scale.astype(jnp.float32)
    return y.astype(u.dtype), ext[:, -P:]


def rope(x, pos):
    half = HEAD_DIM // 2
    inv = ROPE_THETA ** (-jnp.arange(half, dtype=jnp.float32) / half)
    ang = pos.astype(jnp.float32)[:, None] * inv[None, :]
    cos = jnp.cos(ang)[:, None, :]
    sin = jnp.sin(ang)[:, None, :]
    xf = x.astype(jnp.float32)
    x1, x2 = xf[..., :half], xf[..., half:]
    return jnp.concatenate([x1 * cos - x2 * sin, x2 * cos + x1 * sin], axis=-1).astype(x.dtype)


def project_qkv(u, pos, w_qkv, b_qkv):
    h = u @ w_qkv + b_qkv
    lead = u.shape[:-1]
    q = h[..., :Q_DIM].reshape(*lead, N_HEADS, HEAD_DIM)
    k = h[..., Q_DIM:Q_DIM + KV_DIM].reshape(*lead, N_KV_HEADS, HEAD_DIM)
    v = h[..., Q_DIM + KV_DIM:].reshape(*lead, N_KV_HEADS, HEAD_DIM)
    return rope(q, pos), rope(k, pos), v


def band_mask(qpos, kpos):
    d = qpos[..., :, None] - kpos[..., None, :]
    return (d >= 0) & (d < WINDOW) & (kpos[..., None, :] >= 0)


def attend_with_sinks(q, k, v, mask, sinks):
    s = jnp.einsum("...qhgd,...khd->...hgqk", q, k).astype(jnp.float32) * (HEAD_DIM ** -0.5)
    s = jnp.where(mask, s, NEG_INF)
    sink = sinks.astype(jnp.float32).reshape(N_KV_HEADS, GROUP, 1, 1)
    m = jnp.maximum(jnp.max(s, axis=-1, keepdims=True), sink)
    e = jnp.exp(s - m)
    p = e / (jnp.sum(e, axis=-1, keepdims=True) + jnp.exp(sink - m))
    return jnp.einsum("...hgqk,...khd->...qhgd", p.astype(v.dtype), v)


def swa_prompt(u, w_qkv, b_qkv, w_o, b_o, sinks):
    B, T, _ = u.shape
    nb = T // WINDOW
    pos = jnp.arange(T)
    q, k, v = project_qkv(u, pos, w_qkv, b_qkv)
    qb = q.reshape(B, nb, WINDOW, N_KV_HEADS, GROUP, HEAD_DIM)
    pad = jnp.zeros((B, WINDOW, N_KV_HEADS, HEAD_DIM), k.dtype)
    kb = jnp.concatenate([pad, k], axis=1).reshape(B, nb + 1, WINDOW, N_KV_HEADS, HEAD_DIM)
    vb = jnp.concatenate([pad, v], axis=1).reshape(B, nb + 1, WINDOW, N_KV_HEADS, HEAD_DIM)
    kband = jnp.concatenate([kb[:, :-1], kb[:, 1:]], axis=2)
    vband = jnp.concatenate([vb[:, :-1], vb[:, 1:]], axis=2)
    qpos = pos.reshape(nb, WINDOW)
    kpos = jnp.arange(nb)[:, None] * WINDOW - WINDOW + jnp.arange(2 * WINDOW)[None, :]
    mask = band_mask(qpos, kpos)[None, :, None, None]
    o = attend_with_sinks(qb, kband, vband, mask, sinks).reshape(B, T, Q_DIM)
    return o @ w_o + b_o, k[:, -WINDOW:], v[:, -WINDOW:]


def swa_sample(u, k_buf, v_buf, w_qkv, b_qkv, w_o, b_o, sinks):
    B, T, _ = u.shape
    pos = PAST_LEN + jnp.arange(T)
    q, k, v = project_qkv(u, pos, w_qkv, b_qkv)
    kk = jnp.concatenate([k_buf.astype(k.dtype), k], axis=1)
    vv = jnp.concatenate([v_buf.astype(v.dtype), v], axis=1)
    kpos = PAST_LEN - WINDOW + jnp.arange(WINDOW + T)
    mask = band_mask(pos, kpos)[None, None, None]
    qg = q.reshape(B, T, N_KV_HEADS, GROUP, HEAD_DIM)
    o = attend_with_sinks(qg, kk, vv, mask, sinks).reshape(B, T, Q_DIM)
    return o @ w_o + b_o, kk[:, -WINDOW:], vv[:, -WINDOW:]


def setup_inputs(seed: int = 0) -> dict:
    key = jax.random.key(seed)
    ks = jax.random.split(key, 24)
    f32 = jnp.float32
    n_pool = (DEPTH + 1) // 2
    n_attn = DEPTH // 2
    nrm = lambda k, s: jax.random.normal(k, s, f32)
    return {
        "x_prompt": nrm(ks[0], (BATCH, SEQ, D_MODEL)),
        "x_sample": nrm(ks[1], (DEC_BATCH, DEC_SEQ, D_MODEL)),
        "state_pool": nrm(ks[2], (n_pool, DEC_BATCH, POOL_PREFIX, D_MODEL)),
        "cache_k": nrm(ks[3], (n_attn, DEC_BATCH, WINDOW, N_KV_HEADS, HEAD_DIM)),
        "cache_v": nrm(ks[4], (n_attn, DEC_BATCH, WINDOW, N_KV_HEADS, HEAD_DIM)),
        "norm_ffn1": 1.0 + 0.05 * nrm(ks[5], (DEPTH, D_MODEL)),
        "ffn1_w_in": nrm(ks[6], (DEPTH, D_MODEL, 2 * D_FF)) * D_MODEL ** -0.5,
        "ffn1_w_out": nrm(ks[7], (DEPTH, D_FF, D_MODEL)) * D_FF ** -0.5,
        "norm_mix": 1.0 + 0.05 * nrm(ks[8], (DEPTH, D_MODEL)),
        "norm_ffn2": 1.0 + 0.05 * nrm(ks[9], (DEPTH, D_MODEL)),
        "ffn2_w_in": nrm(ks[10], (DEPTH, D_MODEL, 2 * D_FF)) * D_MODEL ** -0.5,
        "ffn2_w_out": nrm(ks[11], (DEPTH, D_FF, D_MODEL)) * D_FF ** -0.5,
        "pool_w": nrm(ks[12], (n_pool, N_POOL_GROUPS, POOL_GROUP_DIM, POOL_GROUP_DIM)) * POOL_GROUP_DIM ** -0.5,
        "pool_scale": 1.0 + 0.05 * nrm(ks[13], (n_pool, D_MODEL)),
        "attn_w_qkv": nrm(ks[14], (n_attn, D_MODEL, QKV_DIM)) * D_MODEL ** -0.5,
        "attn_b_qkv": 0.02 * nrm(ks[15], (n_attn, QKV_DIM)),
        "attn_w_o": nrm(ks[16], (n_attn, Q_DIM, D_MODEL)) * Q_DIM ** -0.5,
        "attn_b_o": 0.02 * nrm(ks[17], (n_attn, D_MODEL)),
        "attn_sinks": nrm(ks[18], (n_attn, N_HEADS)),
        "norm_final": 1.0 + 0.05 * nrm(ks[19], (D_MODEL,)),
    }


def reference(x_prompt, x_sample, state_pool, cache_k, cache_v,
              norm_ffn1, ffn1_w_in, ffn1_w_out, norm_mix, norm_ffn2, ffn2_w_in, ffn2_w_out,
              pool_w, pool_scale, attn_w_qkv, attn_b_qkv, attn_w_o, attn_b_o, attn_sinks,
              norm_final):
    xp, xs = x_prompt, x_sample
    pool_p, pool_s, kp_l, vp_l, ks_l, vs_l = [], [], [], [], [], []
    for i in range(DEPTH):
        xp = half_ffn(xp, norm_ffn1[i], ffn1_w_in[i], ffn1_w_out[i])
        xs = half_ffn(xs, norm_ffn1[i], ffn1_w_in[i], ffn1_w_out[i])
        up = rmsnorm(xp, norm_mix[i])
        us = rmsnorm(xs, norm_mix[i])
        j = i // N_MIXERS
        if i % N_MIXERS == 0:
            zeros = jnp.zeros((up.shape[0], POOL_PREFIX, D_MODEL), up.dtype)
            yp, sp = pool_mix(up, zeros, 0, pool_w[j], pool_scale[j])
            ys, ss = pool_mix(us, state_pool[j], PAST_LEN, pool_w[j], pool_scale[j])
            pool_p.append(sp)
            pool_s.append(ss)
        else:
            yp, kp, vp = swa_prompt(up, attn_w_qkv[j], attn_b_qkv[j], attn_w_o[j], attn_b_o[j], attn_sinks[j])
            ys, kn, vn = swa_sample(us, cache_k[j], cache_v[j], attn_w_qkv[j], attn_b_qkv[j],
                                    attn_w_o[j], attn_b_o[j], attn_sinks[j])
            kp_l.append(kp)
            vp_l.append(vp)
            ks_l.append(kn)
            vs_l.append(vn)
        xp = xp + yp
        xs = xs + ys
        xp = half_ffn(xp, norm_ffn2[i], ffn2_w_in[i], ffn2_w_out[i])
        xs = half_ffn(xs, norm_ffn2[i], ffn2_w_in[i], ffn2_w_out[i])
    y_prompt = rmsnorm(xp, norm_final)
    y_sample = rmsnorm(xs, norm_final)
    new_pool_prompt = jnp.stack(pool_p)
    new_pool_sample = jnp.stack(pool_s)
    new_k_prompt = jnp.stack(kp_l)
    new_v_prompt = jnp.stack(vp_l)
    new_k_sample = jnp.stack(ks_l)
    new_v_sample = jnp.stack(vs_l)
    return (y_prompt, y_sample, new_pool_prompt, new_pool_sample,
            new_k_prompt, new_v_prompt, new_k_sample, new_v_sample)
```

```cpp
#include <hip/hip_runtime.h>
#include <cstdio>
#include <cstdint>

#ifndef PHMASK
#define PHMASK 127
#endif
#ifndef MK_ONE_LAUNCH
#define MK_ONE_LAUNCH 0
#endif

constexpr int DM = 1024, DFF = 2816, NPB = 8, TPS = 2048, MP = NPB * TPS, NSB = 128, TSS = 8, MS = NSB * TSS, MT = MP + MS;
constexpr int QKVN = 1536, NHEAD = 16, NKV = 4, HD = 64, KVD = 256;
constexpr int PAST = 8192;
constexpr float RMS_EPS = 1e-6f;
constexpr float LOG2E = 1.4426950408889634f;
constexpr float QSCALE = 0.125f * LOG2E;
constexpr size_t O_Y = 0;
constexpr size_t O_POOLP = (size_t)MT * DM;
constexpr size_t O_POOLS = O_POOLP + (size_t)NPB * 15 * DM;
constexpr size_t O_KP = O_POOLS + (size_t)NSB * 15 * DM;
constexpr size_t O_VP = O_KP + (size_t)NPB * 128 * KVD;
constexpr size_t O_KS = O_VP + (size_t)NPB * 128 * KVD;
constexpr size_t O_VS = O_KS + (size_t)NSB * 128 * KVD;
constexpr size_t O_END = O_VS + (size_t)NSB * 128 * KVD;

namespace pg8 {
#define PG8_LAS __attribute__((address_space(3)))
typedef unsigned short bf16_t;
typedef short bf16x8 __attribute__((ext_vector_type(8)));
typedef float f32x4 __attribute__((ext_vector_type(4)));
typedef float f32x2 __attribute__((ext_vector_type(2)));
typedef unsigned u32x4 __attribute__((ext_vector_type(4)));
typedef unsigned u32x2 __attribute__((ext_vector_type(2)));
constexpr int BM = 256, BK = 64, HALF = 128, HTB = HALF * BK * 2, STAGE_BYTES = 8 * HTB, NXCD = 8, WGM = 8;

__host__ __device__ __forceinline__ int lds_byte(int r, int c) { const int st = (r >> 4) * 2 + (c >> 5), rr = r & 15, cc = c & 31, ob = rr * 64 + cc * 2; return st * 1024 + (ob ^ (((ob >> 9) & 1) << 5)); }
__host__ __device__ __forceinline__ void stage_rc(int b, int& R, int& C) { const int st = b / 1024, sb = b % 1024, swz = sb ^ (((sb >> 9) & 1) << 5); R = (st >> 1) * 16 + swz / 64; C = (st & 1) * 32 + (swz % 64) / 2; }
__host__ __device__ __forceinline__ int perm32(int rho) { const int n = rho >> 4, i = rho & 15; return 8 * (i >> 2) + 4 * n + (i & 3); }

struct Unit { int pm, pn; };
struct Gemm { const bf16_t* A; const bf16_t* Bt; int M, N, K, lda, ldb, a_pn_cols; };

struct StaticOrder {
    int nM, nN, nwg, G, c;
    __host__ __device__ void init(int M, int N, int G_, int c_) { nM = M / BM; nN = N / BM; nwg = nM * nN; G = G_; c = c_; }
    __host__ __device__ bool next(int i, Unit& u) const {
        const long L = (long)i * G + c; if (L >= nwg) return false;
        int wgid = (int)L; { const int q = nwg / NXCD, r = nwg % NXCD, xcd = wgid % NXCD, off = wgid / NXCD; wgid = (xcd < r ? xcd * (q + 1) : r * (q + 1) + (xcd - r) * q) + off; }
        const int nig = WGM * nN, gid = wgid / nig, fm = gid * WGM, gsz = (nM - fm) < WGM ? (nM - fm) : WGM;
        u.pm = fm + ((wgid % nig) % gsz); u.pn = (wgid % nig) / gsz; return true;
    }
    __device__ __forceinline__ void a_ready(const Unit&) const {}
    __device__ __forceinline__ void done(const Unit&) const {}
};

__device__ __forceinline__ unsigned cvt_pk_bf16(float lo, float hi) { unsigned r; asm volatile("v_cvt_pk_bf16_f32 %0, %1, %2" : "=v"(r) : "v"(lo), "v"(hi)); return r; }

__device__ __forceinline__ float row_rstd(const float* ssq, int row) {
    const f32x4* p = (const f32x4*)(ssq + (size_t)row * 16);
    const f32x4 a = p[0], b = p[1], c = p[2], d = p[3];
    const float s = (((a[0] + a[1]) + (a[2] + a[3])) + ((b[0] + b[1]) + (b[2] + b[3]))) + (((c[0] + c[1]) + (c[2] + c[3])) + ((d[0] + d[1]) + (d[2] + d[3])));
    return 1.0f / sqrtf(s * (1.0f / DM) + RMS_EPS);
}

struct EpiSwiglu {
    static constexpr bool PERM = true, AFTER_DRAIN = false;
    bf16_t* H; const float* ssq;
    __device__ __forceinline__ void operator()(const f32x4 (&acc)[2][2][4][2], const Unit& u, int wr, int wc, int fr, int fq) const {
        const int row0 = u.pm * BM + wr * 64 + fr, col0 = u.pn * HALF + wc * 32 + 8 * fq;
#pragma unroll
        for (int ai = 0; ai < 2; ++ai)
#pragma unroll
            for (int m = 0; m < 4; ++m) {
                const int row = row0 + ai * HALF + m * 16;
                const float rs = row_rstd(ssq, row);
                unsigned w[4];
#pragma unroll
                for (int n = 0; n < 2; ++n) {
                    float o[4];
#pragma unroll
                    for (int i = 0; i < 4; ++i) { const float g = acc[ai][0][m][n][i] * rs, up = acc[ai][1][m][n][i] * rs;
                        const float e = __builtin_amdgcn_exp2f(-g * LOG2E); o[i] = g * __builtin_amdgcn_rcpf(1.0f + e) * up; }
                    w[2 * n] = cvt_pk_bf16(o[0], o[1]); w[2 * n + 1] = cvt_pk_bf16(o[2], o[3]);
                }
                *(u32x4*)(H + (size_t)row * DFF + col0) = (u32x4){w[0], w[1], w[2], w[3]};
                if (m & 1) asm volatile("" ::: "memory");
            }
    }
};
struct EpiRes {
    static constexpr bool PERM = false, AFTER_DRAIN = false;
    const float* xold_lo; const float* xold_hi; float* xnew; bf16_t* xb; float* ssq; const float* bias;
    __device__ __forceinline__ void operator()(const f32x4 (&acc)[2][2][4][2], const Unit& u, int wr, int wc, int fr, int fq) const {
        const int row0 = u.pm * BM + wr * 64 + fr, col0 = u.pn * BM + wc * 32 + 4 * fq;
        f32x4 bv[2][2];
#pragma unroll
        for (int bj = 0; bj < 2; ++bj)
#pragma unroll
            for (int n = 0; n < 2; ++n) bv[bj][n] = bias ? *(const f32x4*)(bias + col0 + bj * HALF + n * 16) : (f32x4){0.f, 0.f, 0.f, 0.f};
#pragma unroll
        for (int ai = 0; ai < 2; ++ai)
#pragma unroll
            for (int m = 0; m < 4; ++m) {
                const int row = row0 + ai * HALF + m * 16;
                const float* xo = (row < MP) ? xold_lo + (size_t)row * DM + col0 : xold_hi + (size_t)(row - MP) * DM + col0;
                float* xn = xnew + (size_t)row * DM + col0; bf16_t* xbp = xb + (size_t)row * DM + col0;
                float s = 0.f;
#pragma unroll
                for (int bj = 0; bj < 2; ++bj)
#pragma unroll
                    for (int n = 0; n < 2; ++n) {
                        const f32x4 v = *(const f32x4*)(xo + bj * HALF + n * 16) + acc[ai][bj][m][n] + bv[bj][n];
                        *(f32x4*)(xn + bj * HALF + n * 16) = v;
                        *(u32x2*)(xbp + bj * HALF + n * 16) = (u32x2){cvt_pk_bf16(v[0], v[1]), cvt_pk_bf16(v[2], v[3])};
                        s += (v[0] * v[0] + v[1] * v[1]) + (v[2] * v[2] + v[3] * v[3]);
                    }
                s += __shfl_xor(s, 16); s += __shfl_xor(s, 32);
                if (fq == 0) ssq[(size_t)row * 16 + u.pn * 4 + wc] = s;
                asm volatile("" ::: "memory");
            }
    }
};
struct EpiQKV {
    static constexpr bool PERM = true, AFTER_DRAIN = false;
    bf16_t* Q; bf16_t* K; bf16_t* V; const float* ssq; const float* bias; const float* rope; float* out;
    __device__ __forceinline__ void operator()(const f32x4 (&acc)[2][2][4][2], const Unit& u, int wr, int wc, int fr, int fq) const {
        const int row0 = u.pm * BM + wr * 64 + fr, pn = u.pn, dd0 = 8 * fq, nat0 = pn * 256 + wc * 64 + dd0;
        f32x4 bv[2][2];
#pragma unroll
        for (int bj = 0; bj < 2; ++bj)
#pragma unroll
            for (int n = 0; n < 2; ++n) bv[bj][n] = *(const f32x4*)(bias + nat0 + bj * 32 + 4 * n);
#pragma unroll
        for (int ai = 0; ai < 2; ++ai)
#pragma unroll
            for (int m = 0; m < 4; ++m) {
                const int row = row0 + ai * HALF + m * 16;
                const float rs = row_rstd(ssq, row);
                f32x4 v[2][2];
#pragma unroll
                for (int bj = 0; bj < 2; ++bj)
#pragma unroll
                    for (int n = 0; n < 2; ++n) v[bj][n] = acc[ai][bj][m][n] * rs + bv[bj][n];
                if (pn < 5) {
                    const int pidx = (row < MP) ? (row & (TPS - 1)) : TPS + ((row - MP) & (TSS - 1));
                    const f32x4* rp = (const f32x4*)(rope + ((size_t)pidx * 32 + dd0) * 2);
#pragma unroll
                    for (int n = 0; n < 2; ++n) {
                        const f32x4 cs0 = rp[2 * n], cs1 = rp[2 * n + 1];
                        const float c[4] = {cs0[0], cs0[2], cs1[0], cs1[2]}, s[4] = {cs0[1], cs0[3], cs1[1], cs1[3]};
                        const f32x4 x1 = v[0][n], x2 = v[1][n];
#pragma unroll
                        for (int i = 0; i < 4; ++i) { v[0][n][i] = x1[i] * c[i] - x2[i] * s[i]; v[1][n][i] = x2[i] * c[i] + x1[i] * s[i]; }
                    }
                }
                if (pn < 4) {
#pragma unroll
                    for (int bj = 0; bj < 2; ++bj) { const f32x4 a = v[bj][0] * QSCALE, b = v[bj][1] * QSCALE;
                        *(u32x4*)(Q + (size_t)row * DM + nat0 + bj * 32) = (u32x4){cvt_pk_bf16(a[0], a[1]), cvt_pk_bf16(a[2], a[3]), cvt_pk_bf16(b[0], b[1]), cvt_pk_bf16(b[2], b[3])}; }
                } else {
                    bf16_t* kv = (pn == 4) ? K : V;
                    const int c0 = wc * 64 + dd0;
#pragma unroll
                    for (int bj = 0; bj < 2; ++bj) { const f32x4 a = v[bj][0], b = v[bj][1];
                        *(u32x4*)(kv + (size_t)row * KVD + c0 + bj * 32) = (u32x4){cvt_pk_bf16(a[0], a[1]), cvt_pk_bf16(a[2], a[3]), cvt_pk_bf16(b[0], b[1]), cvt_pk_bf16(b[2], b[3])}; }
                    float* dst = nullptr;
                    if (row < MP) { const int t = row & (TPS - 1); if (t >= TPS - 128) dst = out + ((pn == 4) ? O_KP : O_VP) + ((size_t)(row >> 11) * 128 + (t - (TPS - 128))) * KVD + c0; }
                    else { const int r = row - MP; dst = out + ((pn == 4) ? O_KS : O_VS) + ((size_t)(r >> 3) * 128 + 120 + (r & 7)) * KVD + c0; }
                    if (dst) {
#pragma unroll
                        for (int bj = 0; bj < 2; ++bj)
#pragma unroll
                            for (int n = 0; n < 2; ++n) *(f32x4*)(dst + bj * 32 + 4 * n) = v[bj][n];
                    }
                }
                asm volatile("" ::: "memory");
            }
    }
};

template <class Epi, class Sched, bool ALIGN_EPI = false, bool SP2 = false>
__device__ __forceinline__ void gemm_phase(PG8_LAS unsigned char* lds, const Gemm g, const Sched& S, const Epi& E, const int tid) {
    const int wid = __builtin_amdgcn_readfirstlane(tid >> 6), lane = tid & 63, wr = wid >> 2, wc = wid & 3, fr = lane & 15, fq = lane >> 4;
    const int K = g.K, nt = K / BK;
    unsigned voffA[2], voffB[2];
#pragma unroll
    for (int i = 0; i < 2; ++i) { int R, C; stage_rc(tid * 16 + i * 8192, R, C); const int Rb = Epi::PERM ? ((R & ~31) + perm32(R & 31)) : R;
        voffA[i] = (unsigned)(R * g.lda + C) * 2u; voffB[i] = (unsigned)(Rb * g.ldb + C) * 2u; }
    const size_t kstep = (size_t)(BK * 2);
    const size_t hstepA = (size_t)HALF * g.lda * 2, hstepB = (size_t)HALF * g.ldb * 2;
    const size_t tstepA = 2 * hstepA, tstepB = 2 * hstepB;
    const size_t pnA = (size_t)g.a_pn_cols * 2;
    const unsigned ldsw = (unsigned)wid * 1024u;
    const int aoff = lds_byte(wr * 64 + fr, fq * 8), boff = lds_byte(wc * 32 + fr, fq * 8);
#define PG8_SA(b, h) (((b) * 2 + (h)) * HTB)
#define PG8_SB(b, h) ((4 + (b) * 2 + (h)) * HTB)
#define PG8_STAGE(bufoff, gbase, voff) do { _Pragma("unroll") for (int _i = 0; _i < 2; ++_i) \
        __builtin_amdgcn_global_load_lds((const unsigned*)((const char*)(gbase) + (voff)[_i]), (PG8_LAS unsigned*)(lds + (bufoff) + ldsw + _i * 8192), 16, 0, 0); } while (0)
#define PG8_LDA(dst, b, h) do { _Pragma("unroll") for (int m = 0; m < 4; ++m) _Pragma("unroll") for (int k = 0; k < 2; ++k) dst[m][k] = *(const PG8_LAS bf16x8*)(lds + PG8_SA(b, h) + aoff + m * 2048 + k * 1024); } while (0)
#define PG8_LDB(dst, b, h) do { _Pragma("unroll") for (int n = 0; n < 2; ++n) _Pragma("unroll") for (int k = 0; k < 2; ++k) dst[n][k] = *(const PG8_LAS bf16x8*)(lds + PG8_SB(b, h) + boff + n * 2048 + k * 1024); } while (0)
#define PG8_MMA(ai, bj, At, Bt) do { __builtin_amdgcn_s_setprio(1); _Pragma("unroll") for (int m = 0; m < 4; ++m) _Pragma("unroll") for (int n = 0; n < 2; ++n) _Pragma("unroll") for (int k = 0; k < 2; ++k) \
        acc[ai][bj][m][n] = __builtin_amdgcn_mfma_f32_16x16x32_bf16(Bt[n][k], At[m][k], acc[ai][bj][m][n], 0, 0, 0); __builtin_amdgcn_s_setprio(0); } while (0)
#define PG8_WAIT_V(n) asm volatile("s_waitcnt vmcnt(" #n ")" ::: "memory")
#define PG8_WAIT_L(n) asm volatile("s_waitcnt lgkmcnt(" #n ")" ::: "memory")
#define PG8_BAR __builtin_amdgcn_s_barrier()
#define PG8_SCHED __builtin_amdgcn_sched_barrier(0)
    Unit cur, nxt; int ui = 0;
    if (!S.next(0, cur)) return;
    f32x4 acc[2][2][4][2];
#pragma unroll
    for (int a = 0; a < 2; ++a)
#pragma unroll
        for (int b = 0; b < 2; ++b)
#pragma unroll
            for (int m = 0; m < 4; ++m)
#pragma unroll
                for (int n = 0; n < 2; ++n) acc[a][b][m][n] = (f32x4){0.f, 0.f, 0.f, 0.f};
    bf16x8 At[4][2], B0[2][2], B1[2][2];
    const char* cA = (const char*)g.A + (size_t)cur.pm * tstepA + (size_t)cur.pn * pnA; const char* cB = (const char*)g.Bt + (size_t)cur.pn * tstepB;
    S.a_ready(cur);
    if constexpr (SP2) {
        PG8_STAGE(PG8_SB(0, 0), cB, voffB); PG8_STAGE(PG8_SB(0, 1), cB + hstepB, voffB); PG8_STAGE(PG8_SA(0, 0), cA, voffA); PG8_STAGE(PG8_SA(0, 1), cA + hstepA, voffA);
        if (wr == 1) PG8_BAR;
        PG8_WAIT_V(2); PG8_BAR;
        PG8_STAGE(PG8_SB(1, 0), cB + kstep, voffB); PG8_STAGE(PG8_SA(1, 0), cA + kstep, voffA); PG8_STAGE(PG8_SB(1, 1), cB + hstepB + kstep, voffB);
        PG8_WAIT_V(6); PG8_BAR;
    } else {
        PG8_STAGE(PG8_SB(0, 0), cB, voffB); PG8_STAGE(PG8_SA(0, 0), cA, voffA); PG8_STAGE(PG8_SB(0, 1), cB + hstepB, voffB); PG8_STAGE(PG8_SA(0, 1), cA + hstepA, voffA);
        if (wr == 1) PG8_BAR;
        PG8_WAIT_V(4); PG8_BAR;
        PG8_STAGE(PG8_SB(1, 0), cB + kstep, voffB); PG8_STAGE(PG8_SA(1, 0), cA + kstep, voffA); PG8_STAGE(PG8_SB(1, 1), cB + hstepB + kstep, voffB);
        PG8_WAIT_V(6); PG8_BAR;
    }
    for (;;) {
        const bool has_next = S.next(ui + 1, nxt);
        const char* nA = has_next ? (const char*)g.A + (size_t)nxt.pm * tstepA + (size_t)nxt.pn * pnA : cA; const char* nB = has_next ? (const char*)g.Bt + (size_t)nxt.pn * tstepB : cB;
        for (int t = 0; t < nt; t += 2) {
            const bool last = (t == nt - 2);
            const char* a1 = cA + (size_t)(t + 1) * kstep;
            const char* a2 = last ? nA : cA + (size_t)(t + 2) * kstep; const char* b2 = last ? nB : cB + (size_t)(t + 2) * kstep;
            const char* a3 = a2 + kstep; const char* b3 = b2 + kstep;
            if (last && has_next) S.a_ready(nxt);
            if constexpr (SP2) {
            PG8_LDB(B0, 0, 0); PG8_LDB(B1, 0, 1); PG8_SCHED; PG8_LDA(At, 0, 0); PG8_STAGE(PG8_SA(1, 1), a1 + hstepA, voffA);
            PG8_WAIT_V(8); PG8_WAIT_L(0); PG8_BAR; PG8_MMA(0, 0, At, B0); PG8_MMA(0, 1, At, B1); PG8_BAR; PG8_SCHED;
            PG8_LDA(At, 0, 1); PG8_STAGE(PG8_SB(0, 0), b2, voffB); PG8_STAGE(PG8_SB(0, 1), b2 + hstepB, voffB); PG8_STAGE(PG8_SA(0, 0), a2, voffA);
            PG8_WAIT_V(8); PG8_WAIT_L(0); PG8_BAR; PG8_MMA(1, 0, At, B0); PG8_MMA(1, 1, At, B1); PG8_BAR; PG8_SCHED;
            PG8_LDB(B0, 1, 0); PG8_LDB(B1, 1, 1); PG8_SCHED; PG8_LDA(At, 1, 0); PG8_STAGE(PG8_SA(0, 1), a2 + hstepA, voffA);
            PG8_WAIT_V(8); PG8_WAIT_L(0); PG8_BAR; PG8_MMA(0, 0, At, B0); PG8_MMA(0, 1, At, B1); PG8_BAR; PG8_SCHED;
            PG8_LDA(At, 1, 1); PG8_STAGE(PG8_SB(1, 0), b3, voffB); PG8_STAGE(PG8_SB(1, 1), b3 + hstepB, voffB); PG8_STAGE(PG8_SA(1, 0), a3, voffA);
            PG8_WAIT_V(8); PG8_WAIT_L(0); PG8_BAR; PG8_MMA(1, 0, At, B0); PG8_MMA(1, 1, At, B1); PG8_BAR; PG8_SCHED;
            } else {
            PG8_LDB(B0, 0, 0); PG8_SCHED; PG8_LDA(At, 0, 0); PG8_STAGE(PG8_SA(1, 1), a1 + hstepA, voffA);
            PG8_WAIT_L(8); PG8_BAR; PG8_WAIT_L(0); PG8_MMA(0, 0, At, B0); PG8_BAR; PG8_SCHED;
            PG8_LDB(B1, 0, 1); PG8_STAGE(PG8_SB(0, 0), b2, voffB);
            PG8_BAR; PG8_WAIT_L(0); PG8_MMA(0, 1, At, B1); PG8_BAR;
            PG8_LDA(At, 0, 1); PG8_STAGE(PG8_SA(0, 0), a2, voffA);
            PG8_BAR; PG8_WAIT_L(0); PG8_MMA(1, 0, At, B0); PG8_BAR; PG8_SCHED;
            PG8_STAGE(PG8_SB(0, 1), b2 + hstepB, voffB);
            PG8_WAIT_V(6); PG8_BAR; PG8_MMA(1, 1, At, B1); PG8_BAR;
            PG8_LDB(B0, 1, 0); PG8_SCHED; PG8_LDA(At, 1, 0); PG8_STAGE(PG8_SA(0, 1), a2 + hstepA, voffA);
            PG8_WAIT_L(8); PG8_BAR; PG8_WAIT_L(0); PG8_MMA(0, 0, At, B0); PG8_BAR; PG8_SCHED;
            PG8_LDB(B1, 1, 1); PG8_STAGE(PG8_SB(1, 0), b3, voffB);
            PG8_BAR; PG8_WAIT_L(0); PG8_MMA(0, 1, At, B1); PG8_BAR;
            PG8_LDA(At, 1, 1); PG8_STAGE(PG8_SA(1, 0), a3, voffA);
            PG8_BAR; PG8_WAIT_L(0); PG8_MMA(1, 0, At, B0); PG8_BAR; PG8_SCHED;
            PG8_STAGE(PG8_SB(1, 1), b3 + hstepB, voffB);
            PG8_WAIT_V(6); PG8_BAR; PG8_MMA(1, 1, At, B1); PG8_BAR;
            }
        }
        if constexpr (ALIGN_EPI) { if (wr == 0) PG8_BAR; }
        if constexpr (!Epi::AFTER_DRAIN) { int le = lane; asm volatile("" : "+v"(le)); E(acc, cur, wr, wc, le & 15, le >> 4); S.done(cur); }
        if (!has_next) break;
#pragma unroll
        for (int a = 0; a < 2; ++a)
#pragma unroll
            for (int b = 0; b < 2; ++b)
#pragma unroll
                for (int m = 0; m < 4; ++m)
#pragma unroll
                    for (int n = 0; n < 2; ++n) acc[a][b][m][n] = (f32x4){0.f, 0.f, 0.f, 0.f};
        cur = nxt; cA = nA; cB = nB; ++ui;
        if constexpr (ALIGN_EPI) { if (wr == 1) PG8_BAR; }
    }
    PG8_WAIT_V(0);
    if constexpr (!ALIGN_EPI) { if (wr == 0) PG8_BAR; }
    PG8_BAR;
#undef PG8_SA
#undef PG8_SB
#undef PG8_STAGE
#undef PG8_LDA
#undef PG8_LDB
#undef PG8_MMA
#undef PG8_WAIT_V
#undef PG8_WAIT_L
#undef PG8_BAR
#undef PG8_SCHED
}
}

#define GAS __attribute__((address_space(1)))
#define LAS __attribute__((address_space(3)))
typedef unsigned short bf16;
typedef unsigned v4u __attribute__((ext_vector_type(4)));
typedef unsigned v2u __attribute__((ext_vector_type(2)));
typedef float f32x4 __attribute__((ext_vector_type(4)));
typedef float f32x2 __attribute__((ext_vector_type(2)));
typedef float f32x16 __attribute__((ext_vector_type(16)));
typedef short bf16x8 __attribute__((ext_vector_type(8)));
typedef short s16x4 __attribute__((ext_vector_type(4)));
typedef GAS unsigned gu32;
#define RLX_AGENT __ATOMIC_RELAXED, __HIP_MEMORY_SCOPE_AGENT
#define LDS_WAIT() asm volatile("s_waitcnt lgkmcnt(0)" ::: "memory")
#define VM_WAIT() asm volatile("s_waitcnt vmcnt(0)" ::: "memory")
__device__ __forceinline__ unsigned f2bf(float f) { unsigned u = __builtin_bit_cast(unsigned, f); return (u + 0x7fffu + ((u >> 16) & 1u)) >> 16; }
__device__ __forceinline__ unsigned pk2(float lo, float hi) { return f2bf(lo) | (f2bf(hi) << 16); }
__device__ __forceinline__ float bf2f(unsigned short b) { return __builtin_bit_cast(float, (unsigned)b << 16); }

constexpr int NWAVES = 8;
constexpr size_t MiB = 1u << 20;
constexpr size_t WS_CTL = 0, CTL_ZERO_BYTES = 64 * 1024;
constexpr size_t WS_ROPE = 1 * MiB;
constexpr size_t WS_SSQ = 2 * MiB;
constexpr size_t WS_WQKV = 4 * MiB, WS_WO = 7 * MiB, WS_WPOOL = 9 * MiB;
constexpr size_t WS_W1 = 10 * MiB, W1_BYTES = (size_t)2 * DFF * DM * 2;
constexpr size_t WS_W2 = 54 * MiB, W2_BYTES = (size_t)DM * DFF * 2;
constexpr size_t WS_XB = 76 * MiB;
constexpr size_t WS_H = 110 * MiB;
constexpr size_t WS_P = WS_H, WS_Q = WS_H, WS_O = WS_H + 34 * MiB, WS_K = WS_H + 68 * MiB, WS_V = WS_H + 77 * MiB;
constexpr size_t WS_END = 204 * MiB;
static_assert(WS_W1 + 4 * W1_BYTES <= WS_W2 && WS_W2 + 4 * W2_BYTES <= WS_XB && WS_XB + (size_t)MT * DM * 2 <= WS_H && WS_H + (size_t)MT * DFF * 2 <= WS_END, "ws map");
static_assert(WS_V + (size_t)MT * KVD * 2 <= WS_END && WS_K + (size_t)MT * KVD * 2 <= WS_V && WS_O + (size_t)MT * DM * 2 <= WS_K, "ws map 2");
constexpr int CW_BAR = 4096;
constexpr int RING_OFF = 0, RING_BYTES = 131072;
constexpr int LDSCTL_OFF = RING_BYTES, MISC_OFF = LDSCTL_OFF + 320;
constexpr int LDS_BYTES = 147456;

#define XB_TMO      128
#define XB_XCNT(j)  (256  + 64 * (j))
#define XB_XSUB(j)  (1280 + 64 * (j))
#define XB_XGEN(j)  (2304 + 64 * (j))
#define XB_TOP      3328
#define XB_TOPGEN   3392
#define XCD_BAR_WORDS 3456
#define XB_SPIN_CAP (1u << 18)
__device__ __forceinline__ unsigned xb_ld(unsigned* p)              { return __hip_atomic_load(p, __ATOMIC_RELAXED, __HIP_MEMORY_SCOPE_AGENT); }
__device__ __forceinline__ unsigned xb_add(unsigned* p, unsigned v) { return __hip_atomic_fetch_add(p, v, __ATOMIC_RELAXED, __HIP_MEMORY_SCOPE_AGENT); }
__device__ __forceinline__ unsigned xb_xcc_id() { return (unsigned)__builtin_amdgcn_s_getreg((3 << 11) | 20) & 0xFu; }
#define XB_SPIN(cond, bar) do { unsigned _sp = 0; while (cond) { __builtin_amdgcn_s_sleep(1); \
    if ((++_sp & 255u) == 0u) { if (xb_ld(&(bar)[XB_TMO])) break; if (_sp > XB_SPIN_CAP) { atomicAdd(&(bar)[XB_TMO], 1u); break; } } } } while (0)
struct XcdBarrier { unsigned* bar; unsigned x; volatile LAS unsigned* st; };
__device__ __forceinline__ XcdBarrier xcd_barrier_post(unsigned* bar, volatile LAS unsigned* st) {
    XcdBarrier b; b.bar = bar; b.x = xb_xcc_id(); b.st = st;
    if (threadIdx.x == 0) (void)xb_add(&bar[XB_XCNT(b.x)], 1u);
    return b;
}
__device__ __forceinline__ void xcd_barrier_complete(unsigned* bar, unsigned x, unsigned& nloc, unsigned& nx) {
    const unsigned G = gridDim.x * gridDim.y * gridDim.z;
    unsigned sum, cnt, mine, sp = 0u;
    for (;;) {
        sum = 0u; cnt = 0u; mine = 0u;
#pragma unroll
        for (unsigned j = 0; j < 16; ++j) { const unsigned c = xb_ld(&bar[XB_XCNT(j)]); sum += c; cnt += (c > 0u) ? 1u : 0u; mine = (j == x) ? c : mine; }
        if (sum == G) break;
        __builtin_amdgcn_s_sleep(1);
        if ((++sp & 255u) == 0u) { if (xb_ld(&bar[XB_TMO])) break; if (sp > XB_SPIN_CAP) { atomicAdd(&bar[XB_TMO], 1u); break; } }
    }
    nloc = mine > 0u ? mine : 1u; nx = cnt > 0u ? cnt : 1u;
}
__device__ __forceinline__ void xcd_barrier(const XcdBarrier& b) {
    asm volatile("s_waitcnt vmcnt(0)" ::: "memory");
    __syncthreads();
    if (threadIdx.x == 0) {
        unsigned* bar = b.bar;
        __builtin_amdgcn_s_waitcnt(0);
        unsigned nloc = b.st[0], nx = b.st[1];
        if (nloc == 0u) { xcd_barrier_complete(bar, b.x, nloc, nx); b.st[0] = nloc; b.st[1] = nx; }
        const unsigned old = xb_add(&bar[XB_XSUB(b.x)], 1u);
        const unsigned gen = old / nloc;
        if (old + 1u == (gen + 1u) * nloc) {
            __builtin_amdgcn_fence(__ATOMIC_RELEASE, "agent");
            asm volatile("s_waitcnt vmcnt(0)" ::: "memory");
            const unsigned og = xb_add(&bar[XB_TOP], 1u);
            const unsigned tg = og / nx;
            if (og + 1u == (tg + 1u) * nx) xb_add(&bar[XB_TOPGEN], 1u);
            else XB_SPIN(xb_ld(&bar[XB_TOPGEN]) == tg, bar);
            __builtin_amdgcn_fence(__ATOMIC_ACQUIRE, "agent");
            xb_add(&bar[XB_XGEN(b.x)], 1u);
            asm volatile("s_waitcnt vmcnt(0)" ::: "memory");
        } else {
            XB_SPIN(xb_ld(&bar[XB_XGEN(b.x)]) == gen, bar);
            __builtin_amdgcn_fence(__ATOMIC_ACQUIRE, "agent");
            asm volatile("s_waitcnt vmcnt(0)" ::: "memory");
        }
    }
    __syncthreads();
}

struct Frame {
    LAS unsigned char* lds;
    int tid, lane, wave, vcu, G;
};
__device__ __forceinline__ float wave_sum(float v) {
#pragma unroll
    for (int o = 1; o < 64; o <<= 1) v += __shfl_xor(v, o);
    return v;
}

__device__ __forceinline__ void transpose_item(const float* W, int ldw, bf16* WT, int K, int drow0, int scol0, int k0, const float* kscale, const float* nscale, float cscale, LAS float* scr, int lane) {
    const float ns = nscale ? nscale[drow0 + (lane & 31)] * cscale : cscale;
#pragma unroll 8
    for (int i = 0; i < 32; ++i) { const int kk = 2 * i + (lane >> 5); float w = W[(size_t)(k0 + kk) * ldw + scol0 + (lane & 31)] * ns; if (kscale) w *= kscale[k0 + kk]; scr[kk * 33 + (lane & 31)] = w; }
    LDS_WAIT(); asm volatile("" ::: "memory");
    const int c = lane & 7;
#pragma unroll
    for (int j = 0; j < 4; ++j) { const int n = (lane >> 3) + 8 * j; const LAS float* s = scr + (8 * c) * 33 + n;
        v4u o; o.x = pk2(s[0 * 33], s[1 * 33]); o.y = pk2(s[2 * 33], s[3 * 33]); o.z = pk2(s[4 * 33], s[5 * 33]); o.w = pk2(s[6 * 33], s[7 * 33]);
        *(GAS v4u*)(WT + (size_t)(drow0 + n) * K + k0 + 8 * c) = o; }
    LDS_WAIT(); asm volatile("" ::: "memory");
}
struct Ptrs {
    const float *xp, *xs, *spool, *ck, *cv, *n1, *w1in, *w1out, *nmix, *n2, *w2in, *w2out, *poolw, *pscale, *wqkv, *bqkv, *wo, *bo, *sinks, *nfin;
    float* out; unsigned char* ws;
};
__device__ __forceinline__ void p0_prologue(const Frame& F, const Ptrs& P) {
    LAS float* scr = (LAS float*)(F.lds + RING_OFF + F.wave * 16384);
    const int gw = F.vcu * NWAVES + F.wave, NGW = F.G * NWAVES;
    constexpr int I_W1 = (DM / 64) * (2 * DFF / 32), I_W2 = (DFF / 64) * (DM / 32), I_FFN = I_W1 + I_W2;
    constexpr int I_QKV = (DM / 64) * (QKVN / 32), I_WO = (DM / 64) * (DM / 32), I_POOL = 4 * 4 * 8;
    constexpr int NITEMS = 4 * I_FFN + I_QKV + I_WO + I_POOL;
    for (int it = gw; it < NITEMS; it += NGW) {
        int r = it;
        if (r < 4 * I_FFN) {
            const int f = r / I_FFN; r -= f * I_FFN; const int layer = f >> 1, second = f & 1;
            const float* win = (second ? P.w2in : P.w1in) + (size_t)layer * DM * 2 * DFF;
            const float* wout = (second ? P.w2out : P.w1out) + (size_t)layer * DFF * DM;
            const float* gn = (second ? P.n2 : P.n1) + layer * DM;
            if (r < I_W1) { const int nblk = 2 * DFF / 32, kb = r / nblk, nb = r % nblk, j = 32 * nb;
                const int scol = ((j >> 7) & 1) * DFF + (j >> 8) * 128 + (j & 127);
                transpose_item(win, 2 * DFF, (bf16*)(P.ws + WS_W1 + f * W1_BYTES), DM, j, scol, 64 * kb, gn, nullptr, 1.0f, scr, F.lane);
            } else { r -= I_W1; const int nblk = DM / 32, kb = r / nblk, nb = r % nblk;
                transpose_item(wout, DM, (bf16*)(P.ws + WS_W2 + f * W2_BYTES), DFF, 32 * nb, 32 * nb, 64 * kb, nullptr, nullptr, 0.5f, scr, F.lane); }
            continue;
        }
        r -= 4 * I_FFN;
        if (r < I_QKV) { const int nblk = QKVN / 32, kb = r / nblk, nb = r % nblk, j = 32 * nb;
            const int scol = (j >> 8) * 256 + ((j >> 5) & 3) * 64 + ((j >> 7) & 1) * 32;
            transpose_item(P.wqkv, QKVN, (bf16*)(P.ws + WS_WQKV), DM, j, scol, 64 * kb, P.nmix + DM, nullptr, 1.0f, scr, F.lane); continue; }
        r -= I_QKV;
        if (r < I_WO) { const int nblk = DM / 32, kb = r / nblk, nb = r % nblk;
            transpose_item(P.wo, DM, (bf16*)(P.ws + WS_WO), DM, 32 * nb, 32 * nb, 64 * kb, nullptr, nullptr, 1.0f, scr, F.lane); continue; }
        r -= I_WO;
        { const int gi = r >> 5, kb = (r >> 3) & 3, nb = r & 7;
            transpose_item(P.poolw + (size_t)gi * 65536, 256, (bf16*)(P.ws + WS_WPOOL), 256, gi * 256 + 32 * nb, 32 * nb, 64 * kb, nullptr, P.pscale, 1.0f, scr, F.lane); }
    }
    {
        float* rope = (float*)(P.ws + WS_ROPE);
        const double r1 = 1.0 / sqrt(sqrt(sqrt(10.0)));
        for (int e = (F.vcu * NWAVES * 64) + F.tid; e < (TPS + TSS) * 32; e += F.G * NWAVES * 64) {
            const int pidx = e >> 5, d = e & 31; const int pos = pidx < TPS ? pidx : PAST + (pidx - TPS);
            double inv = 1.0; for (int i = 0; i < d; ++i) inv *= r1;
            double turns = (double)pos * inv * 0.15915494309189535; turns -= floor(turns);
            const float a = (float)(turns * 6.283185307179586);
            rope[2 * e] = cosf(a); rope[2 * e + 1] = sinf(a);
        }
    }
    {
        bf16* XB = (bf16*)(P.ws + WS_XB); float* SSQ = (float*)(P.ws + WS_SSQ);
        for (int m = gw; m < MT; m += NGW) {
            const float* xrow = (m < MP) ? P.xp + (size_t)m * DM : P.xs + (size_t)(m - MP) * DM;
            const GAS f32x4* xr = (const GAS f32x4*)xrow + F.lane;
            f32x4 v[4]; float s = 0.f;
#pragma unroll
            for (int j = 0; j < 4; ++j) { v[j] = xr[64 * j]; s += (v[j][0] * v[j][0] + v[j][1] * v[j][1]) + (v[j][2] * v[j][2] + v[j][3] * v[j][3]); }
            s = wave_sum(s);
            GAS unsigned long long* o8 = (GAS unsigned long long*)(XB + (size_t)m * DM) + F.lane;
#pragma unroll
            for (int j = 0; j < 4; ++j) o8[64 * j] = (unsigned long long)pk2(v[j][0], v[j][1]) | ((unsigned long long)pk2(v[j][2], v[j][3]) << 32);
            if (F.lane < 16) SSQ[(size_t)m * 16 + F.lane] = (F.lane == 0) ? s : 0.f;
        }
    }
}

template <int WG, int NROWS>
__device__ __forceinline__ void pool_rows(const float* X, int r0, int tpos0, const float* hist_raw  , bool hist_x, const LAS float* rs  ,
                                          f32x2 g, int c0, bf16* Pm, float* np_out  , int np_t0) {
    f32x2 h[16];
#pragma unroll
    for (int k = 0; k < 16; ++k) h[k] = (f32x2){0.f, 0.f};
    if (hist_x) {
#pragma unroll
        for (int k = 1; k < 16; ++k) { const f32x2 x = *(const f32x2*)(X + (size_t)(r0 - 16 + k) * DM + c0); h[k] = x * rs[k - 1] * g; }
    } else if (hist_raw) {
#pragma unroll
        for (int k = 1; k < 16; ++k) h[k] = *(const f32x2*)(hist_raw + (size_t)(k - 1) * DM + c0);
    }
    for (int blk = 0; blk < (NROWS + 15) / 16; ++blk) {
#pragma unroll
        for (int k = 0; k < 16; ++k) {
            if (blk * 16 + k < NROWS) {
                const int lr = blk * 16 + k, row = r0 + lr, tpos = tpos0 + lr;
                const f32x2 x = *(const f32x2*)(X + (size_t)row * DM + c0);
                const f32x2 u = x * rs[15 + lr] * g;
                h[k] = u;
                f32x2 s = u;
#pragma unroll
                for (int j = 1; j < WG; ++j) s += h[(k - j) & 15];
                const int cnt = (tpos + 1 < WG) ? tpos + 1 : WG;
                const f32x2 p = s * (1.0f / (float)cnt) - u;
                *(unsigned*)(Pm + (size_t)row * DM + c0) = pk2(p[0], p[1]);
                if (tpos >= np_t0) *(f32x2*)(np_out + (size_t)(tpos - np_t0) * DM + c0) = u;
            }
        }
    }
}
template <int NROWS>
__device__ __forceinline__ void pool_unit(const Frame& F, const Ptrs& P, int r0, int tpos0, const float* hist_raw, bool hist_x, float* np_out, int np_t0) {
    const float* X = P.out + O_Y; const float* SSQ = (const float*)(P.ws + WS_SSQ); bf16* Pm = (bf16*)(P.ws + WS_P);
    LAS float* rs = (LAS float*)(F.lds + RING_OFF);
    __syncthreads();
    if (F.tid < 15 + NROWS) { const int row = r0 - 15 + F.tid; rs[F.tid] = (F.tid >= 15 || hist_x) ? pg8::row_rstd(SSQ, row) : 0.f; }
    __syncthreads();
    const int c0 = 2 * F.tid; const f32x2 g = *(const f32x2*)(P.nmix + c0);
    const int gi = F.tid >> 7;
    if (gi == 0) pool_rows<2, NROWS>(X, r0, tpos0, hist_raw, hist_x, rs, g, c0, Pm, np_out, np_t0);
    else if (gi == 1) pool_rows<4, NROWS>(X, r0, tpos0, hist_raw, hist_x, rs, g, c0, Pm, np_out, np_t0);
    else if (gi == 2) pool_rows<8, NROWS>(X, r0, tpos0, hist_raw, hist_x, rs, g, c0, Pm, np_out, np_t0);
    else pool_rows<16, NROWS>(X, r0, tpos0, hist_raw, hist_x, rs, g, c0, Pm, np_out, np_t0);
}
__device__ __forceinline__ void pool_phase(const Frame& F, const Ptrs& P) {
    for (int u = F.vcu; u < MP / 64; u += F.G) {
        const int r0 = u * 64, b = r0 >> 11, t0 = r0 & (TPS - 1);
        pool_unit<64>(F, P, r0, t0, nullptr, t0 > 0, P.out + O_POOLP + (size_t)b * 15 * DM, TPS - 15);
    }
    for (int b = F.vcu; b < NSB; b += F.G) {
        const float* sp = P.spool + (size_t)b * 15 * DM; float* np = P.out + O_POOLS + (size_t)b * 15 * DM;
        for (int e = F.tid; e < 7 * DM / 4; e += NWAVES * 64) ((f32x4*)np)[e] = ((const f32x4*)(sp + 8 * DM))[e];
        pool_unit<8>(F, P, MP + b * TSS, PAST, sp, false, np, PAST - 7);
    }
}

namespace att {
constexpr int LDS_K = 0, LDS_V = 3 * 8192, LDS_WS = 6 * 8192, LDS_OST = LDS_WS + NWAVES * 256, LDS_TOTAL = LDS_OST + NWAVES * 4096;
__device__ __forceinline__ int crow(int r, int hi) { return (r & 3) + 8 * (r >> 2) + 4 * hi; }
__device__ __forceinline__ unsigned cvtpk_s(float lo, float hi) { typedef float f2 __attribute__((ext_vector_type(2))); typedef __bf16 b2 __attribute__((ext_vector_type(2))); f2 v = {lo, hi}; b2 b = __builtin_convertvector(v, b2); return __builtin_bit_cast(unsigned, b); }
typedef short v4i16_t __attribute__((ext_vector_type(4)));
__device__ __forceinline__ s16x4 vtr(const LAS unsigned char* p) { return __builtin_bit_cast(s16x4, __builtin_amdgcn_ds_read_tr16_b64_v4i16((LAS v4i16_t*)p)); }
constexpr float NEG = -1.0e30f;

struct Soft { v4u pa[5][2]; float l; };
__device__ __forceinline__ void softmax5(f32x16 (&sc)[5], float sk, Soft& R) {
    float m = sk;
#pragma unroll
    for (int i = 0; i < 5; ++i)
#pragma unroll
        for (int r = 0; r < 16; ++r) m = fmaxf(m, sc[i][r]);
    { auto rr = __builtin_amdgcn_permlane32_swap(__float_as_uint(m), __float_as_uint(m), false, false); m = fmaxf(__uint_as_float(rr[0]), __uint_as_float(rr[1])); }
    float l = 0.f;
#pragma unroll
    for (int i = 0; i < 5; ++i) {
#pragma unroll
        for (int r = 0; r < 16; ++r) { const float p = __builtin_amdgcn_exp2f(sc[i][r] - m); sc[i][r] = p; l += p; }
#pragma unroll
        for (int s = 0; s < 2; ++s) R.pa[i][s] = (v4u){cvtpk_s(sc[i][8 * s + 0], sc[i][8 * s + 1]), cvtpk_s(sc[i][8 * s + 2], sc[i][8 * s + 3]), cvtpk_s(sc[i][8 * s + 4], sc[i][8 * s + 5]), cvtpk_s(sc[i][8 * s + 6], sc[i][8 * s + 7])};
    }
    { auto rr = __builtin_amdgcn_permlane32_swap(__float_as_uint(l), __float_as_uint(l), false, false); l = __uint_as_float(rr[0]) + __uint_as_float(rr[1]); }
    R.l = l + __builtin_amdgcn_exp2f(sk - m);
}

__device__ __forceinline__ void prompt_unit(const Frame& F, int b, int kvh, int qb, const bf16* Q, const bf16* K, const bf16* V, bf16* O, const float* sinks) {
    const int lane = F.lane, wid = F.wave, r32 = lane & 31, hi = lane >> 5;
    LAS unsigned char* lds = F.lds + RING_OFF;
    const int q0 = qb * 64, jmin = (qb >= 2) ? 0 : 2 - qb;
    const long rowbase = (long)b * TPS;
    __syncthreads();
#pragma unroll
    for (int j = 0; j < 3; ++j) if (j >= jmin) {
        const long kr0 = rowbase + q0 - 128 + 64 * j;
        const v4u kv = *(const v4u*)(K + (kr0 + lane) * KVD + kvh * 64 + wid * 8);
        *(LAS v4u*)(lds + LDS_K + j * 8192 + wid * 1024 + lane * 16) = kv;
        const v4u vv = *(const v4u*)(V + (kr0 + 16 * (wid & 3) + (lane >> 2)) * KVD + kvh * 64 + (wid >> 2) * 32 + (lane & 3) * 8);
        *(LAS v4u*)(lds + LDS_V + j * 8192 + wid * 1024 + lane * 16) = vv;
    }
    const int g = wid >> 1, half = wid & 1, h = 4 * kvh + g;
    const bf16* Qw = Q + (rowbase + q0 + 32 * half) * DM + h * HD;
    bf16x8 qr[4];
#pragma unroll
    for (int d0 = 0; d0 < 4; ++d0) qr[d0] = *(const bf16x8*)(Qw + (long)r32 * DM + d0 * 16 + hi * 8);
    const float sk = sinks[h] * LOG2E;
    __syncthreads();
    f32x16 sc[5];
#pragma unroll
    for (int i = 0; i < 5; ++i) {
        const int kb = half + i, tile = kb >> 1, p = kb & 1;
        if (tile >= jmin) {
            const LAS unsigned char* kp = lds + LDS_K + tile * 8192 + p * 512 + hi * 1024 + r32 * 16;
            f32x16 a = {};
#pragma unroll
            for (int d0 = 0; d0 < 4; ++d0) a = __builtin_amdgcn_mfma_f32_32x32x16_bf16(*(const LAS bf16x8*)(kp + d0 * 2048), qr[d0], a, 0, 0, 0);
            sc[i] = a;
        } else {
#pragma unroll
            for (int r = 0; r < 16; ++r) sc[i][r] = NEG;
        }
    }
#pragma unroll
    for (int r = 0; r < 16; ++r) { const int kk = crow(r, hi); if (!(kk > r32)) sc[0][r] = NEG; if (!(kk <= r32)) sc[4][r] = NEG; }
    Soft S; softmax5(sc, sk, S);
    f32x16 o[2]; o[0] = f32x16{}; o[1] = f32x16{};
#pragma unroll
    for (int i = 0; i < 5; ++i) {
        const int kb = half + i, tile = kb >> 1, p = kb & 1;
        if (tile >= jmin) {
            const LAS unsigned char* vp = lds + LDS_V + tile * 8192 + ((lane >> 4) & 1) * 32 + (lane & 3) * 8 + (4 * hi + ((lane & 15) >> 2)) * 64;
#pragma unroll
            for (int s = 0; s < 2; ++s)
#pragma unroll
                for (int d0 = 0; d0 < 2; ++d0) {
                    const s16x4 lo = vtr(vp + d0 * 4096 + (2 * p + s) * 1024), hh = vtr(vp + d0 * 4096 + (2 * p + s) * 1024 + 512);
                    const bf16x8 vf = (bf16x8){lo[0], lo[1], lo[2], lo[3], hh[0], hh[1], hh[2], hh[3]};
                    o[d0] = __builtin_amdgcn_mfma_f32_32x32x16_bf16(__builtin_bit_cast(bf16x8, S.pa[i][s]), vf, o[d0], 0, 0, 0);
                }
        }
    }
    LAS float* wsf = (LAS float*)(lds + LDS_WS) + wid * 64;
    if (hi == 0) wsf[r32] = S.l;
    LDS_WAIT();
    LAS bf16* stg = (LAS bf16*)(lds + LDS_OST) + wid * 2048;
#pragma unroll
    for (int r = 0; r < 16; ++r) { const int orow = crow(r, hi); const float rl = __builtin_amdgcn_rcpf(wsf[orow]);
#pragma unroll
        for (int d0 = 0; d0 < 2; ++d0) stg[orow * 64 + d0 * 32 + r32] = (bf16)f2bf(o[d0][r] * rl); }
    LDS_WAIT();
    bf16* Ow = O + (rowbase + q0 + 32 * half) * DM + h * HD;
#pragma unroll
    for (int i = 0; i < 4; ++i) { const int row = i * 8 + (lane >> 3), ch = lane & 7; const v4u v = *(const LAS v4u*)(stg + row * 64 + ch * 8); *(v4u*)(Ow + (long)row * DM + ch * 8) = v; }
}

__device__ __forceinline__ void sample_unit(int lane, int b, int kvh, const bf16* Q, const bf16* Kn, const bf16* Vn, const float* ck, const float* cv, bf16* O, const float* sinks, LAS float* wsf) {
    const int r32 = lane & 31, hi = lane >> 5, qi = r32 & 7, h = 4 * kvh + (r32 >> 3);
    const long qrow = (long)MP + b * TSS + qi;
    bf16x8 qr[4];
#pragma unroll
    for (int d0 = 0; d0 < 4; ++d0) qr[d0] = *(const bf16x8*)(Q + qrow * DM + h * HD + d0 * 16 + hi * 8);
    const float sk = sinks[h] * LOG2E;
    f32x16 sc[5];
#pragma unroll
    for (int blk = 0; blk < 4; ++blk) {
        f32x16 a = {};
        const float* kp = ck + ((size_t)(b * 128 + 32 * blk + r32) * NKV + kvh) * HD + hi * 8;
#pragma unroll
        for (int d0 = 0; d0 < 4; ++d0) { const f32x4 x0 = *(const f32x4*)(kp + d0 * 16), x1 = *(const f32x4*)(kp + d0 * 16 + 4);
            const v4u kw = (v4u){cvtpk_s(x0[0], x0[1]), cvtpk_s(x0[2], x0[3]), cvtpk_s(x1[0], x1[1]), cvtpk_s(x1[2], x1[3])};
            a = __builtin_amdgcn_mfma_f32_32x32x16_bf16(__builtin_bit_cast(bf16x8, kw), qr[d0], a, 0, 0, 0); }
        sc[blk] = a;
    }
    {
        f32x16 a = {};
        const bf16* kp = Kn + ((long)MP + b * TSS + (r32 & 7)) * KVD + kvh * HD + hi * 8;
#pragma unroll
        for (int d0 = 0; d0 < 4; ++d0) { v4u kw = *(const v4u*)(kp + d0 * 16); if (r32 >= 8) kw = (v4u){0u, 0u, 0u, 0u};
            a = __builtin_amdgcn_mfma_f32_32x32x16_bf16(__builtin_bit_cast(bf16x8, kw), qr[d0], a, 0, 0, 0); }
        sc[4] = a;
    }
#pragma unroll
    for (int blk = 0; blk < 5; ++blk)
#pragma unroll
        for (int r = 0; r < 16; ++r) { const int j = 32 * blk + crow(r, hi); if (!(j >= qi + 1 && j <= 128 + qi)) sc[blk][r] = NEG; }
    Soft S; softmax5(sc, sk, S);
    f32x16 o[2]; o[0] = f32x16{}; o[1] = f32x16{};
#pragma unroll
    for (int blk = 0; blk < 4; ++blk)
#pragma unroll
        for (int s = 0; s < 2; ++s)
#pragma unroll
            for (int d0 = 0; d0 < 2; ++d0) {
                float vv[8];
#pragma unroll
                for (int jj = 0; jj < 8; ++jj) { const int key = 32 * blk + 16 * s + 8 * (jj >> 2) + 4 * hi + (jj & 3); vv[jj] = cv[((size_t)(b * 128 + key) * NKV + kvh) * HD + d0 * 32 + r32]; }
                const v4u vw = (v4u){cvtpk_s(vv[0], vv[1]), cvtpk_s(vv[2], vv[3]), cvtpk_s(vv[4], vv[5]), cvtpk_s(vv[6], vv[7])};
                o[d0] = __builtin_amdgcn_mfma_f32_32x32x16_bf16(__builtin_bit_cast(bf16x8, S.pa[blk][s]), __builtin_bit_cast(bf16x8, vw), o[d0], 0, 0, 0);
            }
#pragma unroll
    for (int d0 = 0; d0 < 2; ++d0) {
        unsigned short e[4];
#pragma unroll
        for (int jj = 0; jj < 4; ++jj) e[jj] = Vn[((long)MP + b * TSS + 4 * hi + jj) * KVD + kvh * HD + d0 * 32 + r32];
        const v4u vw = (v4u){(unsigned)e[0] | ((unsigned)e[1] << 16), (unsigned)e[2] | ((unsigned)e[3] << 16), 0u, 0u};
        o[d0] = __builtin_amdgcn_mfma_f32_32x32x16_bf16(__builtin_bit_cast(bf16x8, S.pa[4][0]), __builtin_bit_cast(bf16x8, vw), o[d0], 0, 0, 0);
    }
    if (hi == 0) wsf[r32] = S.l;
    LDS_WAIT();
#pragma unroll
    for (int r = 0; r < 16; ++r) { const int q = crow(r, hi); const float rl = __builtin_amdgcn_rcpf(wsf[q]);
        bf16* orow = O + ((long)MP + b * TSS + (q & 7)) * DM + (4 * kvh + (q >> 3)) * HD + r32;
#pragma unroll
        for (int d0 = 0; d0 < 2; ++d0) orow[d0 * 32] = (bf16)f2bf(o[d0][r] * rl); }
    LDS_WAIT();
}

__device__ __forceinline__ void attn_phase(const Frame& F, const Ptrs& P) {
    const bf16* Q = (const bf16*)(P.ws + WS_Q); const bf16* K = (const bf16*)(P.ws + WS_K); const bf16* V = (const bf16*)(P.ws + WS_V); bf16* O = (bf16*)(P.ws + WS_O);
    constexpr int NPU = NPB * NKV * 32;
    const int per = (NPU + F.G - 1) / F.G;
    for (int i = 0; i < per; ++i) { const int u = F.vcu * per + i; if (u < NPU) prompt_unit(F, u >> 7, (u >> 5) & 3, u & 31, Q, K, V, O, P.sinks); }
    __syncthreads();
    LAS float* wsf = (LAS float*)(F.lds + RING_OFF + LDS_WS) + F.wave * 64;
    const int gw = F.vcu * NWAVES + F.wave, NGW = F.G * NWAVES;
    for (int u = gw; u < NSB * NKV; u += NGW) sample_unit(F.lane, u >> 2, u & 3, Q, K, V, P.ck, P.cv, O, P.sinks, wsf);
    {
        constexpr int PER_B = 120 * KVD / 4;
        const int gt = F.vcu * NWAVES * 64 + F.tid, NT = F.G * NWAVES * 64;
        for (int e = gt; e < 2 * NSB * PER_B; e += NT) {
            const int which = e / (NSB * PER_B), r = e - which * (NSB * PER_B), b = r / PER_B, w = r - b * PER_B;
            const f32x4* src = (const f32x4*)(which ? P.cv : P.ck) + (size_t)b * (128 * KVD / 4) + (8 * KVD / 4) + w;
            f32x4* dst = (f32x4*)(P.out + (which ? O_VS : O_KS)) + (size_t)b * (128 * KVD / 4) + w;
            *dst = *src;
        }
    }
}
}

__device__ __forceinline__ void final_phase(const Frame& F, const Ptrs& P) {
    float* X = P.out + O_Y; const float* SSQ = (const float*)(P.ws + WS_SSQ);
    const int gw = F.vcu * NWAVES + F.wave, NGW = F.G * NWAVES;
    f32x4 gv[4];
#pragma unroll
    for (int j = 0; j < 4; ++j) gv[j] = ((const f32x4*)P.nfin)[64 * j + F.lane];
    for (int m = gw; m < MT; m += NGW) {
        const float rs = pg8::row_rstd(SSQ, m);
        f32x4* xr = (f32x4*)(X + (size_t)m * DM) + F.lane;
#pragma unroll
        for (int j = 0; j < 4; ++j) xr[64 * j] = xr[64 * j] * rs * gv[j];
    }
}

constexpr int NPHASES = 15;
struct Args { const float* in[20]; float* out; unsigned char* ws; int ph_lo, ph_hi; };
__global__ void __launch_bounds__(NWAVES * 64, 2) mk_fwd(Args args) {
    extern __shared__ __attribute__((aligned(16))) unsigned char lds_raw[];
    {
        LAS unsigned char* l0 = (LAS unsigned char*)lds_raw;
        for (int u = threadIdx.x; u < (LDS_BYTES - LDSCTL_OFF) / 4; u += NWAVES * 64) ((LAS unsigned*)(l0 + LDSCTL_OFF))[u] = 0u;
        __syncthreads();
    }
    const int lo = args.ph_lo, hi = args.ph_hi;
    XcdBarrier bar; bar.bar = (unsigned*)(args.ws + WS_CTL) + CW_BAR; bar.x = 0; bar.st = nullptr;
    if (hi - lo > 1) bar = xcd_barrier_post((unsigned*)(args.ws + WS_CTL) + CW_BAR, (volatile LAS unsigned*)((LAS unsigned char*)lds_raw + MISC_OFF) + 8);
    for (int ph = lo; ph < hi; ++ph) {
        int tid = threadIdx.x; asm volatile("" : "+v"(tid));
        int bx = blockIdx.x, G = gridDim.x; asm volatile("" : "+s"(bx), "+s"(G));
        const __attribute__((address_space(4))) Args* ap = (const __attribute__((address_space(4))) Args*)__builtin_amdgcn_kernarg_segment_ptr(); asm volatile("" : "+s"(ap));
        Frame F;
        F.lds = (LAS unsigned char*)lds_raw;
        F.tid = tid; F.lane = tid & 63; F.wave = __builtin_amdgcn_readfirstlane(tid >> 6);
        F.G = G; F.vcu = (G % 8 == 0) ? (bx % 8) * (G / 8) + bx / 8 : bx;
        Ptrs P;
        P.xp = ap->in[0]; P.xs = ap->in[1]; P.spool = ap->in[2]; P.ck = ap->in[3]; P.cv = ap->in[4]; P.n1 = ap->in[5]; P.w1in = ap->in[6]; P.w1out = ap->in[7];
        P.nmix = ap->in[8]; P.n2 = ap->in[9]; P.w2in = ap->in[10]; P.w2out = ap->in[11]; P.poolw = ap->in[12]; P.pscale = ap->in[13]; P.wqkv = ap->in[14]; P.bqkv = ap->in[15];
        P.wo = ap->in[16]; P.bo = ap->in[17]; P.sinks = ap->in[18]; P.nfin = ap->in[19]; P.out = ap->out; P.ws = ap->ws;
        unsigned char* ws = P.ws;
        bf16* XB = (bf16*)(ws + WS_XB); bf16* Hb = (bf16*)(ws + WS_H); float* SSQ = (float*)(ws + WS_SSQ);
        float* X = P.out + O_Y;
        if (ph == 0 && (PHMASK & 1)) {
            p0_prologue(F, P);
        } else if ((ph == 1 || ph == 5 || ph == 7 || ph == 12) && (PHMASK & 2)) {
            const int f = (ph == 1) ? 0 : (ph == 5) ? 1 : (ph == 7) ? 2 : 3;
            pg8::Gemm g{XB, (const bf16*)(ws + WS_W1 + f * W1_BYTES), MT, 2 * DFF, DM, DM, DM, 0};
            pg8::StaticOrder S; S.init(MT, 2 * DFF, F.G, bx);
            pg8::EpiSwiglu E{Hb, SSQ};
            pg8::gemm_phase<pg8::EpiSwiglu, pg8::StaticOrder, true, true>(F.lds + RING_OFF, g, S, E, F.tid);
        } else if ((ph == 2 || ph == 6 || ph == 8 || ph == 13 || ph == 4 || ph == 11) && (PHMASK & 4)) {
            pg8::Gemm g; pg8::EpiRes E;
            E.xold_lo = X; E.xold_hi = X + (size_t)MP * DM; E.xnew = X; E.xb = XB; E.ssq = SSQ; E.bias = nullptr;
            if (ph == 4) { g = pg8::Gemm{(const bf16*)(ws + WS_P), (const bf16*)(ws + WS_WPOOL), MT, DM, 256, DM, 256, 256}; }
            else if (ph == 11) { g = pg8::Gemm{(const bf16*)(ws + WS_O), (const bf16*)(ws + WS_WO), MT, DM, DM, DM, DM, 0}; E.bias = P.bo; }
            else { const int f = (ph == 2) ? 0 : (ph == 6) ? 1 : (ph == 8) ? 2 : 3;
                g = pg8::Gemm{Hb, (const bf16*)(ws + WS_W2 + f * W2_BYTES), MT, DM, DFF, DFF, DFF, 0};
                if (ph == 2) { E.xold_lo = P.xp; E.xold_hi = P.xs; } }
            pg8::StaticOrder S; S.init(MT, DM, F.G, bx);
            pg8::gemm_phase<pg8::EpiRes, pg8::StaticOrder, true, true>(F.lds + RING_OFF, g, S, E, F.tid);
        } else if (ph == 3 && (PHMASK & 8)) {
            pool_phase(F, P);
        } else if (ph == 9 && (PHMASK & 16)) {
            pg8::Gemm g{XB, (const bf16*)(ws + WS_WQKV), MT, QKVN, DM, DM, DM, 0};
            pg8::StaticOrder S; S.init(MT, QKVN, F.G, bx);
            pg8::EpiQKV E{(bf16*)(ws + WS_Q), (bf16*)(ws + WS_K), (bf16*)(ws + WS_V), SSQ, P.bqkv, (const float*)(ws + WS_ROPE), P.out};
            pg8::gemm_phase<pg8::EpiQKV, pg8::StaticOrder, true, true>(F.lds + RING_OFF, g, S, E, F.tid);
        } else if (ph == 10 && (PHMASK & 32)) {
            att::attn_phase(F, P);
        } else if (ph == 14 && (PHMASK & 64)) {
            final_phase(F, P);
        }
        if (ph + 1 < hi) { XcdBarrier b2 = bar; unsigned* bb = bar.bar; asm volatile("" : "+s"(bb)); b2.bar = bb; xcd_barrier(b2); }
    }
}

extern "C" void kernel_launch(void* const* d_in, const int* in_sizes, int n_in, void* d_out, int out_size, void* d_ws, size_t ws_size, hipStream_t stream) {
    static int grid = 0;
    if (grid == 0) {
        if (n_in != 20 || (size_t)out_size != O_END || ws_size < WS_END) { fprintf(stderr, "kernel_launch: unexpected shapes (n_in %d out %d ws %zu)\n", n_in, out_size, ws_size); grid = -1; return; }
        int dev = 0, cus = 0, per_cu = 0;
        if (hipGetDevice(&dev) != hipSuccess || hipDeviceGetAttribute(&cus, hipDeviceAttributeMultiprocessorCount, dev) != hipSuccess) { grid = -1; return; }
        if (hipFuncSetAttribute((const void*)mk_fwd, hipFuncAttributeMaxDynamicSharedMemorySize, LDS_BYTES) != hipSuccess) { fprintf(stderr, "kernel_launch: hipFuncSetAttribute failed\n"); grid = -1; return; }
        if (hipOccupancyMaxActiveBlocksPerMultiprocessor(&per_cu, (const void*)mk_fwd, NWAVES * 64, LDS_BYTES) != hipSuccess || per_cu < 1)
            fprintf(stderr, "kernel_launch: occupancy query reports %d workgroups per CU\n", per_cu);
        (void)hipGetLastError();
        grid = cus;
    }
    if (grid < 0) return;
    (void)hipMemsetAsync((char*)d_ws + WS_CTL, 0, CTL_ZERO_BYTES, stream);
    Args a{};
    for (int i = 0; i < 20; ++i) a.in[i] = (const float*)d_in[i];
    a.out = (float*)d_out; a.ws = (unsigned char*)d_ws;
#if MK_ONE_LAUNCH
    a.ph_lo = 0; a.ph_hi = NPHASES;
    hipLaunchKernelGGL(mk_fwd, dim3(grid), dim3(NWAVES * 64), LDS_BYTES, stream, a);
#else
    for (int ph = 0; ph < NPHASES; ++ph) { a.ph_lo = ph; a.ph_hi = ph + 1; hipLaunchKernelGGL(mk_fwd, dim3(grid), dim3(NWAVES * 64), LDS_BYTES, stream, a); }
#endif
}
```

```cpp
#include <hip/hip_runtime.h>
#include <cstdio>
#include <cstdint>

#ifndef PHMASK
#define PHMASK 127
#endif
#ifndef MK_ONE_LAUNCH
#define MK_ONE_LAUNCH 1
#endif

constexpr int DM = 1024, DFF = 2816, NPB = 8, TPS = 2048, MP = NPB * TPS, NSB = 128, TSS = 8, MS = NSB * TSS, MT = MP + MS;
constexpr int QKVN = 1536, NHEAD = 16, NKV = 4, HD = 64, KVD = 256;
constexpr int PAST = 8192;
constexpr float RMS_EPS = 1e-6f;
constexpr float LOG2E = 1.4426950408889634f;
constexpr float QSCALE = 0.125f * LOG2E;
constexpr size_t O_Y = 0;
constexpr size_t O_POOLP = (size_t)MT * DM;
constexpr size_t O_POOLS = O_POOLP + (size_t)NPB * 15 * DM;
constexpr size_t O_KP = O_POOLS + (size_t)NSB * 15 * DM;
constexpr size_t O_VP = O_KP + (size_t)NPB * 128 * KVD;
constexpr size_t O_KS = O_VP + (size_t)NPB * 128 * KVD;
constexpr size_t O_VS = O_KS + (size_t)NSB * 128 * KVD;
constexpr size_t O_END = O_VS + (size_t)NSB * 128 * KVD;

namespace pg8 {
#define PG8_LAS __attribute__((address_space(3)))
typedef unsigned short bf16_t;
typedef short bf16x8 __attribute__((ext_vector_type(8)));
typedef float f32x4 __attribute__((ext_vector_type(4)));
typedef float f32x2 __attribute__((ext_vector_type(2)));
typedef unsigned u32x4 __attribute__((ext_vector_type(4)));
typedef unsigned u32x2 __attribute__((ext_vector_type(2)));
constexpr int BM = 256, BK = 64, HALF = 128, HTB = HALF * BK * 2, STAGE_BYTES = 8 * HTB, NXCD = 8, WGM = 8;

__host__ __device__ __forceinline__ int lds_byte(int r, int c) { const int st = (r >> 4) * 2 + (c >> 5), rr = r & 15, cc = c & 31, ob = rr * 64 + cc * 2; return st * 1024 + (ob ^ (((ob >> 9) & 1) << 5)); }
__host__ __device__ __forceinline__ void stage_rc(int b, int& R, int& C) { const int st = b / 1024, sb = b % 1024, swz = sb ^ (((sb >> 9) & 1) << 5); R = (st >> 1) * 16 + swz / 64; C = (st & 1) * 32 + (swz % 64) / 2; }
__host__ __device__ __forceinline__ int perm32(int rho) { const int n = rho >> 4, i = rho & 15; return 8 * (i >> 2) + 4 * n + (i & 3); }

struct Unit { int pm, pn; };
struct Gemm { const bf16_t* A; const bf16_t* Bt; int M, N, K, lda, ldb, a_pn_cols; };

struct StaticOrder {
    int nM, nN, nwg, G, c;
    __host__ __device__ void init(int M, int N, int G_, int c_) { nM = M / BM; nN = N / BM; nwg = nM * nN; G = G_; c = c_; }
    __host__ __device__ bool next(int i, Unit& u) const {
        const long L = (long)i * G + c; if (L >= nwg) return false;
        int wgid = (int)L; { const int q = nwg / NXCD, r = nwg % NXCD, xcd = wgid % NXCD, off = wgid / NXCD; wgid = (xcd < r ? xcd * (q + 1) : r * (q + 1) + (xcd - r) * q) + off; }
        const int nig = WGM * nN, gid = wgid / nig, fm = gid * WGM, gsz = (nM - fm) < WGM ? (nM - fm) : WGM;
        u.pm = fm + ((wgid % nig) % gsz); u.pn = (wgid % nig) / gsz; return true;
    }
    __device__ __forceinline__ void a_ready(const Unit&) const {}
    __device__ __forceinline__ void done(const Unit&) const {}
};

__device__ __forceinline__ unsigned cvt_pk_bf16(float lo, float hi) { unsigned r; asm volatile("v_cvt_pk_bf16_f32 %0, %1, %2" : "=v"(r) : "v"(lo), "v"(hi)); return r; }

__device__ __forceinline__ float row_rstd(const float* ssq, int row) {
    const f32x4* p = (const f32x4*)(ssq + (size_t)row * 16);
    const f32x4 a = p[0], b = p[1], c = p[2], d = p[3];
    const float s = (((a[0] + a[1]) + (a[2] + a[3])) + ((b[0] + b[1]) + (b[2] + b[3]))) + (((c[0] + c[1]) + (c[2] + c[3])) + ((d[0] + d[1]) + (d[2] + d[3])));
    return 1.0f / sqrtf(s * (1.0f / DM) + RMS_EPS);
}

struct EpiSwiglu {
    static constexpr bool PERM = true, AFTER_DRAIN = false;
    bf16_t* H; const float* ssq;
    __device__ __forceinline__ void operator()(const f32x4 (&acc)[2][2][4][2], const Unit& u, int wr, int wc, int fr, int fq) const {
        const int row0 = u.pm * BM + wr * 64 + fr, col0 = u.pn * HALF + wc * 32 + 8 * fq;
#pragma unroll
        for (int ai = 0; ai < 2; ++ai)
#pragma unroll
            for (int m = 0; m < 4; ++m) {
                const int row = row0 + ai * HALF + m * 16;
                const float rs = row_rstd(ssq, row);
                unsigned w[4];
#pragma unroll
                for (int n = 0; n < 2; ++n) {
                    float o[4];
#pragma unroll
                    for (int i = 0; i < 4; ++i) { const float g = acc[ai][0][m][n][i] * rs, up = acc[ai][1][m][n][i] * rs;
                        const float e = __builtin_amdgcn_exp2f(-g * LOG2E); o[i] = g * __builtin_amdgcn_rcpf(1.0f + e) * up; }
                    w[2 * n] = cvt_pk_bf16(o[0], o[1]); w[2 * n + 1] = cvt_pk_bf16(o[2], o[3]);
                }
                *(u32x4*)(H + (size_t)row * DFF + col0) = (u32x4){w[0], w[1], w[2], w[3]};
                if (m & 1) asm volatile("" ::: "memory");
            }
    }
};
struct EpiRes {
    static constexpr bool PERM = false, AFTER_DRAIN = false;
    const float* xold_lo; const float* xold_hi; float* xnew; bf16_t* xb; float* ssq; const float* bias;
    __device__ __forceinline__ void operator()(const f32x4 (&acc)[2][2][4][2], const Unit& u, int wr, int wc, int fr, int fq) const {
        const int row0 = u.pm * BM + wr * 64 + fr, col0 = u.pn * BM + wc * 32 + 4 * fq;
        f32x4 bv[2][2];
#pragma unroll
        for (int bj = 0; bj < 2; ++bj)
#pragma unroll
            for (int n = 0; n < 2; ++n) bv[bj][n] = bias ? *(const f32x4*)(bias + col0 + bj * HALF + n * 16) : (f32x4){0.f, 0.f, 0.f, 0.f};
#pragma unroll
        for (int ai = 0; ai < 2; ++ai)
#pragma unroll
            for (int m = 0; m < 4; ++m) {
                const int row = row0 + ai * HALF + m * 16;
                const float* xo = (row < MP) ? xold_lo + (size_t)row * DM + col0 : xold_hi + (size_t)(row - MP) * DM + col0;
                float* xn = xnew + (size_t)row * DM + col0; bf16_t* xbp = xb + (size_t)row * DM + col0;
                float s = 0.f;
#pragma unroll
                for (int bj = 0; bj < 2; ++bj)
#pragma unroll
                    for (int n = 0; n < 2; ++n) {
                        const f32x4 v = *(const f32x4*)(xo + bj * HALF + n * 16) + acc[ai][bj][m][n] + bv[bj][n];
                        *(f32x4*)(xn + bj * HALF + n * 16) = v;
                        *(u32x2*)(xbp + bj * HALF + n * 16) = (u32x2){cvt_pk_bf16(v[0], v[1]), cvt_pk_bf16(v[2], v[3])};
                        s += (v[0] * v[0] + v[1] * v[1]) + (v[2] * v[2] + v[3] * v[3]);
                    }
                s += __shfl_xor(s, 16); s += __shfl_xor(s, 32);
                if (fq == 0) ssq[(size_t)row * 16 + u.pn * 4 + wc] = s;
                asm volatile("" ::: "memory");
            }
    }
};
struct EpiQKV {
    static constexpr bool PERM = true, AFTER_DRAIN = false;
    bf16_t* Q; bf16_t* K; bf16_t* V; const float* ssq; const float* bias; const float* rope; float* out;
    __device__ __forceinline__ void operator()(const f32x4 (&acc)[2][2][4][2], const Unit& u, int wr, int wc, int fr, int fq) const {
        const int row0 = u.pm * BM + wr * 64 + fr, pn = u.pn, dd0 = 8 * fq, nat0 = pn * 256 + wc * 64 + dd0;
        f32x4 bv[2][2];
#pragma unroll
        for (int bj = 0; bj < 2; ++bj)
#pragma unroll
            for (int n = 0; n < 2; ++n) bv[bj][n] = *(const f32x4*)(bias + nat0 + bj * 32 + 4 * n);
#pragma unroll
        for (int ai = 0; ai < 2; ++ai)
#pragma unroll
            for (int m = 0; m < 4; ++m) {
                const int row = row0 + ai * HALF + m * 16;
                const float rs = row_rstd(ssq, row);
                f32x4 v[2][2];
#pragma unroll
                for (int bj = 0; bj < 2; ++bj)
#pragma unroll
                    for (int n = 0; n < 2; ++n) v[bj][n] = acc[ai][bj][m][n] * rs + bv[bj][n];
                if (pn < 5) {
                    const int pidx = (row < MP) ? (row & (TPS - 1)) : TPS + ((row - MP) & (TSS - 1));
                    const f32x4* rp = (const f32x4*)(rope + ((size_t)pidx * 32 + dd0) * 2);
#pragma unroll
                    for (int n = 0; n < 2; ++n) {
                        const f32x4 cs0 = rp[2 * n], cs1 = rp[2 * n + 1];
                        const float c[4] = {cs0[0], cs0[2], cs1[0], cs1[2]}, s[4] = {cs0[1], cs0[3], cs1[1], cs1[3]};
                        const f32x4 x1 = v[0][n], x2 = v[1][n];
#pragma unroll
                        for (int i = 0; i < 4; ++i) { v[0][n][i] = x1[i] * c[i] - x2[i] * s[i]; v[1][n][i] = x2[i] * c[i] + x1[i] * s[i]; }
                    }
                }
                if (pn < 4) {
#pragma unroll
                    for (int bj = 0; bj < 2; ++bj) { const f32x4 a = v[bj][0] * QSCALE, b = v[bj][1] * QSCALE;
                        *(u32x4*)(Q + (size_t)row * DM + nat0 + bj * 32) = (u32x4){cvt_pk_bf16(a[0], a[1]), cvt_pk_bf16(a[2], a[3]), cvt_pk_bf16(b[0], b[1]), cvt_pk_bf16(b[2], b[3])}; }
                } else {
                    bf16_t* kv = (pn == 4) ? K : V;
                    const int c0 = wc * 64 + dd0;
#pragma unroll
                    for (int bj = 0; bj < 2; ++bj) { const f32x4 a = v[bj][0], b = v[bj][1];
                        *(u32x4*)(kv + (size_t)row * KVD + c0 + bj * 32) = (u32x4){cvt_pk_bf16(a[0], a[1]), cvt_pk_bf16(a[2], a[3]), cvt_pk_bf16(b[0], b[1]), cvt_pk_bf16(b[2], b[3])}; }
                    float* dst = nullptr;
                    if (row < MP) { const int t = row & (TPS - 1); if (t >= TPS - 128) dst = out + ((pn == 4) ? O_KP : O_VP) + ((size_t)(row >> 11) * 128 + (t - (TPS - 128))) * KVD + c0; }
                    else { const int r = row - MP; dst = out + ((pn == 4) ? O_KS : O_VS) + ((size_t)(r >> 3) * 128 + 120 + (r & 7)) * KVD + c0; }
                    if (dst) {
#pragma unroll
                        for (int bj = 0; bj < 2; ++bj)
#pragma unroll
                            for (int n = 0; n < 2; ++n) *(f32x4*)(dst + bj * 32 + 4 * n) = v[bj][n];
                    }
                }
                asm volatile("" ::: "memory");
            }
    }
};

template <class Epi, class Sched, bool ALIGN_EPI = false, bool SP2 = false>
__device__ __forceinline__ void gemm_phase(PG8_LAS unsigned char* lds, const Gemm g, const Sched& S, const Epi& E, const int tid) {
    const int wid = __builtin_amdgcn_readfirstlane(tid >> 6), lane = tid & 63, wr = wid >> 2, wc = wid & 3, fr = lane & 15, fq = lane >> 4;
    const int K = g.K, nt = K / BK;
    unsigned voffA[2], voffB[2];
#pragma unroll
    for (int i = 0; i < 2; ++i) { int R, C; stage_rc(tid * 16 + i * 8192, R, C); const int Rb = Epi::PERM ? ((R & ~31) + perm32(R & 31)) : R;
        voffA[i] = (unsigned)(R * g.lda + C) * 2u; voffB[i] = (unsigned)(Rb * g.ldb + C) * 2u; }
    const size_t kstep = (size_t)(BK * 2);
    const size_t hstepA = (size_t)HALF * g.lda * 2, hstepB = (size_t)HALF * g.ldb * 2;
    const size_t tstepA = 2 * hstepA, tstepB = 2 * hstepB;
    const size_t pnA = (size_t)g.a_pn_cols * 2;
    const unsigned ldsw = (unsigned)wid * 1024u;
    const int aoff = lds_byte(wr * 64 + fr, fq * 8), boff = lds_byte(wc * 32 + fr, fq * 8);
#define PG8_SA(b, h) (((b) * 2 + (h)) * HTB)
#define PG8_SB(b, h) ((4 + (b) * 2 + (h)) * HTB)
#define PG8_STAGE(bufoff, gbase, voff) do { _Pragma("unroll") for (int _i = 0; _i < 2; ++_i) \
        __builtin_amdgcn_global_load_lds((const unsigned*)((const char*)(gbase) + (voff)[_i]), (PG8_LAS unsigned*)(lds + (bufoff) + ldsw + _i * 8192), 16, 0, 0); } while (0)
#define PG8_LDA(dst, b, h) do { _Pragma("unroll") for (int m = 0; m < 4; ++m) _Pragma("unroll") for (int k = 0; k < 2; ++k) dst[m][k] = *(const PG8_LAS bf16x8*)(lds + PG8_SA(b, h) + aoff + m * 2048 + k * 1024); } while (0)
#define PG8_LDB(dst, b, h) do { _Pragma("unroll") for (int n = 0; n < 2; ++n) _Pragma("unroll") for (int k = 0; k < 2; ++k) dst[n][k] = *(const PG8_LAS bf16x8*)(lds + PG8_SB(b, h) + boff + n * 2048 + k * 1024); } while (0)
#define PG8_MMA(ai, bj, At, Bt) do { __builtin_amdgcn_s_setprio(1); _Pragma("unroll") for (int m = 0; m < 4; ++m) _Pragma("unroll") for (int n = 0; n < 2; ++n) _Pragma("unroll") for (int k = 0; k < 2; ++k) \
        acc[ai][bj][m][n] = __builtin_amdgcn_mfma_f32_16x16x32_bf16(Bt[n][k], At[m][k], acc[ai][bj][m][n], 0, 0, 0); __builtin_amdgcn_s_setprio(0); } while (0)
#define PG8_WAIT_V(n) asm volatile("s_waitcnt vmcnt(" #n ")" ::: "memory")
#define PG8_WAIT_L(n) asm volatile("s_waitcnt lgkmcnt(" #n ")" ::: "memory")
#define PG8_BAR __builtin_amdgcn_s_barrier()
#define PG8_SCHED __builtin_amdgcn_sched_barrier(0)
    Unit cur, nxt; int ui = 0;
    if (!S.next(0, cur)) return;
    f32x4 acc[2][2][4][2];
#pragma unroll
    for (int a = 0; a < 2; ++a)
#pragma unroll
        for (int b = 0; b < 2; ++b)
#pragma unroll
            for (int m = 0; m < 4; ++m)
#pragma unroll
                for (int n = 0; n < 2; ++n) acc[a][b][m][n] = (f32x4){0.f, 0.f, 0.f, 0.f};
    bf16x8 At[4][2], B0[2][2], B1[2][2];
    const char* cA = (const char*)g.A + (size_t)cur.pm * tstepA + (size_t)cur.pn * pnA; const char* cB = (const char*)g.Bt + (size_t)cur.pn * tstepB;
    S.a_ready(cur);
    if constexpr (SP2) {
        PG8_STAGE(PG8_SB(0, 0), cB, voffB); PG8_STAGE(PG8_SB(0, 1), cB + hstepB, voffB); PG8_STAGE(PG8_SA(0, 0), cA, voffA); PG8_STAGE(PG8_SA(0, 1), cA + hstepA, voffA);
        if (wr == 1) PG8_BAR;
        PG8_WAIT_V(2); PG8_BAR;
        PG8_STAGE(PG8_SB(1, 0), cB + kstep, voffB); PG8_STAGE(PG8_SA(1, 0), cA + kstep, voffA); PG8_STAGE(PG8_SB(1, 1), cB + hstepB + kstep, voffB);
        PG8_WAIT_V(6); PG8_BAR;
    } else {
        PG8_STAGE(PG8_SB(0, 0), cB, voffB); PG8_STAGE(PG8_SA(0, 0), cA, voffA); PG8_STAGE(PG8_SB(0, 1), cB + hstepB, voffB); PG8_STAGE(PG8_SA(0, 1), cA + hstepA, voffA);
        if (wr == 1) PG8_BAR;
        PG8_WAIT_V(4); PG8_BAR;
        PG8_STAGE(PG8_SB(1, 0), cB + kstep, voffB); PG8_STAGE(PG8_SA(1, 0), cA + kstep, voffA); PG8_STAGE(PG8_SB(1, 1), cB + hstepB + kstep, voffB);
        PG8_WAIT_V(6); PG8_BAR;
    }
    for (;;) {
        const bool has_next = S.next(ui + 1, nxt);
        const char* nA = has_next ? (const char*)g.A + (size_t)nxt.pm * tstepA + (size_t)nxt.pn * pnA : cA; const char* nB = has_next ? (const char*)g.Bt + (size_t)nxt.pn * tstepB : cB;
        for (int t = 0; t < nt; t += 2) {
            const bool last = (t == nt - 2);
            const char* a1 = cA + (size_t)(t + 1) * kstep;
            const char* a2 = last ? nA : cA + (size_t)(t + 2) * kstep; const char* b2 = last ? nB : cB + (size_t)(t + 2) * kstep;
            const char* a3 = a2 + kstep; const char* b3 = b2 + kstep;
            if (last && has_next) S.a_ready(nxt);
            if constexpr (SP2) {
            PG8_LDB(B0, 0, 0); PG8_LDB(B1, 0, 1); PG8_SCHED; PG8_LDA(At, 0, 0); PG8_STAGE(PG8_SA(1, 1), a1 + hstepA, voffA);
            PG8_WAIT_V(8); PG8_WAIT_L(0); PG8_BAR; PG8_MMA(0, 0, At, B0); PG8_MMA(0, 1, At, B1); PG8_BAR; PG8_SCHED;
            PG8_LDA(At, 0, 1); PG8_STAGE(PG8_SB(0, 0), b2, voffB); PG8_STAGE(PG8_SB(0, 1), b2 + hstepB, voffB); PG8_STAGE(PG8_SA(0, 0), a2, voffA);
            PG8_WAIT_V(8); PG8_WAIT_L(0); PG8_BAR; PG8_MMA(1, 0, At, B0); PG8_MMA(1, 1, At, B1); PG8_BAR; PG8_SCHED;
            PG8_LDB(B0, 1, 0); PG8_LDB(B1, 1, 1); PG8_SCHED; PG8_LDA(At, 1, 0); PG8_STAGE(PG8_SA(0, 1), a2 + hstepA, voffA);
            PG8_WAIT_V(8); PG8_WAIT_L(0); PG8_BAR; PG8_MMA(0, 0, At, B0); PG8_MMA(0, 1, At, B1); PG8_BAR; PG8_SCHED;
            PG8_LDA(At, 1, 1); PG8_STAGE(PG8_SB(1, 0), b3, voffB); PG8_STAGE(PG8_SB(1, 1), b3 + hstepB, voffB); PG8_STAGE(PG8_SA(1, 0), a3, voffA);
            PG8_WAIT_V(8); PG8_WAIT_L(0); PG8_BAR; PG8_MMA(1, 0, At, B0); PG8_MMA(1, 1, At, B1); PG8_BAR; PG8_SCHED;
            } else {
            PG8_LDB(B0, 0, 0); PG8_SCHED; PG8_LDA(At, 0, 0); PG8_STAGE(PG8_SA(1, 1), a1 + hstepA, voffA);
            PG8_WAIT_L(8); PG8_BAR; PG8_WAIT_L(0); PG8_MMA(0, 0, At, B0); PG8_BAR; PG8_SCHED;
            PG8_LDB(B1, 0, 1); PG8_STAGE(PG8_SB(0, 0), b2, voffB);
            PG8_BAR; PG8_WAIT_L(0); PG8_MMA(0, 1, At, B1); PG8_BAR;
            PG8_LDA(At, 0, 1); PG8_STAGE(PG8_SA(0, 0), a2, voffA);
            PG8_BAR; PG8_WAIT_L(0); PG8_MMA(1, 0, At, B0); PG8_BAR; PG8_SCHED;
            PG8_STAGE(PG8_SB(0, 1), b2 + hstepB, voffB);
            PG8_WAIT_V(6); PG8_BAR; PG8_MMA(1, 1, At, B1); PG8_BAR;
            PG8_LDB(B0, 1, 0); PG8_SCHED; PG8_LDA(At, 1, 0); PG8_STAGE(PG8_SA(0, 1), a2 + hstepA, voffA);
            PG8_WAIT_L(8); PG8_BAR; PG8_WAIT_L(0); PG8_MMA(0, 0, At, B0); PG8_BAR; PG8_SCHED;
            PG8_LDB(B1, 1, 1); PG8_STAGE(PG8_SB(1, 0), b3, voffB);
            PG8_BAR; PG8_WAIT_L(0); PG8_MMA(0, 1, At, B1); PG8_BAR;
            PG8_LDA(At, 1, 1); PG8_STAGE(PG8_SA(1, 0), a3, voffA);
            PG8_BAR; PG8_WAIT_L(0); PG8_MMA(1, 0, At, B0); PG8_BAR; PG8_SCHED;
            PG8_STAGE(PG8_SB(1, 1), b3 + hstepB, voffB);
            PG8_WAIT_V(6); PG8_BAR; PG8_MMA(1, 1, At, B1); PG8_BAR;
            }
        }
        if constexpr (ALIGN_EPI) { if (wr == 0) PG8_BAR; }
        if constexpr (!Epi::AFTER_DRAIN) { int le = lane; asm volatile("" : "+v"(le)); E(acc, cur, wr, wc, le & 15, le >> 4); S.done(cur); }
        if (!has_next) break;
#pragma unroll
        for (int a = 0; a < 2; ++a)
#pragma unroll
            for (int b = 0; b < 2; ++b)
#pragma unroll
                for (int m = 0; m < 4; ++m)
#pragma unroll
                    for (int n = 0; n < 2; ++n) acc[a][b][m][n] = (f32x4){0.f, 0.f, 0.f, 0.f};
        cur = nxt; cA = nA; cB = nB; ++ui;
        if constexpr (ALIGN_EPI) { if (wr == 1) PG8_BAR; }
    }
    PG8_WAIT_V(0);
    if constexpr (!ALIGN_EPI) { if (wr == 0) PG8_BAR; }
    PG8_BAR;
#undef PG8_SA
#undef PG8_SB
#undef PG8_STAGE
#undef PG8_LDA
#undef PG8_LDB
#undef PG8_MMA
#undef PG8_WAIT_V
#undef PG8_WAIT_L
#undef PG8_BAR
#undef PG8_SCHED
}
}

#define GAS __attribute__((address_space(1)))
#define LAS __attribute__((address_space(3)))
typedef unsigned short bf16;
typedef unsigned v4u __attribute__((ext_vector_type(4)));
typedef unsigned v2u __attribute__((ext_vector_type(2)));
typedef float f32x4 __attribute__((ext_vector_type(4)));
typedef float f32x2 __attribute__((ext_vector_type(2)));
typedef float f32x16 __attribute__((ext_vector_type(16)));
typedef short bf16x8 __attribute__((ext_vector_type(8)));
typedef short s16x4 __attribute__((ext_vector_type(4)));
typedef GAS unsigned gu32;
#define RLX_AGENT __ATOMIC_RELAXED, __HIP_MEMORY_SCOPE_AGENT
#define LDS_WAIT() asm volatile("s_waitcnt lgkmcnt(0)" ::: "memory")
#define VM_WAIT() asm volatile("s_waitcnt vmcnt(0)" ::: "memory")
__device__ __forceinline__ unsigned f2bf(float f) { unsigned u = __builtin_bit_cast(unsigned, f); return (u + 0x7fffu + ((u >> 16) & 1u)) >> 16; }
__device__ __forceinline__ unsigned pk2(float lo, float hi) { return f2bf(lo) | (f2bf(hi) << 16); }
__device__ __forceinline__ float bf2f(unsigned short b) { return __builtin_bit_cast(float, (unsigned)b << 16); }

constexpr int NWAVES = 8;
constexpr size_t MiB = 1u << 20;
constexpr size_t WS_CTL = 0, CTL_ZERO_BYTES = 64 * 1024;
constexpr size_t WS_ROPE = 1 * MiB;
constexpr size_t WS_SSQ = 2 * MiB;
constexpr size_t WS_WQKV = 4 * MiB, WS_WO = 7 * MiB, WS_WPOOL = 9 * MiB;
constexpr size_t WS_W1 = 10 * MiB, W1_BYTES = (size_t)2 * DFF * DM * 2;
constexpr size_t WS_W2 = 54 * MiB, W2_BYTES = (size_t)DM * DFF * 2;
constexpr size_t WS_XB = 76 * MiB;
constexpr size_t WS_H = 110 * MiB;
constexpr size_t WS_P = WS_H, WS_Q = WS_H, WS_O = WS_H + 34 * MiB, WS_K = WS_H + 68 * MiB, WS_V = WS_H + 77 * MiB;
constexpr size_t WS_END = 204 * MiB;
static_assert(WS_W1 + 4 * W1_BYTES <= WS_W2 && WS_W2 + 4 * W2_BYTES <= WS_XB && WS_XB + (size_t)MT * DM * 2 <= WS_H && WS_H + (size_t)MT * DFF * 2 <= WS_END, "ws map");
static_assert(WS_V + (size_t)MT * KVD * 2 <= WS_END && WS_K + (size_t)MT * KVD * 2 <= WS_V && WS_O + (size_t)MT * DM * 2 <= WS_K, "ws map 2");
constexpr int CW_BAR = 4096;
constexpr int RING_OFF = 0, RING_BYTES = 131072;
constexpr int LDSCTL_OFF = RING_BYTES, MISC_OFF = LDSCTL_OFF + 320;
constexpr int LDS_BYTES = 147456;

#define XB_TMO      128
#define XB_XCNT(j)  (256  + 64 * (j))
#define XB_XSUB(j)  (1280 + 64 * (j))
#define XB_XGEN(j)  (2304 + 64 * (j))
#define XB_TOP      3328
#define XB_TOPGEN   3392
#define XCD_BAR_WORDS 3456
#define XB_SPIN_CAP (1u << 18)
__device__ __forceinline__ unsigned xb_ld(unsigned* p)              { return __hip_atomic_load(p, __ATOMIC_RELAXED, __HIP_MEMORY_SCOPE_AGENT); }
__device__ __forceinline__ unsigned xb_add(unsigned* p, unsigned v) { return __hip_atomic_fetch_add(p, v, __ATOMIC_RELAXED, __HIP_MEMORY_SCOPE_AGENT); }
__device__ __forceinline__ unsigned xb_xcc_id() { return (unsigned)__builtin_amdgcn_s_getreg((3 << 11) | 20) & 0xFu; }
#define XB_SPIN(cond, bar) do { unsigned _sp = 0; while (cond) { __builtin_amdgcn_s_sleep(1); \
    if ((++_sp & 255u) == 0u) { if (xb_ld(&(bar)[XB_TMO])) break; if (_sp > XB_SPIN_CAP) { atomicAdd(&(bar)[XB_TMO], 1u); break; } } } } while (0)
struct XcdBarrier { unsigned* bar; unsigned x; volatile LAS unsigned* st; };
__device__ __forceinline__ XcdBarrier xcd_barrier_post(unsigned* bar, volatile LAS unsigned* st) {
    XcdBarrier b; b.bar = bar; b.x = xb_xcc_id(); b.st = st;
    if (threadIdx.x == 0) (void)xb_add(&bar[XB_XCNT(b.x)], 1u);
    return b;
}
__device__ __forceinline__ void xcd_barrier_complete(unsigned* bar, unsigned x, unsigned& nloc, unsigned& nx) {
    const unsigned G = gridDim.x * gridDim.y * gridDim.z;
    unsigned sum, cnt, mine, sp = 0u;
    for (;;) {
        sum = 0u; cnt = 0u; mine = 0u;
#pragma unroll
        for (unsigned j = 0; j < 16; ++j) { const unsigned c = xb_ld(&bar[XB_XCNT(j)]); sum += c; cnt += (c > 0u) ? 1u : 0u; mine = (j == x) ? c : mine; }
        if (sum == G) break;
        __builtin_amdgcn_s_sleep(1);
        if ((++sp & 255u) == 0u) { if (xb_ld(&bar[XB_TMO])) break; if (sp > XB_SPIN_CAP) { atomicAdd(&bar[XB_TMO], 1u); break; } }
    }
    nloc = mine > 0u ? mine : 1u; nx = cnt > 0u ? cnt : 1u;
}
__device__ __forceinline__ void xcd_barrier(const XcdBarrier& b) {
    asm volatile("s_waitcnt vmcnt(0)" ::: "memory");
    __syncthreads();
    if (threadIdx.x == 0) {
        unsigned* bar = b.bar;
        __builtin_amdgcn_s_waitcnt(0);
        unsigned nloc = b.st[0], nx = b.st[1];
        if (nloc == 0u) { xcd_barrier_complete(bar, b.x, nloc, nx); b.st[0] = nloc; b.st[1] = nx; }
        const unsigned old = xb_add(&bar[XB_XSUB(b.x)], 1u);
        const unsigned gen = old / nloc;
        if (old + 1u == (gen + 1u) * nloc) {
            __builtin_amdgcn_fence(__ATOMIC_RELEASE, "agent");
            asm volatile("s_waitcnt vmcnt(0)" ::: "memory");
            const unsigned og = xb_add(&bar[XB_TOP], 1u);
            const unsigned tg = og / nx;
            if (og + 1u == (tg + 1u) * nx) xb_add(&bar[XB_TOPGEN], 1u);
            else XB_SPIN(xb_ld(&bar[XB_TOPGEN]) == tg, bar);
            __builtin_amdgcn_fence(__ATOMIC_ACQUIRE, "agent");
            xb_add(&bar[XB_XGEN(b.x)], 1u);
            asm volatile("s_waitcnt vmcnt(0)" ::: "memory");
        } else {
            XB_SPIN(xb_ld(&bar[XB_XGEN(b.x)]) == gen, bar);
            __builtin_amdgcn_fence(__ATOMIC_ACQUIRE, "agent");
            asm volatile("s_waitcnt vmcnt(0)" ::: "memory");
        }
    }
    __syncthreads();
}

struct Frame {
    LAS unsigned char* lds;
    int tid, lane, wave, vcu, G;
};
__device__ __forceinline__ float wave_sum(float v) {
#pragma unroll
    for (int o = 1; o < 64; o <<= 1) v += __shfl_xor(v, o);
    return v;
}

__device__ __forceinline__ void transpose_item(const float* W, int ldw, bf16* WT, int K, int drow0, int scol0, int k0, const float* kscale, const float* nscale, float cscale, LAS float* scr, int lane) {
    const float ns = nscale ? nscale[drow0 + (lane & 31)] * cscale : cscale;
#pragma unroll 8
    for (int i = 0; i < 32; ++i) { const int kk = 2 * i + (lane >> 5); float w = W[(size_t)(k0 + kk) * ldw + scol0 + (lane & 31)] * ns; if (kscale) w *= kscale[k0 + kk]; scr[kk * 33 + (lane & 31)] = w; }
    LDS_WAIT(); asm volatile("" ::: "memory");
    const int c = lane & 7;
#pragma unroll
    for (int j = 0; j < 4; ++j) { const int n = (lane >> 3) + 8 * j; const LAS float* s = scr + (8 * c) * 33 + n;
        v4u o; o.x = pk2(s[0 * 33], s[1 * 33]); o.y = pk2(s[2 * 33], s[3 * 33]); o.z = pk2(s[4 * 33], s[5 * 33]); o.w = pk2(s[6 * 33], s[7 * 33]);
        *(GAS v4u*)(WT + (size_t)(drow0 + n) * K + k0 + 8 * c) = o; }
    LDS_WAIT(); asm volatile("" ::: "memory");
}
struct Ptrs {
    const float *xp, *xs, *spool, *ck, *cv, *n1, *w1in, *w1out, *nmix, *n2, *w2in, *w2out, *poolw, *pscale, *wqkv, *bqkv, *wo, *bo, *sinks, *nfin;
    float* out; unsigned char* ws;
};
__device__ __forceinline__ void p0_prologue(const Frame& F, const Ptrs& P) {
    LAS float* scr = (LAS float*)(F.lds + RING_OFF + F.wave * 16384);
    const int gw = F.vcu * NWAVES + F.wave, NGW = F.G * NWAVES;
    constexpr int I_W1 = (DM / 64) * (2 * DFF / 32), I_W2 = (DFF / 64) * (DM / 32), I_FFN = I_W1 + I_W2;
    constexpr int I_QKV = (DM / 64) * (QKVN / 32), I_WO = (DM / 64) * (DM / 32), I_POOL = 4 * 4 * 8;
    constexpr int NITEMS = 4 * I_FFN + I_QKV + I_WO + I_POOL;
    for (int it = gw; it < NITEMS; it += NGW) {
        int r = it;
        if (r < 4 * I_FFN) {
            const int f = r / I_FFN; r -= f * I_FFN; const int layer = f >> 1, second = f & 1;
            const float* win = (second ? P.w2in : P.w1in) + (size_t)layer * DM * 2 * DFF;
            const float* wout = (second ? P.w2out : P.w1out) + (size_t)layer * DFF * DM;
            const float* gn = (second ? P.n2 : P.n1) + layer * DM;
            if (r < I_W1) { const int nblk = 2 * DFF / 32, kb = r / nblk, nb = r % nblk, j = 32 * nb;
                const int scol = ((j >> 7) & 1) * DFF + (j >> 8) * 128 + (j & 127);
                transpose_item(win, 2 * DFF, (bf16*)(P.ws + WS_W1 + f * W1_BYTES), DM, j, scol, 64 * kb, gn, nullptr, 1.0f, scr, F.lane);
            } else { r -= I_W1; const int nblk = DM / 32, kb = r / nblk, nb = r % nblk;
                transpose_item(wout, DM, (bf16*)(P.ws + WS_W2 + f * W2_BYTES), DFF, 32 * nb, 32 * nb, 64 * kb, nullptr, nullptr, 0.5f, scr, F.lane); }
            continue;
        }
        r -= 4 * I_FFN;
        if (r < I_QKV) { const int nblk = QKVN / 32, kb = r / nblk, nb = r % nblk, j = 32 * nb;
            const int scol = (j >> 8) * 256 + ((j >> 5) & 3) * 64 + ((j >> 7) & 1) * 32;
            transpose_item(P.wqkv, QKVN, (bf16*)(P.ws + WS_WQKV), DM, j, scol, 64 * kb, P.nmix + DM, nullptr, 1.0f, scr, F.lane); continue; }
        r -= I_QKV;
        if (r < I_WO) { const int nblk = DM / 32, kb = r / nblk, nb = r % nblk;
            transpose_item(P.wo, DM, (bf16*)(P.ws + WS_WO), DM, 32 * nb, 32 * nb, 64 * kb, nullptr, nullptr, 1.0f, scr, F.lane); continue; }
        r -= I_WO;
        { const int gi = r >> 5, kb = (r >> 3) & 3, nb = r & 7;
            transpose_item(P.poolw + (size_t)gi * 65536, 256, (bf16*)(P.ws + WS_WPOOL), 256, gi * 256 + 32 * nb, 32 * nb, 64 * kb, nullptr, P.pscale, 1.0f, scr, F.lane); }
    }
    {
        float* rope = (float*)(P.ws + WS_ROPE);
        const double r1 = 1.0 / sqrt(sqrt(sqrt(10.0)));
        for (int e = (F.vcu * NWAVES * 64) + F.tid; e < (TPS + TSS) * 32; e += F.G * NWAVES * 64) {
            const int pidx = e >> 5, d = e & 31; const int pos = pidx < TPS ? pidx : PAST + (pidx - TPS);
            double inv = 1.0; for (int i = 0; i < d; ++i) inv *= r1;
            double turns = (double)pos * inv * 0.15915494309189535; turns -= floor(turns);
            const float a = (float)(turns * 6.283185307179586);
            rope[2 * e] = cosf(a); rope[2 * e + 1] = sinf(a);
        }
    }
    {
        bf16* XB = (bf16*)(P.ws + WS_XB); float* SSQ = (float*)(P.ws + WS_SSQ);
        for (int m = gw; m < MT; m += NGW) {
            const float* xrow = (m < MP) ? P.xp + (size_t)m * DM : P.xs + (size_t)(m - MP) * DM;
            const GAS f32x4* xr = (const GAS f32x4*)xrow + F.lane;
            f32x4 v[4]; float s = 0.f;
#pragma unroll
            for (int j = 0; j < 4; ++j) { v[j] = xr[64 * j]; s += (v[j][0] * v[j][0] + v[j][1] * v[j][1]) + (v[j][2] * v[j][2] + v[j][3] * v[j][3]); }
            s = wave_sum(s);
            GAS unsigned long long* o8 = (GAS unsigned long long*)(XB + (size_t)m * DM) + F.lane;
#pragma unroll
            for (int j = 0; j < 4; ++j) o8[64 * j] = (unsigned long long)pk2(v[j][0], v[j][1]) | ((unsigned long long)pk2(v[j][2], v[j][3]) << 32);
            if (F.lane < 16) SSQ[(size_t)m * 16 + F.lane] = (F.lane == 0) ? s : 0.f;
        }
    }
}

template <int WG, int NROWS>
__device__ __forceinline__ void pool_rows(const float* X, int r0, int tpos0, const float* hist_raw  , bool hist_x, const LAS float* rs  ,
                                          f32x2 g, int c0, bf16* Pm, float* np_out  , int np_t0) {
    f32x2 h[16];
#pragma unroll
    for (int k = 0; k < 16; ++k) h[k] = (f32x2){0.f, 0.f};
    if (hist_x) {
#pragma unroll
        for (int k = 1; k < 16; ++k) { const f32x2 x = *(const f32x2*)(X + (size_t)(r0 - 16 + k) * DM + c0); h[k] = x * rs[k - 1] * g; }
    } else if (hist_raw) {
#pragma unroll
        for (int k = 1; k < 16; ++k) h[k] = *(const f32x2*)(hist_raw + (size_t)(k - 1) * DM + c0);
    }
    for (int blk = 0; blk < (NROWS + 15) / 16; ++blk) {
#pragma unroll
        for (int k = 0; k < 16; ++k) {
            if (blk * 16 + k < NROWS) {
                const int lr = blk * 16 + k, row = r0 + lr, tpos = tpos0 + lr;
                const f32x2 x = *(const f32x2*)(X + (size_t)row * DM + c0);
                const f32x2 u = x * rs[15 + lr] * g;
                h[k] = u;
                f32x2 s = u;
#pragma unroll
                for (int j = 1; j < WG; ++j) s += h[(k - j) & 15];
                const int cnt = (tpos + 1 < WG) ? tpos + 1 : WG;
                const f32x2 p = s * (1.0f / (float)cnt) - u;
                *(unsigned*)(Pm + (size_t)row * DM + c0) = pk2(p[0], p[1]);
                if (tpos >= np_t0) *(f32x2*)(np_out + (size_t)(tpos - np_t0) * DM + c0) = u;
            }
        }
    }
}
template <int NROWS>
__device__ __forceinline__ void pool_unit(const Frame& F, const Ptrs& P, int r0, int tpos0, const float* hist_raw, bool hist_x, float* np_out, int np_t0) {
    const float* X = P.out + O_Y; const float* SSQ = (const float*)(P.ws + WS_SSQ); bf16* Pm = (bf16*)(P.ws + WS_P);
    LAS float* rs = (LAS float*)(F.lds + RING_OFF);
    __syncthreads();
    if (F.tid < 15 + NROWS) { const int row = r0 - 15 + F.tid; rs[F.tid] = (F.tid >= 15 || hist_x) ? pg8::row_rstd(SSQ, row) : 0.f; }
    __syncthreads();
    const int c0 = 2 * F.tid; const f32x2 g = *(const f32x2*)(P.nmix + c0);
    const int gi = F.tid >> 7;
    if (gi == 0) pool_rows<2, NROWS>(X, r0, tpos0, hist_raw, hist_x, rs, g, c0, Pm, np_out, np_t0);
    else if (gi == 1) pool_rows<4, NROWS>(X, r0, tpos0, hist_raw, hist_x, rs, g, c0, Pm, np_out, np_t0);
    else if (gi == 2) pool_rows<8, NROWS>(X, r0, tpos0, hist_raw, hist_x, rs, g, c0, Pm, np_out, np_t0);
    else pool_rows<16, NROWS>(X, r0, tpos0, hist_raw, hist_x, rs, g, c0, Pm, np_out, np_t0);
}
__device__ __forceinline__ void pool_phase(const Frame& F, const Ptrs& P) {
    for (int u = F.vcu; u < MP / 64; u += F.G) {
        const int r0 = u * 64, b = r0 >> 11, t0 = r0 & (TPS - 1);
        pool_unit<64>(F, P, r0, t0, nullptr, t0 > 0, P.out + O_POOLP + (size_t)b * 15 * DM, TPS - 15);
    }
    for (int b = F.vcu; b < NSB; b += F.G) {
        const float* sp = P.spool + (size_t)b * 15 * DM; float* np = P.out + O_POOLS + (size_t)b * 15 * DM;
        for (int e = F.tid; e < 7 * DM / 4; e += NWAVES * 64) ((f32x4*)np)[e] = ((const f32x4*)(sp + 8 * DM))[e];
        pool_unit<8>(F, P, MP + b * TSS, PAST, sp, false, np, PAST - 7);
    }
}

namespace att {
constexpr int LDS_K = 0, LDS_V = 3 * 8192, LDS_WS = 6 * 8192, LDS_OST = LDS_WS + NWAVES * 256, LDS_TOTAL = LDS_OST + NWAVES * 4096;
__device__ __forceinline__ int crow(int r, int hi) { return (r & 3) + 8 * (r >> 2) + 4 * hi; }
__device__ __forceinline__ unsigned cvtpk_s(float lo, float hi) { typedef float f2 __attribute__((ext_vector_type(2))); typedef __bf16 b2 __attribute__((ext_vector_type(2))); f2 v = {lo, hi}; b2 b = __builtin_convertvector(v, b2); return __builtin_bit_cast(unsigned, b); }
typedef short v4i16_t __attribute__((ext_vector_type(4)));
__device__ __forceinline__ s16x4 vtr(const LAS unsigned char* p) { return __builtin_bit_cast(s16x4, __builtin_amdgcn_ds_read_tr16_b64_v4i16((LAS v4i16_t*)p)); }
constexpr float NEG = -1.0e30f;

struct Soft { v4u pa[5][2]; float l; };
__device__ __forceinline__ void softmax5(f32x16 (&sc)[5], float sk, Soft& R) {
    float m = sk;
#pragma unroll
    for (int i = 0; i < 5; ++i)
#pragma unroll
        for (int r = 0; r < 16; ++r) m = fmaxf(m, sc[i][r]);
    { auto rr = __builtin_amdgcn_permlane32_swap(__float_as_uint(m), __float_as_uint(m), false, false); m = fmaxf(__uint_as_float(rr[0]), __uint_as_float(rr[1])); }
    float l = 0.f;
#pragma unroll
    for (int i = 0; i < 5; ++i) {
#pragma unroll
        for (int r = 0; r < 16; ++r) { const float p = __builtin_amdgcn_exp2f(sc[i][r] - m); sc[i][r] = p; l += p; }
#pragma unroll
        for (int s = 0; s < 2; ++s) R.pa[i][s] = (v4u){cvtpk_s(sc[i][8 * s + 0], sc[i][8 * s + 1]), cvtpk_s(sc[i][8 * s + 2], sc[i][8 * s + 3]), cvtpk_s(sc[i][8 * s + 4], sc[i][8 * s + 5]), cvtpk_s(sc[i][8 * s + 6], sc[i][8 * s + 7])};
    }
    { auto rr = __builtin_amdgcn_permlane32_swap(__float_as_uint(l), __float_as_uint(l), false, false); l = __uint_as_float(rr[0]) + __uint_as_float(rr[1]); }
    R.l = l + __builtin_amdgcn_exp2f(sk - m);
}

__device__ __forceinline__ void prompt_unit(const Frame& F, int b, int kvh, int qb, const bf16* Q, const bf16* K, const bf16* V, bf16* O, const float* sinks) {
    const int lane = F.lane, wid = F.wave, r32 = lane & 31, hi = lane >> 5;
    LAS unsigned char* lds = F.lds + RING_OFF;
    const int q0 = qb * 64, jmin = (qb >= 2) ? 0 : 2 - qb;
    const long rowbase = (long)b * TPS;
    __syncthreads();
#pragma unroll
    for (int j = 0; j < 3; ++j) if (j >= jmin) {
        const long kr0 = rowbase + q0 - 128 + 64 * j;
        const v4u kv = *(const v4u*)(K + (kr0 + lane) * KVD + kvh * 64 + wid * 8);
        *(LAS v4u*)(lds + LDS_K + j * 8192 + wid * 1024 + lane * 16) = kv;
        const v4u vv = *(const v4u*)(V + (kr0 + 16 * (wid & 3) + (lane >> 2)) * KVD + kvh * 64 + (wid >> 2) * 32 + (lane & 3) * 8);
        *(LAS v4u*)(lds + LDS_V + j * 8192 + wid * 1024 + lane * 16) = vv;
    }
    const int g = wid >> 1, half = wid & 1, h = 4 * kvh + g;
    const bf16* Qw = Q + (rowbase + q0 + 32 * half) * DM + h * HD;
    bf16x8 qr[4];
#pragma unroll
    for (int d0 = 0; d0 < 4; ++d0) qr[d0] = *(const bf16x8*)(Qw + (long)r32 * DM + d0 * 16 + hi * 8);
    const float sk = sinks[h] * LOG2E;
    __syncthreads();
    f32x16 sc[5];
#pragma unroll
    for (int i = 0; i < 5; ++i) {
        const int kb = half + i, tile = kb >> 1, p = kb & 1;
        if (tile >= jmin) {
            const LAS unsigned char* kp = lds + LDS_K + tile * 8192 + p * 512 + hi * 1024 + r32 * 16;
            f32x16 a = {};
#pragma unroll
            for (int d0 = 0; d0 < 4; ++d0) a = __builtin_amdgcn_mfma_f32_32x32x16_bf16(*(const LAS bf16x8*)(kp + d0 * 2048), qr[d0], a, 0, 0, 0);
            sc[i] = a;
        } else {
#pragma unroll
            for (int r = 0; r < 16; ++r) sc[i][r] = NEG;
        }
    }
#pragma unroll
    for (int r = 0; r < 16; ++r) { const int kk = crow(r, hi); if (!(kk > r32)) sc[0][r] = NEG; if (!(kk <= r32)) sc[4][r] = NEG; }
    Soft S; softmax5(sc, sk, S);
    f32x16 o[2]; o[0] = f32x16{}; o[1] = f32x16{};
#pragma unroll
    for (int i = 0; i < 5; ++i) {
        const int kb = half + i, tile = kb >> 1, p = kb & 1;
        if (tile >= jmin) {
            const LAS unsigned char* vp = lds + LDS_V + tile * 8192 + ((lane >> 4) & 1) * 32 + (lane & 3) * 8 + (4 * hi + ((lane & 15) >> 2)) * 64;
#pragma unroll
            for (int s = 0; s < 2; ++s)
#pragma unroll
                for (int d0 = 0; d0 < 2; ++d0) {
                    const s16x4 lo = vtr(vp + d0 * 4096 + (2 * p + s) * 1024), hh = vtr(vp + d0 * 4096 + (2 * p + s) * 1024 + 512);
                    const bf16x8 vf = (bf16x8){lo[0], lo[1], lo[2], lo[3], hh[0], hh[1], hh[2], hh[3]};
                    o[d0] = __builtin_amdgcn_mfma_f32_32x32x16_bf16(__builtin_bit_cast(bf16x8, S.pa[i][s]), vf, o[d0], 0, 0, 0);
                }
        }
    }
    LAS float* wsf = (LAS float*)(lds + LDS_WS) + wid * 64;
    if (hi == 0) wsf[r32] = S.l;
    LDS_WAIT();
    LAS bf16* stg = (LAS bf16*)(lds + LDS_OST) + wid * 2048;
#pragma unroll
    for (int r = 0; r < 16; ++r) { const int orow = crow(r, hi); const float rl = __builtin_amdgcn_rcpf(wsf[orow]);
#pragma unroll
        for (int d0 = 0; d0 < 2; ++d0) stg[orow * 64 + d0 * 32 + r32] = (bf16)f2bf(o[d0][r] * rl); }
    LDS_WAIT();
    bf16* Ow = O + (rowbase + q0 + 32 * half) * DM + h * HD;
#pragma unroll
    for (int i = 0; i < 4; ++i) { const int row = i * 8 + (lane >> 3), ch = lane & 7; const v4u v = *(const LAS v4u*)(stg + row * 64 + ch * 8); *(v4u*)(Ow + (long)row * DM + ch * 8) = v; }
}

__device__ __forceinline__ void sample_unit(int lane, int b, int kvh, const bf16* Q, const bf16* Kn, const bf16* Vn, const float* ck, const float* cv, bf16* O, const float* sinks, LAS float* wsf) {
    const int r32 = lane & 31, hi = lane >> 5, qi = r32 & 7, h = 4 * kvh + (r32 >> 3);
    const long qrow = (long)MP + b * TSS + qi;
    bf16x8 qr[4];
#pragma unroll
    for (int d0 = 0; d0 < 4; ++d0) qr[d0] = *(const bf16x8*)(Q + qrow * DM + h * HD + d0 * 16 + hi * 8);
    const float sk = sinks[h] * LOG2E;
    f32x16 sc[5];
#pragma unroll
    for (int blk = 0; blk < 4; ++blk) {
        f32x16 a = {};
        const float* kp = ck + ((size_t)(b * 128 + 32 * blk + r32) * NKV + kvh) * HD + hi * 8;
#pragma unroll
        for (int d0 = 0; d0 < 4; ++d0) { const f32x4 x0 = *(const f32x4*)(kp + d0 * 16), x1 = *(const f32x4*)(kp + d0 * 16 + 4);
            const v4u kw = (v4u){cvtpk_s(x0[0], x0[1]), cvtpk_s(x0[2], x0[3]), cvtpk_s(x1[0], x1[1]), cvtpk_s(x1[2], x1[3])};
            a = __builtin_amdgcn_mfma_f32_32x32x16_bf16(__builtin_bit_cast(bf16x8, kw), qr[d0], a, 0, 0, 0); }
        sc[blk] = a;
    }
    {
        f32x16 a = {};
        const bf16* kp = Kn + ((long)MP + b * TSS + (r32 & 7)) * KVD + kvh * HD + hi * 8;
#pragma unroll
        for (int d0 = 0; d0 < 4; ++d0) { v4u kw = *(const v4u*)(kp + d0 * 16); if (r32 >= 8) kw = (v4u){0u, 0u, 0u, 0u};
            a = __builtin_amdgcn_mfma_f32_32x32x16_bf16(__builtin_bit_cast(bf16x8, kw), qr[d0], a, 0, 0, 0); }
        sc[4] = a;
    }
#pragma unroll
    for (int blk = 0; blk < 5; ++blk)
#pragma unroll
        for (int r = 0; r < 16; ++r) { const int j = 32 * blk + crow(r, hi); if (!(j >= qi + 1 && j <= 128 + qi)) sc[blk][r] = NEG; }
    Soft S; softmax5(sc, sk, S);
    f32x16 o[2]; o[0] = f32x16{}; o[1] = f32x16{};
#pragma unroll
    for (int blk = 0; blk < 4; ++blk)
#pragma unroll
        for (int s = 0; s < 2; ++s)
#pragma unroll
            for (int d0 = 0; d0 < 2; ++d0) {
                float vv[8];
#pragma unroll
                for (int jj = 0; jj < 8; ++jj) { const int key = 32 * blk + 16 * s + 8 * (jj >> 2) + 4 * hi + (jj & 3); vv[jj] = cv[((size_t)(b * 128 + key) * NKV + kvh) * HD + d0 * 32 + r32]; }
                const v4u vw = (v4u){cvtpk_s(vv[0], vv[1]), cvtpk_s(vv[2], vv[3]), cvtpk_s(vv[4], vv[5]), cvtpk_s(vv[6], vv[7])};
                o[d0] = __builtin_amdgcn_mfma_f32_32x32x16_bf16(__builtin_bit_cast(bf16x8, S.pa[blk][s]), __builtin_bit_cast(bf16x8, vw), o[d0], 0, 0, 0);
            }
#pragma unroll
    for (int d0 = 0; d0 < 2; ++d0) {
        unsigned short e[4];
#pragma unroll
        for (int jj = 0; jj < 4; ++jj) e[jj] = Vn[((long)MP + b * TSS + 4 * hi + jj) * KVD + kvh * HD + d0 * 32 + r32];
        const v4u vw = (v4u){(unsigned)e[0] | ((unsigned)e[1] << 16), (unsigned)e[2] | ((unsigned)e[3] << 16), 0u, 0u};
        o[d0] = __builtin_amdgcn_mfma_f32_32x32x16_bf16(__builtin_bit_cast(bf16x8, S.pa[4][0]), __builtin_bit_cast(bf16x8, vw), o[d0], 0, 0, 0);
    }
    if (hi == 0) wsf[r32] = S.l;
    LDS_WAIT();
#pragma unroll
    for (int r = 0; r < 16; ++r) { const int q = crow(r, hi); const float rl = __builtin_amdgcn_rcpf(wsf[q]);
        bf16* orow = O + ((long)MP + b * TSS + (q & 7)) * DM + (4 * kvh + (q >> 3)) * HD + r32;
#pragma unroll
        for (int d0 = 0; d0 < 2; ++d0) orow[d0 * 32] = (bf16)f2bf(o[d0][r] * rl); }
    LDS_WAIT();
}

__device__ __forceinline__ void attn_phase(const Frame& F, const Ptrs& P) {
    const bf16* Q = (const bf16*)(P.ws + WS_Q); const bf16* K = (const bf16*)(P.ws + WS_K); const bf16* V = (const bf16*)(P.ws + WS_V); bf16* O = (bf16*)(P.ws + WS_O);
    constexpr int NPU = NPB * NKV * 32;
    const int per = (NPU + F.G - 1) / F.G;
    for (int i = 0; i < per; ++i) { const int u = F.vcu * per + i; if (u < NPU) prompt_unit(F, u >> 7, (u >> 5) & 3, u & 31, Q, K, V, O, P.sinks); }
    __syncthreads();
    LAS float* wsf = (LAS float*)(F.lds + RING_OFF + LDS_WS) + F.wave * 64;
    const int gw = F.vcu * NWAVES + F.wave, NGW = F.G * NWAVES;
    for (int u = gw; u < NSB * NKV; u += NGW) sample_unit(F.lane, u >> 2, u & 3, Q, K, V, P.ck, P.cv, O, P.sinks, wsf);
    {
        constexpr int PER_B = 120 * KVD / 4;
        const int gt = F.vcu * NWAVES * 64 + F.tid, NT = F.G * NWAVES * 64;
        for (int e = gt; e < 2 * NSB * PER_B; e += NT) {
            const int which = e / (NSB * PER_B), r = e - which * (NSB * PER_B), b = r / PER_B, w = r - b * PER_B;
            const f32x4* src = (const f32x4*)(which ? P.cv : P.ck) + (size_t)b * (128 * KVD / 4) + (8 * KVD / 4) + w;
            f32x4* dst = (f32x4*)(P.out + (which ? O_VS : O_KS)) + (size_t)b * (128 * KVD / 4) + w;
            *dst = *src;
        }
    }
}
}

__device__ __forceinline__ void final_phase(const Frame& F, const Ptrs& P) {
    float* X = P.out + O_Y; const float* SSQ = (const float*)(P.ws + WS_SSQ);
    const int gw = F.vcu * NWAVES + F.wave, NGW = F.G * NWAVES;
    f32x4 gv[4];
#pragma unroll
    for (int j = 0; j < 4; ++j) gv[j] = ((const f32x4*)P.nfin)[64 * j + F.lane];
    for (int m = gw; m < MT; m += NGW) {
        const float rs = pg8::row_rstd(SSQ, m);
        f32x4* xr = (f32x4*)(X + (size_t)m * DM) + F.lane;
#pragma unroll
        for (int j = 0; j < 4; ++j) xr[64 * j] = xr[64 * j] * rs * gv[j];
    }
}

constexpr int NPHASES = 15;
struct Args { const float* in[20]; float* out; unsigned char* ws; int ph_lo, ph_hi; };
__global__ void __launch_bounds__(NWAVES * 64, 2) mk_fwd(Args args) {
    extern __shared__ __attribute__((aligned(16))) unsigned char lds_raw[];
    {
        LAS unsigned char* l0 = (LAS unsigned char*)lds_raw;
        for (int u = threadIdx.x; u < (LDS_BYTES - LDSCTL_OFF) / 4; u += NWAVES * 64) ((LAS unsigned*)(l0 + LDSCTL_OFF))[u] = 0u;
        __syncthreads();
    }
    const int lo = args.ph_lo, hi = args.ph_hi;
    XcdBarrier bar; bar.bar = (unsigned*)(args.ws + WS_CTL) + CW_BAR; bar.x = 0; bar.st = nullptr;
    if (hi - lo > 1) bar = xcd_barrier_post((unsigned*)(args.ws + WS_CTL) + CW_BAR, (volatile LAS unsigned*)((LAS unsigned char*)lds_raw + MISC_OFF) + 8);
    for (int ph = lo; ph < hi; ++ph) {
        int tid = threadIdx.x; asm volatile("" : "+v"(tid));
        int bx = blockIdx.x, G = gridDim.x; asm volatile("" : "+s"(bx), "+s"(G));
        const __attribute__((address_space(4))) Args* ap = (const __attribute__((address_space(4))) Args*)__builtin_amdgcn_kernarg_segment_ptr(); asm volatile("" : "+s"(ap));
        Frame F;
        F.lds = (LAS unsigned char*)lds_raw;
        F.tid = tid; F.lane = tid & 63; F.wave = __builtin_amdgcn_readfirstlane(tid >> 6);
        F.G = G; F.vcu = (G % 8 == 0) ? (bx % 8) * (G / 8) + bx / 8 : bx;
        Ptrs P;
        P.xp = ap->in[0]; P.xs = ap->in[1]; P.spool = ap->in[2]; P.ck = ap->in[3]; P.cv = ap->in[4]; P.n1 = ap->in[5]; P.w1in = ap->in[6]; P.w1out = ap->in[7];
        P.nmix = ap->in[8]; P.n2 = ap->in[9]; P.w2in = ap->in[10]; P.w2out = ap->in[11]; P.poolw = ap->in[12]; P.pscale = ap->in[13]; P.wqkv = ap->in[14]; P.bqkv = ap->in[15];
        P.wo = ap->in[16]; P.bo = ap->in[17]; P.sinks = ap->in[18]; P.nfin = ap->in[19]; P.out = ap->out; P.ws = ap->ws;
        unsigned char* ws = P.ws;
        bf16* XB = (bf16*)(ws + WS_XB); bf16* Hb = (bf16*)(ws + WS_H); float* SSQ = (float*)(ws + WS_SSQ);
        float* X = P.out + O_Y;
        if (ph == 0 && (PHMASK & 1)) {
            p0_prologue(F, P);
        } else if ((ph == 1 || ph == 5 || ph == 7 || ph == 12) && (PHMASK & 2)) {
            const int f = (ph == 1) ? 0 : (ph == 5) ? 1 : (ph == 7) ? 2 : 3;
            pg8::Gemm g{XB, (const bf16*)(ws + WS_W1 + f * W1_BYTES), MT, 2 * DFF, DM, DM, DM, 0};
            pg8::StaticOrder S; S.init(MT, 2 * DFF, F.G, bx);
            pg8::EpiSwiglu E{Hb, SSQ};
            pg8::gemm_phase<pg8::EpiSwiglu, pg8::StaticOrder, true, true>(F.lds + RING_OFF, g, S, E, F.tid);
        } else if ((ph == 2 || ph == 6 || ph == 8 || ph == 13 || ph == 4 || ph == 11) && (PHMASK & 4)) {
            pg8::Gemm g; pg8::EpiRes E;
            E.xold_lo = X; E.xold_hi = X + (size_t)MP * DM; E.xnew = X; E.xb = XB; E.ssq = SSQ; E.bias = nullptr;
            if (ph == 4) { g = pg8::Gemm{(const bf16*)(ws + WS_P), (const bf16*)(ws + WS_WPOOL), MT, DM, 256, DM, 256, 256}; }
            else if (ph == 11) { g = pg8::Gemm{(const bf16*)(ws + WS_O), (const bf16*)(ws + WS_WO), MT, DM, DM, DM, DM, 0}; E.bias = P.bo; }
            else { const int f = (ph == 2) ? 0 : (ph == 6) ? 1 : (ph == 8) ? 2 : 3;
                g = pg8::Gemm{Hb, (const bf16*)(ws + WS_W2 + f * W2_BYTES), MT, DM, DFF, DFF, DFF, 0};
                if (ph == 2) { E.xold_lo = P.xp; E.xold_hi = P.xs; } }
            pg8::StaticOrder S; S.init(MT, DM, F.G, bx);
            pg8::gemm_phase<pg8::EpiRes, pg8::StaticOrder, true, true>(F.lds + RING_OFF, g, S, E, F.tid);
        } else if (ph == 3 && (PHMASK & 8)) {
            pool_phase(F, P);
        } else if (ph == 9 && (PHMASK & 16)) {
            pg8::Gemm g{XB, (const bf16*)(ws + WS_WQKV), MT, QKVN, DM, DM, DM, 0};
            pg8::StaticOrder S; S.init(MT, QKVN, F.G, bx);
            pg8::EpiQKV E{(bf16*)(ws + WS_Q), (bf16*)(ws + WS_K), (bf16*)(ws + WS_V), SSQ, P.bqkv, (const float*)(ws + WS_ROPE), P.out};
            pg8::gemm_phase<pg8::EpiQKV, pg8::StaticOrder, true, true>(F.lds + RING_OFF, g, S, E, F.tid);
        } else if (ph == 10 && (PHMASK & 32)) {
            att::attn_phase(F, P);
        } else if (ph == 14 && (PHMASK & 64)) {
            final_phase(F, P);
        }
        if (ph + 1 < hi) { XcdBarrier b2 = bar; unsigned* bb = bar.bar; asm volatile("" : "+s"(bb)); b2.bar = bb; xcd_barrier(b2); }
    }
}

extern "C" void kernel_launch(void* const* d_in, const int* in_sizes, int n_in, void* d_out, int out_size, void* d_ws, size_t ws_size, hipStream_t stream) {
    static int grid = 0;
    if (grid == 0) {
        if (n_in != 20 || (size_t)out_size != O_END || ws_size < WS_END) { fprintf(stderr, "kernel_launch: unexpected shapes (n_in %d out %d ws %zu)\n", n_in, out_size, ws_size); grid = -1; return; }
        int dev = 0, cus = 0, per_cu = 0;
        if (hipGetDevice(&dev) != hipSuccess || hipDeviceGetAttribute(&cus, hipDeviceAttributeMultiprocessorCount, dev) != hipSuccess) { grid = -1; return; }
        if (hipFuncSetAttribute((const void*)mk_fwd, hipFuncAttributeMaxDynamicSharedMemorySize, LDS_BYTES) != hipSuccess) { fprintf(stderr, "kernel_launch: hipFuncSetAttribute failed\n"); grid = -1; return; }
        if (hipOccupancyMaxActiveBlocksPerMultiprocessor(&per_cu, (const void*)mk_fwd, NWAVES * 64, LDS_BYTES) != hipSuccess || per_cu < 1)
            fprintf(stderr, "kernel_launch: occupancy query reports %d workgroups per CU\n", per_cu);
        (void)hipGetLastError();
        grid = cus;
    }
    if (grid < 0) return;
    (void)hipMemsetAsync((char*)d_ws + WS_CTL, 0, CTL_ZERO_BYTES, stream);
    Args a{};
    for (int i = 0; i < 20; ++i) a.in[i] = (const float*)d_in[i];
    a.out = (float*)d_out; a.ws = (unsigned char*)d_ws;
#if MK_ONE_LAUNCH
    a.ph_lo = 0; a.ph_hi = NPHASES;
    hipLaunchKernelGGL(mk_fwd, dim3(grid), dim3(NWAVES * 64), LDS_BYTES, stream, a);
#else
    for (int ph = 0; ph < NPHASES; ++ph) { a.ph_lo = ph; a.ph_hi = ph + 1; hipLaunchKernelGGL(mk_fwd, dim3(grid), dim3(NWAVES * 64), LDS_BYTES, stream, a); }
#endif
}
```

```cpp
#include <hip/hip_runtime.h>
#include <cstdio>
#include <cstdint>

#ifndef PHMASK
#define PHMASK 255
#endif
#ifndef PROBE_NULL_EPI
#define PROBE_NULL_EPI 0
#endif
#ifndef DUP_MASK
#define DUP_MASK 0
#endif
#ifndef MK_ONE_LAUNCH
#define MK_ONE_LAUNCH 1
#endif

constexpr int DM = 1024, DFF = 2816, NPB = 8, TPS = 2048, MP = NPB * TPS, NSB = 128, TSS = 8, MS = NSB * TSS, MT = MP + MS;
constexpr int QKVN = 1536, NHEAD = 16, NKV = 4, HD = 64, KVD = 256;
constexpr int PAST = 8192;
constexpr float RMS_EPS = 1e-6f;
constexpr float LOG2E = 1.4426950408889634f;
constexpr float QSCALE = 0.125f * LOG2E;
constexpr size_t O_Y = 0;
constexpr size_t O_POOLP = (size_t)MT * DM;
constexpr size_t O_POOLS = O_POOLP + (size_t)NPB * 15 * DM;
constexpr size_t O_KP = O_POOLS + (size_t)NSB * 15 * DM;
constexpr size_t O_VP = O_KP + (size_t)NPB * 128 * KVD;
constexpr size_t O_KS = O_VP + (size_t)NPB * 128 * KVD;
constexpr size_t O_VS = O_KS + (size_t)NSB * 128 * KVD;
constexpr size_t O_END = O_VS + (size_t)NSB * 128 * KVD;

namespace pg8 {
#define PG8_LAS __attribute__((address_space(3)))
typedef unsigned short bf16_t;
typedef short bf16x8 __attribute__((ext_vector_type(8)));
typedef float f32x4 __attribute__((ext_vector_type(4)));
typedef float f32x2 __attribute__((ext_vector_type(2)));
typedef unsigned u32x4 __attribute__((ext_vector_type(4)));
typedef unsigned u32x2 __attribute__((ext_vector_type(2)));
constexpr int BM = 256, BK = 64, HALF = 128, HTB = HALF * BK * 2, STAGE_BYTES = 8 * HTB, NXCD = 8, WGM = 8;
constexpr int EPI_SCR_OFF = STAGE_BYTES + 4096;

__host__ __device__ __forceinline__ int lds_byte(int r, int c) { const int st = (r >> 4) * 2 + (c >> 5), rr = r & 15, cc = c & 31, ob = rr * 64 + cc * 2; return st * 1024 + (ob ^ (((ob >> 9) & 1) << 5)); }
__host__ __device__ __forceinline__ void stage_rc(int b, int& R, int& C) { const int st = b / 1024, sb = b % 1024, swz = sb ^ (((sb >> 9) & 1) << 5); R = (st >> 1) * 16 + swz / 64; C = (st & 1) * 32 + (swz % 64) / 2; }
__host__ __device__ __forceinline__ int perm32(int rho) { const int n = rho >> 4, i = rho & 15; return 8 * (i >> 2) + 4 * n + (i & 3); }

struct Unit { int pm, pn, ks; };
struct Gemm { const bf16_t* A; const bf16_t* Bt; int M, N, K, lda, ldb, a_pn_cols; };

struct StaticOrder {
    int nM, nN, nwg, G, c;
    __host__ __device__ void init(int M, int N, int G_, int c_) { nM = M / BM; nN = N / BM; nwg = nM * nN; G = G_; c = c_; }
    __host__ __device__ bool next(int i, Unit& u) const {
        const long L = (long)i * G + c; if (L >= nwg) return false;
        int wgid = (int)L; { const int q = nwg / NXCD, r = nwg % NXCD, xcd = wgid % NXCD, off = wgid / NXCD; wgid = (xcd < r ? xcd * (q + 1) : r * (q + 1) + (xcd - r) * q) + off; }
        const int nig = WGM * nN, gid = wgid / nig, fm = gid * WGM, gsz = (nM - fm) < WGM ? (nM - fm) : WGM;
        u.pm = fm + ((wgid % nig) % gsz); u.pn = (wgid % nig) / gsz; u.ks = 0; return true;
    }
    __device__ __forceinline__ void a_ready(const Unit&) const {}
    __device__ __forceinline__ void done(const Unit&) const {}
};

struct SplitOrder {
    int c, n;
    __device__ __forceinline__ bool next(int i, Unit& u) const { if (i > 0 || c >= n) return false; u.pm = 64 + ((c & 15) >> 2); u.pn = c & 3; u.ks = c >> 4; return true; }
    __device__ __forceinline__ void a_ready(const Unit&) const {}
    __device__ __forceinline__ void done(const Unit&) const {}
};

__device__ __forceinline__ unsigned cvt_pk_bf16(float lo, float hi) { unsigned r; asm volatile("v_cvt_pk_bf16_f32 %0, %1, %2" : "=v"(r) : "v"(lo), "v"(hi)); return r; }

__device__ __forceinline__ float xor_shfl(float v, int lane, int mask) { return __builtin_bit_cast(float, __builtin_amdgcn_ds_bpermute((lane ^ mask) << 2, __builtin_bit_cast(int, v))); }
__device__ __forceinline__ float rstd_of(const f32x4 a) { return 1.0f / sqrtf(((a[0] + a[1]) + (a[2] + a[3])) * (1.0f / DM) + RMS_EPS); }
__device__ __forceinline__ float row_rstd(const float* ssq, int row) { return rstd_of(*(const f32x4*)(ssq + (size_t)row * 4)); }

struct EpiSwiglu {
    static constexpr bool PERM = true, AFTER_DRAIN = false;
    bf16_t* H; const float* ssq;
    __device__ __forceinline__ void operator()(const f32x4 (&acc)[2][2][4][2], const Unit& u, int wr, int wc, int fr, int fq, PG8_LAS unsigned char* xl, int tid) const {
        if (H == nullptr) return;
        const int row0 = u.pm * BM + wr * 64 + fr, col0 = u.pn * HALF + wc * 32 + 8 * fq;
        f32x4 sq[2][4];
#pragma unroll
        for (int ai = 0; ai < 2; ++ai)
#pragma unroll
            for (int m = 0; m < 4; ++m) sq[ai][m] = *(const f32x4*)(ssq + (size_t)(row0 + ai * HALF + m * 16) * 4);
#pragma unroll
        for (int ai = 0; ai < 2; ++ai)
#pragma unroll
            for (int m = 0; m < 4; ++m) {
                const int row = row0 + ai * HALF + m * 16;
                const float rs = rstd_of(sq[ai][m]);
                unsigned w[4];
#pragma unroll
                for (int n = 0; n < 2; ++n) {
                    float o[4];
#pragma unroll
                    for (int i = 0; i < 4; ++i) { const float g = acc[ai][0][m][n][i] * rs, up = acc[ai][1][m][n][i] * rs;
                        const float e = __builtin_amdgcn_exp2f(-g * LOG2E); o[i] = g * __builtin_amdgcn_rcpf(1.0f + e) * up; }
                    w[2 * n] = cvt_pk_bf16(o[0], o[1]); w[2 * n + 1] = cvt_pk_bf16(o[2], o[3]);
                }
                *(u32x4*)(H + (size_t)row * DFF + col0) = (u32x4){w[0], w[1], w[2], w[3]};
            }
    }
};
struct EpiRes {
    static constexpr bool PERM = false, AFTER_DRAIN = false;
    const float* xold_lo; const float* xold_hi; float* xnew; bf16_t* xb; float* ssq; const float* bias; float accs;
    __device__ __forceinline__ void operator()(const f32x4 (&acc)[2][2][4][2], const Unit& u, int wr, int wc, int fr, int fq, PG8_LAS unsigned char* xl, int tid) const {
        if (xnew == nullptr) return;
        const int row0 = u.pm * BM + wr * 64 + fr, col0 = u.pn * BM + wc * 32 + 4 * fq;
        PG8_LAS float* scr = (PG8_LAS float*)xl;
        f32x4 bv[2][2];
#pragma unroll
        for (int bj = 0; bj < 2; ++bj)
#pragma unroll
            for (int n = 0; n < 2; ++n) bv[bj][n] = bias ? *(const f32x4*)(bias + col0 + bj * HALF + n * 16) : (f32x4){0.f, 0.f, 0.f, 0.f};
#pragma unroll
        for (int ai = 0; ai < 2; ++ai) {
            f32x4 xo[4][2][2];
#pragma unroll
            for (int m = 0; m < 4; ++m) {
                const int row = row0 + ai * HALF + m * 16;
                const float* xp = (row < MP) ? xold_lo + (size_t)row * DM + col0 : xold_hi + (size_t)(row - MP) * DM + col0;
#pragma unroll
                for (int bj = 0; bj < 2; ++bj)
#pragma unroll
                    for (int n = 0; n < 2; ++n) xo[m][bj][n] = *(const f32x4*)(xp + bj * HALF + n * 16);
            }
#pragma unroll
            for (int m = 0; m < 4; ++m) {
                const int row = row0 + ai * HALF + m * 16;
                float* xn = xnew + (size_t)row * DM + col0; bf16_t* xbp = xb + (size_t)row * DM + col0;
                float sm = 0.f;
#pragma unroll
                for (int bj = 0; bj < 2; ++bj)
#pragma unroll
                    for (int n = 0; n < 2; ++n) {
                        const f32x4 v = xo[m][bj][n] + acc[ai][bj][m][n] * accs + bv[bj][n];
                        *(f32x4*)(xn + bj * HALF + n * 16) = v;
                        *(u32x2*)(xbp + bj * HALF + n * 16) = (u32x2){cvt_pk_bf16(v[0], v[1]), cvt_pk_bf16(v[2], v[3])};
                        sm += (v[0] * v[0] + v[1] * v[1]) + (v[2] * v[2] + v[3] * v[3]);
                    }
                { const int ln = fr + 16 * fq; sm += xor_shfl(sm, ln, 16); sm += xor_shfl(sm, ln, 32); }
                if (fq == 0) scr[(ai * HALF + wr * 64 + m * 16 + fr) * 4 + wc] = sm;
            }
            asm volatile("" ::: "memory");
        }
        asm volatile("s_waitcnt lgkmcnt(0)" ::: "memory"); __builtin_amdgcn_s_barrier(); asm volatile("" ::: "memory");
        if (tid < BM) { const f32x4 p = *(const PG8_LAS f32x4*)(scr + tid * 4); ssq[(size_t)(u.pm * BM + tid) * 4 + u.pn] = (p[0] + p[1]) + (p[2] + p[3]); }
    }
};
struct EpiSlab {
    static constexpr bool PERM = false, AFTER_DRAIN = false;
    float* slab;
    __device__ __forceinline__ void operator()(const f32x4 (&acc)[2][2][4][2], const Unit& u, int wr, int wc, int fr, int fq, PG8_LAS unsigned char* xl, int tid) const {
        const int unit = u.ks * 16 + (u.pm - 64) * 4 + u.pn;
        f32x4* dst = (f32x4*)slab + (size_t)unit * 32 * 512 + tid;
#pragma unroll
        for (int ai = 0; ai < 2; ++ai)
#pragma unroll
            for (int bj = 0; bj < 2; ++bj)
#pragma unroll
                for (int m = 0; m < 4; ++m)
#pragma unroll
                    for (int n = 0; n < 2; ++n) dst[(size_t)(ai * 16 + bj * 8 + m * 2 + n) * 512] = acc[ai][bj][m][n];
    }
};
struct EpiQKV {
    static constexpr bool PERM = true, AFTER_DRAIN = false;
    bf16_t* Q; bf16_t* K; bf16_t* V; const float* ssq; const float* bias; const float* rope; float* out;
    __device__ __forceinline__ void operator()(const f32x4 (&acc)[2][2][4][2], const Unit& u, int wr, int wc, int fr, int fq, PG8_LAS unsigned char* xl, int tid) const {
        const int row0 = u.pm * BM + wr * 64 + fr, pn = u.pn, dd0 = 8 * fq, nat0 = pn * 256 + wc * 64 + dd0;
        f32x4 bv[2][2];
#pragma unroll
        for (int bj = 0; bj < 2; ++bj)
#pragma unroll
            for (int n = 0; n < 2; ++n) bv[bj][n] = *(const f32x4*)(bias + nat0 + bj * 32 + 4 * n);
        float rs8[2][4];
        {
            f32x4 sq[2][4];
#pragma unroll
            for (int ai = 0; ai < 2; ++ai)
#pragma unroll
                for (int m = 0; m < 4; ++m) sq[ai][m] = *(const f32x4*)(ssq + (size_t)(row0 + ai * HALF + m * 16) * 4);
#pragma unroll
            for (int ai = 0; ai < 2; ++ai)
#pragma unroll
                for (int m = 0; m < 4; ++m) { rs8[ai][m] = rstd_of(sq[ai][m]); asm volatile("" : "+v"(rs8[ai][m])); }
        }
        asm volatile("" ::: "memory");
#pragma unroll
        for (int ah = 0; ah < 4; ++ah) {
            const int ai = ah >> 1;
            f32x4 rp[4][4];
            if (pn < 5) {
#pragma unroll
                for (int m = 2 * (ah & 1); m < 2 * (ah & 1) + 2; ++m) { const int row = row0 + ai * HALF + m * 16;
                    const int pidx = (row < MP) ? (row & (TPS - 1)) : TPS + ((row - MP) & (TSS - 1));
                    const f32x4* rq = (const f32x4*)(rope + ((size_t)pidx * 32 + dd0) * 2);
#pragma unroll
                    for (int j = 0; j < 4; ++j) rp[m][j] = rq[j]; }
            }
#pragma unroll
            for (int m = 2 * (ah & 1); m < 2 * (ah & 1) + 2; ++m) {
                const int row = row0 + ai * HALF + m * 16;
                const float rs = rs8[ai][m];
                f32x4 v[2][2];
#pragma unroll
                for (int bj = 0; bj < 2; ++bj)
#pragma unroll
                    for (int n = 0; n < 2; ++n) v[bj][n] = acc[ai][bj][m][n] * rs + bv[bj][n];
                if (pn < 5) {
#pragma unroll
                    for (int n = 0; n < 2; ++n) {
                        const f32x4 cs0 = rp[m][2 * n], cs1 = rp[m][2 * n + 1];
                        const float c[4] = {cs0[0], cs0[2], cs1[0], cs1[2]}, sn[4] = {cs0[1], cs0[3], cs1[1], cs1[3]};
                        const f32x4 x1 = v[0][n], x2 = v[1][n];
#pragma unroll
                        for (int i = 0; i < 4; ++i) { v[0][n][i] = x1[i] * c[i] - x2[i] * sn[i]; v[1][n][i] = x2[i] * c[i] + x1[i] * sn[i]; }
                    }
                }
                if (pn < 4) {
#pragma unroll
                    for (int bj = 0; bj < 2; ++bj) { const f32x4 a = v[bj][0] * QSCALE, b = v[bj][1] * QSCALE;
                        *(u32x4*)(Q + (size_t)row * DM + nat0 + bj * 32) = (u32x4){cvt_pk_bf16(a[0], a[1]), cvt_pk_bf16(a[2], a[3]), cvt_pk_bf16(b[0], b[1]), cvt_pk_bf16(b[2], b[3])}; }
                } else {
                    bf16_t* kv = (pn == 4) ? K : V;
                    const int c0 = wc * 64 + dd0;
#pragma unroll
                    for (int bj = 0; bj < 2; ++bj) { const f32x4 a = v[bj][0], b = v[bj][1];
                        *(u32x4*)(kv + (size_t)row * KVD + c0 + bj * 32) = (u32x4){cvt_pk_bf16(a[0], a[1]), cvt_pk_bf16(a[2], a[3]), cvt_pk_bf16(b[0], b[1]), cvt_pk_bf16(b[2], b[3])}; }
                    float* dst = nullptr;
                    if (row < MP) { const int t = row & (TPS - 1); if (t >= TPS - 128) dst = out + ((pn == 4) ? O_KP : O_VP) + ((size_t)(row >> 11) * 128 + (t - (TPS - 128))) * KVD + c0; }
                    else { const int r = row - MP; dst = out + ((pn == 4) ? O_KS : O_VS) + ((size_t)(r >> 3) * 128 + 120 + (r & 7)) * KVD + c0; }
                    if (dst) {
#pragma unroll
                        for (int bj = 0; bj < 2; ++bj)
#pragma unroll
                            for (int n = 0; n < 2; ++n) *(f32x4*)(dst + bj * 32 + 4 * n) = v[bj][n];
                    }
                }
            }
            asm volatile("" ::: "memory");
        }
    }
};

template <class Epi, class Sched, bool ALIGN_EPI = false, bool SP2 = false>
__device__ __forceinline__ void gemm_phase(PG8_LAS unsigned char* lds, const Gemm g, const Sched& S, const Epi& E, const int tid) {
    const int wid = __builtin_amdgcn_readfirstlane(tid >> 6), lane = tid & 63, wr = wid >> 2, wc = wid & 3, fr = lane & 15, fq = lane >> 4;
    const int K = g.K, nt = K / BK;
    unsigned voffA[2], voffB[2];
#pragma unroll
    for (int i = 0; i < 2; ++i) { int R, C; stage_rc(tid * 16 + i * 8192, R, C); const int Rb = Epi::PERM ? ((R & ~31) + perm32(R & 31)) : R;
        voffA[i] = (unsigned)(R * g.lda + C) * 2u; voffB[i] = (unsigned)(Rb * g.ldb + C) * 2u; }
    const size_t kstep = (size_t)(BK * 2);
    const size_t hstepA = (size_t)HALF * g.lda * 2, hstepB = (size_t)HALF * g.ldb * 2;
    const size_t tstepA = 2 * hstepA, tstepB = 2 * hstepB;
    const size_t pnA = (size_t)g.a_pn_cols * 2;
    const unsigned ldsw = (unsigned)wid * 1024u;
    const int aoff = lds_byte(wr * 64 + fr, fq * 8), boff = lds_byte(wc * 32 + fr, fq * 8);
#define PG8_SA(b, h) (((b) * 2 + (h)) * HTB)
#define PG8_SB(b, h) ((4 + (b) * 2 + (h)) * HTB)
#define PG8_STAGE(bufoff, gbase, voff) do { _Pragma("unroll") for (int _i = 0; _i < 2; ++_i) \
        __builtin_amdgcn_global_load_lds((const unsigned*)((const char*)(gbase) + (voff)[_i]), (PG8_LAS unsigned*)(lds + (bufoff) + ldsw + _i * 8192), 16, 0, 0); } while (0)
#define PG8_LDA(dst, b, h) do { _Pragma("unroll") for (int m = 0; m < 4; ++m) _Pragma("unroll") for (int k = 0; k < 2; ++k) dst[m][k] = *(const PG8_LAS bf16x8*)(lds + PG8_SA(b, h) + aoff + m * 2048 + k * 1024); } while (0)
#define PG8_LDB(dst, b, h) do { _Pragma("unroll") for (int n = 0; n < 2; ++n) _Pragma("unroll") for (int k = 0; k < 2; ++k) dst[n][k] = *(const PG8_LAS bf16x8*)(lds + PG8_SB(b, h) + boff + n * 2048 + k * 1024); } while (0)
#define PG8_MMA(ai, bj, At, Bt) do { __builtin_amdgcn_s_setprio(1); _Pragma("unroll") for (int m = 0; m < 4; ++m) _Pragma("unroll") for (int n = 0; n < 2; ++n) _Pragma("unroll") for (int k = 0; k < 2; ++k) \
        acc[ai][bj][m][n] = __builtin_amdgcn_mfma_f32_16x16x32_bf16(Bt[n][k], At[m][k], acc[ai][bj][m][n], 0, 0, 0); __builtin_amdgcn_s_setprio(0); } while (0)
#define PG8_WAIT_V(n) asm volatile("s_waitcnt vmcnt(" #n ")" ::: "memory")
#define PG8_WAIT_L(n) asm volatile("s_waitcnt lgkmcnt(" #n ")" ::: "memory")
#define PG8_BAR __builtin_amdgcn_s_barrier()
#define PG8_SCHED __builtin_amdgcn_sched_barrier(0)
    Unit cur, nxt; int ui = 0;
    if (!S.next(0, cur)) return;
    f32x4 acc[2][2][4][2];
#pragma unroll
    for (int a = 0; a < 2; ++a)
#pragma unroll
        for (int b = 0; b < 2; ++b)
#pragma unroll
            for (int m = 0; m < 4; ++m)
#pragma unroll
                for (int n = 0; n < 2; ++n) acc[a][b][m][n] = (f32x4){0.f, 0.f, 0.f, 0.f};
    bf16x8 At[4][2], B0[2][2], B1[2][2];
    const size_t ksb = (size_t)K * 2;
    const char* cA = (const char*)g.A + (size_t)cur.pm * tstepA + (size_t)cur.pn * pnA + (size_t)cur.ks * ksb; const char* cB = (const char*)g.Bt + (size_t)cur.pn * tstepB + (size_t)cur.ks * ksb;
    S.a_ready(cur);
    if constexpr (SP2) {
        PG8_STAGE(PG8_SB(0, 0), cB, voffB); PG8_STAGE(PG8_SB(0, 1), cB + hstepB, voffB); PG8_STAGE(PG8_SA(0, 0), cA, voffA); PG8_STAGE(PG8_SA(0, 1), cA + hstepA, voffA);
        if (wr == 1) PG8_BAR;
        PG8_WAIT_V(2); PG8_BAR;
        PG8_STAGE(PG8_SB(1, 0), cB + kstep, voffB); PG8_STAGE(PG8_SA(1, 0), cA + kstep, voffA); PG8_STAGE(PG8_SB(1, 1), cB + hstepB + kstep, voffB);
        PG8_WAIT_V(6); PG8_BAR;
    } else {
        PG8_STAGE(PG8_SB(0, 0), cB, voffB); PG8_STAGE(PG8_SA(0, 0), cA, voffA); PG8_STAGE(PG8_SB(0, 1), cB + hstepB, voffB); PG8_STAGE(PG8_SA(0, 1), cA + hstepA, voffA);
        if (wr == 1) PG8_BAR;
        PG8_WAIT_V(4); PG8_BAR;
        PG8_STAGE(PG8_SB(1, 0), cB + kstep, voffB); PG8_STAGE(PG8_SA(1, 0), cA + kstep, voffA); PG8_STAGE(PG8_SB(1, 1), cB + hstepB + kstep, voffB);
        PG8_WAIT_V(6); PG8_BAR;
    }
    for (;;) {
        const bool has_next = S.next(ui + 1, nxt);
        const char* nA = has_next ? (const char*)g.A + (size_t)nxt.pm * tstepA + (size_t)nxt.pn * pnA + (size_t)nxt.ks * ksb : cA; const char* nB = has_next ? (const char*)g.Bt + (size_t)nxt.pn * tstepB + (size_t)nxt.ks * ksb : cB;
        for (int t = 0; t < nt; t += 2) {
            const bool last = (t == nt - 2);
            const char* a1 = cA + (size_t)(t + 1) * kstep;
            const char* a2 = last ? nA : cA + (size_t)(t + 2) * kstep; const char* b2 = last ? nB : cB + (size_t)(t + 2) * kstep;
            const char* a3 = a2 + kstep; const char* b3 = b2 + kstep;
            if (last && has_next) S.a_ready(nxt);
            if constexpr (SP2) {
            PG8_LDB(B0, 0, 0); PG8_LDB(B1, 0, 1); PG8_SCHED; PG8_LDA(At, 0, 0); PG8_STAGE(PG8_SA(1, 1), a1 + hstepA, voffA);
            PG8_WAIT_V(8); PG8_WAIT_L(0); PG8_BAR; PG8_MMA(0, 0, At, B0); PG8_MMA(0, 1, At, B1); PG8_BAR; PG8_SCHED;
            PG8_LDA(At, 0, 1); PG8_STAGE(PG8_SB(0, 0), b2, voffB); PG8_STAGE(PG8_SB(0, 1), b2 + hstepB, voffB); PG8_STAGE(PG8_SA(0, 0), a2, voffA);
            PG8_WAIT_V(8); PG8_WAIT_L(0); PG8_BAR; PG8_MMA(1, 0, At, B0); PG8_MMA(1, 1, At, B1); PG8_BAR; PG8_SCHED;
            PG8_LDB(B0, 1, 0); PG8_LDB(B1, 1, 1); PG8_SCHED; PG8_LDA(At, 1, 0); PG8_STAGE(PG8_SA(0, 1), a2 + hstepA, voffA);
            PG8_WAIT_V(8); PG8_WAIT_L(0); PG8_BAR; PG8_MMA(0, 0, At, B0); PG8_MMA(0, 1, At, B1); PG8_BAR; PG8_SCHED;
            PG8_LDA(At, 1, 1); PG8_STAGE(PG8_SB(1, 0), b3, voffB); PG8_STAGE(PG8_SB(1, 1), b3 + hstepB, voffB); PG8_STAGE(PG8_SA(1, 0), a3, voffA);
            PG8_WAIT_V(8); PG8_WAIT_L(0); PG8_BAR; PG8_MMA(1, 0, At, B0); PG8_MMA(1, 1, At, B1); PG8_BAR; PG8_SCHED;
            } else {
            PG8_LDB(B0, 0, 0); PG8_SCHED; PG8_LDA(At, 0, 0); PG8_STAGE(PG8_SA(1, 1), a1 + hstepA, voffA);
            PG8_WAIT_L(8); PG8_BAR; PG8_WAIT_L(0); PG8_MMA(0, 0, At, B0); PG8_BAR; PG8_SCHED;
            PG8_LDB(B1, 0, 1); PG8_STAGE(PG8_SB(0, 0), b2, voffB);
            PG8_BAR; PG8_WAIT_L(0); PG8_MMA(0, 1, At, B1); PG8_BAR;
            PG8_LDA(At, 0, 1); PG8_STAGE(PG8_SA(0, 0), a2, voffA);
            PG8_BAR; PG8_WAIT_L(0); PG8_MMA(1, 0, At, B0); PG8_BAR; PG8_SCHED;
            PG8_STAGE(PG8_SB(0, 1), b2 + hstepB, voffB);
            PG8_WAIT_V(6); PG8_BAR; PG8_MMA(1, 1, At, B1); PG8_BAR;
            PG8_LDB(B0, 1, 0); PG8_SCHED; PG8_LDA(At, 1, 0); PG8_STAGE(PG8_SA(0, 1), a2 + hstepA, voffA);
            PG8_WAIT_L(8); PG8_BAR; PG8_WAIT_L(0); PG8_MMA(0, 0, At, B0); PG8_BAR; PG8_SCHED;
            PG8_LDB(B1, 1, 1); PG8_STAGE(PG8_SB(1, 0), b3, voffB);
            PG8_BAR; PG8_WAIT_L(0); PG8_MMA(0, 1, At, B1); PG8_BAR;
            PG8_LDA(At, 1, 1); PG8_STAGE(PG8_SA(1, 0), a3, voffA);
            PG8_BAR; PG8_WAIT_L(0); PG8_MMA(1, 0, At, B0); PG8_BAR; PG8_SCHED;
            PG8_STAGE(PG8_SB(1, 1), b3 + hstepB, voffB);
            PG8_WAIT_V(6); PG8_BAR; PG8_MMA(1, 1, At, B1); PG8_BAR;
            }
        }
        if constexpr (ALIGN_EPI) { if (wr == 0) PG8_BAR; }
        if constexpr (!Epi::AFTER_DRAIN) { int le = lane; asm volatile("" : "+v"(le)); E(acc, cur, wr, wc, le & 15, le >> 4, lds + EPI_SCR_OFF, tid); S.done(cur); }
        if (!has_next) break;
#pragma unroll
        for (int a = 0; a < 2; ++a)
#pragma unroll
            for (int b = 0; b < 2; ++b)
#pragma unroll
                for (int m = 0; m < 4; ++m)
#pragma unroll
                    for (int n = 0; n < 2; ++n) acc[a][b][m][n] = (f32x4){0.f, 0.f, 0.f, 0.f};
        cur = nxt; cA = nA; cB = nB; ++ui;
        if constexpr (ALIGN_EPI) { if (wr == 1) PG8_BAR; }
    }
    PG8_WAIT_V(0);
    if constexpr (!ALIGN_EPI) { if (wr == 0) PG8_BAR; }
    PG8_BAR;
#undef PG8_SA
#undef PG8_SB
#undef PG8_STAGE
#undef PG8_LDA
#undef PG8_LDB
#undef PG8_MMA
#undef PG8_WAIT_V
#undef PG8_WAIT_L
#undef PG8_BAR
#undef PG8_SCHED
}
}

#define GAS __attribute__((address_space(1)))
#define LAS __attribute__((address_space(3)))
typedef unsigned short bf16;
typedef unsigned v4u __attribute__((ext_vector_type(4)));
typedef unsigned v2u __attribute__((ext_vector_type(2)));
typedef float f32x4 __attribute__((ext_vector_type(4)));
typedef float f32x2 __attribute__((ext_vector_type(2)));
typedef float f32x16 __attribute__((ext_vector_type(16)));
typedef short bf16x8 __attribute__((ext_vector_type(8)));
typedef short s16x4 __attribute__((ext_vector_type(4)));
typedef GAS unsigned gu32;
#define RLX_AGENT __ATOMIC_RELAXED, __HIP_MEMORY_SCOPE_AGENT
#define LDS_WAIT() asm volatile("s_waitcnt lgkmcnt(0)" ::: "memory")
#define VM_WAIT() asm volatile("s_waitcnt vmcnt(0)" ::: "memory")
__device__ __forceinline__ unsigned f2bf(float f) { unsigned u = __builtin_bit_cast(unsigned, f); return (u + 0x7fffu + ((u >> 16) & 1u)) >> 16; }
__device__ __forceinline__ unsigned pk2(float lo, float hi) { return f2bf(lo) | (f2bf(hi) << 16); }
__device__ __forceinline__ float bf2f(unsigned short b) { return __builtin_bit_cast(float, (unsigned)b << 16); }

constexpr int NWAVES = 8;
constexpr size_t MiB = 1u << 20;
constexpr size_t WS_CTL = 0, CTL_ZERO_BYTES = 64 * 1024;
constexpr size_t WS_ROPE = 1 * MiB;
constexpr size_t WS_SSQ = 2 * MiB;
constexpr size_t WS_WQKV = 4 * MiB, WS_WO = 7 * MiB, WS_WPOOL = 9 * MiB;
constexpr size_t WS_W1 = 10 * MiB, W1_BYTES = (size_t)2 * DFF * DM * 2;
constexpr size_t WS_W2 = 54 * MiB, W2_BYTES = (size_t)DM * DFF * 2;
constexpr size_t WS_XB = 76 * MiB;
constexpr size_t WS_H = 110 * MiB;
constexpr size_t WS_P = WS_H, WS_Q = WS_H, WS_O = WS_H + 34 * MiB, WS_K = WS_H + 68 * MiB, WS_V = WS_H + 77 * MiB;
constexpr size_t WS_SLAB = 204 * MiB;
constexpr int NSPLIT = 11;
constexpr size_t WS_END = 248 * MiB;
static_assert(WS_W1 + 4 * W1_BYTES <= WS_W2 && WS_W2 + 4 * W2_BYTES <= WS_XB && WS_XB + (size_t)MT * DM * 2 <= WS_H && WS_H + (size_t)MT * DFF * 2 <= WS_END, "ws map");
static_assert(WS_V + (size_t)MT * KVD * 2 <= WS_END && WS_K + (size_t)MT * KVD * 2 <= WS_V && WS_O + (size_t)MT * DM * 2 <= WS_K, "ws map 2");
constexpr int CW_BAR = 4096;
constexpr int RING_OFF = 0, RING_BYTES = 131072;
constexpr int LDSCTL_OFF = RING_BYTES, MISC_OFF = LDSCTL_OFF + 320;
constexpr int LDS_BYTES = 147456;

#define XB_TMO      128
#define XB_XCNT(j)  (256  + 64 * (j))
#define XB_XSUB(j)  (1280 + 64 * (j))
#define XB_XGEN(j)  (2304 + 64 * (j))
#define XB_TOP      3328
#define XB_TOPGEN   3392
#define XCD_BAR_WORDS 3456
#define XB_SPIN_CAP (1u << 18)
__device__ __forceinline__ unsigned xb_ld(unsigned* p)              { return __hip_atomic_load(p, __ATOMIC_RELAXED, __HIP_MEMORY_SCOPE_AGENT); }
__device__ __forceinline__ unsigned xb_add(unsigned* p, unsigned v) { return __hip_atomic_fetch_add(p, v, __ATOMIC_RELAXED, __HIP_MEMORY_SCOPE_AGENT); }
__device__ __forceinline__ unsigned xb_xcc_id() { return (unsigned)__builtin_amdgcn_s_getreg((3 << 11) | 20) & 0xFu; }
#define XB_SPIN(cond, bar) do { unsigned _sp = 0; while (cond) { __builtin_amdgcn_s_sleep(1); \
    if ((++_sp & 255u) == 0u) { if (xb_ld(&(bar)[XB_TMO])) break; if (_sp > XB_SPIN_CAP) { atomicAdd(&(bar)[XB_TMO], 1u); break; } } } } while (0)
struct XcdBarrier { unsigned* bar; unsigned x; volatile LAS unsigned* st; };
__device__ __forceinline__ XcdBarrier xcd_barrier_post(unsigned* bar, volatile LAS unsigned* st) {
    XcdBarrier b; b.bar = bar; b.x = xb_xcc_id(); b.st = st;
    if (threadIdx.x == 0) (void)xb_add(&bar[XB_XCNT(b.x)], 1u);
    return b;
}
__device__ __forceinline__ void xcd_barrier_complete(unsigned* bar, unsigned x, unsigned& nloc, unsigned& nx) {
    const unsigned G = gridDim.x * gridDim.y * gridDim.z;
    unsigned sum, cnt, mine, sp = 0u;
    for (;;) {
        sum = 0u; cnt = 0u; mine = 0u;
#pragma unroll
        for (unsigned j = 0; j < 16; ++j) { const unsigned c = xb_ld(&bar[XB_XCNT(j)]); sum += c; cnt += (c > 0u) ? 1u : 0u; mine = (j == x) ? c : mine; }
        if (sum == G) break;
        __builtin_amdgcn_s_sleep(1);
        if ((++sp & 255u) == 0u) { if (xb_ld(&bar[XB_TMO])) break; if (sp > XB_SPIN_CAP) { atomicAdd(&bar[XB_TMO], 1u); break; } }
    }
    nloc = mine > 0u ? mine : 1u; nx = cnt > 0u ? cnt : 1u;
}
__device__ __forceinline__ void xcd_barrier(const XcdBarrier& b) {
    asm volatile("s_waitcnt vmcnt(0)" ::: "memory");
    __syncthreads();
    if (threadIdx.x == 0) {
        unsigned* bar = b.bar;
        __builtin_amdgcn_s_waitcnt(0);
        unsigned nloc = b.st[0], nx = b.st[1];
        if (nloc == 0u) { xcd_barrier_complete(bar, b.x, nloc, nx); b.st[0] = nloc; b.st[1] = nx; }
        const unsigned old = xb_add(&bar[XB_XSUB(b.x)], 1u);
        const unsigned gen = old / nloc;
        if (old + 1u == (gen + 1u) * nloc) {
            __builtin_amdgcn_fence(__ATOMIC_RELEASE, "agent");
            asm volatile("s_waitcnt vmcnt(0)" ::: "memory");
            const unsigned og = xb_add(&bar[XB_TOP], 1u);
            const unsigned tg = og / nx;
            if (og + 1u == (tg + 1u) * nx) xb_add(&bar[XB_TOPGEN], 1u);
            else XB_SPIN(xb_ld(&bar[XB_TOPGEN]) == tg, bar);
            __builtin_amdgcn_fence(__ATOMIC_ACQUIRE, "agent");
            xb_add(&bar[XB_XGEN(b.x)], 1u);
            asm volatile("s_waitcnt vmcnt(0)" ::: "memory");
        } else {
            XB_SPIN(xb_ld(&bar[XB_XGEN(b.x)]) == gen, bar);
            __builtin_amdgcn_fence(__ATOMIC_ACQUIRE, "agent");
            asm volatile("s_waitcnt vmcnt(0)" ::: "memory");
        }
    }
    __syncthreads();
}

struct Frame {
    LAS unsigned char* lds;
    int tid, lane, wave, vcu, G;
};
__device__ __forceinline__ float wave_sum(float v, int lane) {
#pragma unroll
    for (int o = 1; o < 64; o <<= 1) v += pg8::xor_shfl(v, lane, o);
    return v;
}

__device__ __forceinline__ void transpose_item(const float* W, int ldw, bf16* WT, int K, int drow0, int scol0, int k0, const float* kscale, const float* nscale, float cscale, LAS float* scr, int lane) {
    const float ns = nscale ? nscale[drow0 + (lane & 31)] * cscale : cscale;
#pragma unroll 8
    for (int i = 0; i < 32; ++i) { const int kk = 2 * i + (lane >> 5); float w = W[(size_t)(k0 + kk) * ldw + scol0 + (lane & 31)] * ns; if (kscale) w *= kscale[k0 + kk]; scr[kk * 33 + (lane & 31)] = w; }
    LDS_WAIT(); asm volatile("" ::: "memory");
    const int c = lane & 7;
#pragma unroll
    for (int j = 0; j < 4; ++j) { const int n = (lane >> 3) + 8 * j; const LAS float* s = scr + (8 * c) * 33 + n;
        v4u o; o.x = pk2(s[0 * 33], s[1 * 33]); o.y = pk2(s[2 * 33], s[3 * 33]); o.z = pk2(s[4 * 33], s[5 * 33]); o.w = pk2(s[6 * 33], s[7 * 33]);
        *(GAS v4u*)(WT + (size_t)(drow0 + n) * K + k0 + 8 * c) = o; }
    LDS_WAIT(); asm volatile("" ::: "memory");
}
struct Args { const float* in[20]; float* out; unsigned char* ws; int ph_lo, ph_hi; };
typedef const __attribute__((address_space(4))) Args* ArgsP;
struct Ptrs {
    ArgsP ap;
#define PTR_ACC(name, idx) __device__ __forceinline__ const float* name() const { return ap->in[idx]; }
    PTR_ACC(xp, 0) PTR_ACC(xs, 1) PTR_ACC(spool, 2) PTR_ACC(ck, 3) PTR_ACC(cv, 4) PTR_ACC(n1, 5) PTR_ACC(w1in, 6) PTR_ACC(w1out, 7) PTR_ACC(nmix, 8) PTR_ACC(n2, 9)
    PTR_ACC(w2in, 10) PTR_ACC(w2out, 11) PTR_ACC(poolw, 12) PTR_ACC(pscale, 13) PTR_ACC(wqkv, 14) PTR_ACC(bqkv, 15) PTR_ACC(wo, 16) PTR_ACC(bo, 17) PTR_ACC(sinks, 18) PTR_ACC(nfin, 19)
#undef PTR_ACC
    __device__ __forceinline__ float* out() const { return ap->out; }
    __device__ __forceinline__ unsigned char* ws() const { return ap->ws; }
};
__device__ __forceinline__ void p0_prologue(const Frame& F, const Ptrs& P) {
    LAS float* scr = (LAS float*)(F.lds + RING_OFF + F.wave * 16384);
    const int gw = F.vcu * NWAVES + F.wave, NGW = F.G * NWAVES;
    constexpr int I_W1 = (DM / 64) * (2 * DFF / 32), I_W2 = (DFF / 64) * (DM / 32), I_FFN = I_W1 + I_W2;
    constexpr int I_QKV = (DM / 64) * (QKVN / 32), I_WO = (DM / 64) * (DM / 32), I_POOL = 4 * 4 * 8;
    constexpr int NITEMS = 4 * I_FFN + I_QKV + I_WO + I_POOL;
    for (int it = gw; it < NITEMS; it += NGW) {
        int r = it;
        if (r < 4 * I_FFN) {
            const int f = r / I_FFN; r -= f * I_FFN; const int layer = f >> 1, second = f & 1;
            const float* win = (second ? P.w2in() : P.w1in()) + (size_t)layer * DM * 2 * DFF;
            const float* wout = (second ? P.w2out() : P.w1out()) + (size_t)layer * DFF * DM;
            const float* gn = (second ? P.n2() : P.n1()) + layer * DM;
            if (r < I_W1) { const int nblk = 2 * DFF / 32, kb = r / nblk, nb = r % nblk, j = 32 * nb;
                const int scol = ((j >> 7) & 1) * DFF + (j >> 8) * 128 + (j & 127);
                transpose_item(win, 2 * DFF, (bf16*)(P.ws() + WS_W1 + f * W1_BYTES), DM, j, scol, 64 * kb, gn, nullptr, 1.0f, scr, F.lane);
            } else { r -= I_W1; const int nblk = DM / 32, kb = r / nblk, nb = r % nblk;
                transpose_item(wout, DM, (bf16*)(P.ws() + WS_W2 + f * W2_BYTES), DFF, 32 * nb, 32 * nb, 64 * kb, nullptr, nullptr, 0.5f, scr, F.lane); }
            continue;
        }
        r -= 4 * I_FFN;
        if (r < I_QKV) { const int nblk = QKVN / 32, kb = r / nblk, nb = r % nblk, j = 32 * nb;
            const int scol = (j >> 8) * 256 + ((j >> 5) & 3) * 64 + ((j >> 7) & 1) * 32;
            transpose_item(P.wqkv(), QKVN, (bf16*)(P.ws() + WS_WQKV), DM, j, scol, 64 * kb, P.nmix() + DM, nullptr, 1.0f, scr, F.lane); continue; }
        r -= I_QKV;
        if (r < I_WO) { const int nblk = DM / 32, kb = r / nblk, nb = r % nblk;
            transpose_item(P.wo(), DM, (bf16*)(P.ws() + WS_WO), DM, 32 * nb, 32 * nb, 64 * kb, nullptr, nullptr, 1.0f, scr, F.lane); continue; }
        r -= I_WO;
        { const int gi = r >> 5, kb = (r >> 3) & 3, nb = r & 7;
            transpose_item(P.poolw() + (size_t)gi * 65536, 256, (bf16*)(P.ws() + WS_WPOOL), 256, gi * 256 + 32 * nb, 32 * nb, 64 * kb, nullptr, P.pscale(), 1.0f, scr, F.lane); }
    }
    {
        float* rope = (float*)(P.ws() + WS_ROPE);
        const double r1 = 1.0 / sqrt(sqrt(sqrt(10.0)));
        for (int e = (F.vcu * NWAVES * 64) + F.tid; e < (TPS + TSS) * 32; e += F.G * NWAVES * 64) {
            const int pidx = e >> 5, d = e & 31; const int pos = pidx < TPS ? pidx : PAST + (pidx - TPS);
            double inv = 1.0; for (int i = 0; i < d; ++i) inv *= r1;
            double turns = (double)pos * inv * 0.15915494309189535; turns -= floor(turns);
            const float a = (float)(turns * 6.283185307179586);
            rope[2 * e] = cosf(a); rope[2 * e + 1] = sinf(a);
        }
    }
    {
        bf16* XB = (bf16*)(P.ws() + WS_XB); float* SSQ = (float*)(P.ws() + WS_SSQ);
        for (int m = gw; m < MT; m += NGW) {
            const float* xrow = (m < MP) ? P.xp() + (size_t)m * DM : P.xs() + (size_t)(m - MP) * DM;
            const GAS f32x4* xr = (const GAS f32x4*)xrow + F.lane;
            f32x4 v[4]; float s = 0.f;
#pragma unroll
            for (int j = 0; j < 4; ++j) { v[j] = xr[64 * j]; s += (v[j][0] * v[j][0] + v[j][1] * v[j][1]) + (v[j][2] * v[j][2] + v[j][3] * v[j][3]); }
            s = wave_sum(s, F.lane);
            GAS unsigned long long* o8 = (GAS unsigned long long*)(XB + (size_t)m * DM) + F.lane;
#pragma unroll
            for (int j = 0; j < 4; ++j) o8[64 * j] = (unsigned long long)pk2(v[j][0], v[j][1]) | ((unsigned long long)pk2(v[j][2], v[j][3]) << 32);
            if (F.lane < 4) SSQ[(size_t)m * 4 + F.lane] = (F.lane == 0) ? s : 0.f;
        }
    }
}

template <int WG, int NROWS>
__device__ __forceinline__ void pool_rows(const float* X, int r0, int tpos0, const float* hist_raw  , bool hist_x, const LAS float* rs  ,
                                          f32x2 g, int c0, bf16* Pm, float* np_out  , int np_t0) {
    f32x2 h[16];
#pragma unroll
    for (int k = 0; k < 16; ++k) h[k] = (f32x2){0.f, 0.f};
    if (hist_x) {
#pragma unroll
        for (int k = 1; k < 16; ++k) { const f32x2 x = *(const f32x2*)(X + (size_t)(r0 - 16 + k) * DM + c0); h[k] = x * rs[k - 1] * g; }
    } else if (hist_raw) {
#pragma unroll
        for (int k = 1; k < 16; ++k) h[k] = *(const f32x2*)(hist_raw + (size_t)(k - 1) * DM + c0);
    }
    for (int blk = 0; blk < (NROWS + 15) / 16; ++blk) {
#pragma unroll
        for (int k = 0; k < 16; ++k) {
            if (blk * 16 + k < NROWS) {
                const int lr = blk * 16 + k, row = r0 + lr, tpos = tpos0 + lr;
                const f32x2 x = *(const f32x2*)(X + (size_t)row * DM + c0);
                const f32x2 u = x * rs[15 + lr] * g;
                h[k] = u;
                f32x2 s = u;
#pragma unroll
                for (int j = 1; j < WG; ++j) s += h[(k - j) & 15];
                const int cnt = (tpos + 1 < WG) ? tpos + 1 : WG;
                const f32x2 p = s * (1.0f / (float)cnt) - u;
                *(unsigned*)(Pm + (size_t)row * DM + c0) = pk2(p[0], p[1]);
                if (tpos >= np_t0) *(f32x2*)(np_out + (size_t)(tpos - np_t0) * DM + c0) = u;
            }
        }
    }
}
template <int NROWS>
__device__ __forceinline__ void pool_unit(const Frame& F, const Ptrs& P, int r0, int tpos0, const float* hist_raw, bool hist_x, float* np_out, int np_t0) {
    const float* X = P.out() + O_Y; const float* SSQ = (const float*)(P.ws() + WS_SSQ); bf16* Pm = (bf16*)(P.ws() + WS_P);
    LAS float* rs = (LAS float*)(F.lds + RING_OFF);
    __syncthreads();
    if (F.tid < 15 + NROWS) { const int row = r0 - 15 + F.tid; rs[F.tid] = (F.tid >= 15 || hist_x) ? pg8::row_rstd(SSQ, row) : 0.f; }
    __syncthreads();
    const int c0 = 2 * F.tid; const f32x2 g = *(const f32x2*)(P.nmix() + c0);
    const int gi = F.tid >> 7;
    if (gi == 0) pool_rows<2, NROWS>(X, r0, tpos0, hist_raw, hist_x, rs, g, c0, Pm, np_out, np_t0);
    else if (gi == 1) pool_rows<4, NROWS>(X, r0, tpos0, hist_raw, hist_x, rs, g, c0, Pm, np_out, np_t0);
    else if (gi == 2) pool_rows<8, NROWS>(X, r0, tpos0, hist_raw, hist_x, rs, g, c0, Pm, np_out, np_t0);
    else pool_rows<16, NROWS>(X, r0, tpos0, hist_raw, hist_x, rs, g, c0, Pm, np_out, np_t0);
}
__device__ __forceinline__ void pool_phase(const Frame& F, const Ptrs& P) {
    for (int u = F.vcu; u < MP / 64; u += F.G) {
        const int r0 = u * 64, b = r0 >> 11, t0 = r0 & (TPS - 1);
        pool_unit<64>(F, P, r0, t0, nullptr, t0 > 0, P.out() + O_POOLP + (size_t)b * 15 * DM, TPS - 15);
    }
    for (int b = F.vcu; b < NSB; b += F.G) {
        const float* sp = P.spool() + (size_t)b * 15 * DM; float* np = P.out() + O_POOLS + (size_t)b * 15 * DM;
        for (int e = F.tid; e < 7 * DM / 4; e += NWAVES * 64) ((f32x4*)np)[e] = ((const f32x4*)(sp + 8 * DM))[e];
        pool_unit<8>(F, P, MP + b * TSS, PAST, sp, false, np, PAST - 7);
    }
}

namespace att {
constexpr int LDS_K = 0, LDS_V = 3 * 8192, LDS_WS = 6 * 8192, LDS_OST = LDS_WS + NWAVES * 256, LDS_TOTAL = LDS_OST + NWAVES * 4096;
__device__ __forceinline__ int crow(int r, int hi) { return (r & 3) + 8 * (r >> 2) + 4 * hi; }
__device__ __forceinline__ unsigned cvtpk_s(float lo, float hi) { typedef float f2 __attribute__((ext_vector_type(2))); typedef __bf16 b2 __attribute__((ext_vector_type(2))); f2 v = {lo, hi}; b2 b = __builtin_convertvector(v, b2); return __builtin_bit_cast(unsigned, b); }
typedef short v4i16_t __attribute__((ext_vector_type(4)));
__device__ __forceinline__ s16x4 vtr(const LAS unsigned char* p) { return __builtin_bit_cast(s16x4, __builtin_amdgcn_ds_read_tr16_b64_v4i16((LAS v4i16_t*)p)); }
constexpr float NEG = -1.0e30f;

struct Soft { v4u pa[5][2]; float l; };
__device__ __forceinline__ void softmax5(f32x16 (&sc)[5], float sk, Soft& R) {
    float m = sk;
#pragma unroll
    for (int i = 0; i < 5; ++i)
#pragma unroll
        for (int r = 0; r < 16; ++r) m = fmaxf(m, sc[i][r]);
    { auto rr = __builtin_amdgcn_permlane32_swap(__float_as_uint(m), __float_as_uint(m), false, false); m = fmaxf(__uint_as_float(rr[0]), __uint_as_float(rr[1])); }
    float l = 0.f;
#pragma unroll
    for (int i = 0; i < 5; ++i) {
#pragma unroll
        for (int r = 0; r < 16; ++r) { const float p = __builtin_amdgcn_exp2f(sc[i][r] - m); sc[i][r] = p; l += p; }
#pragma unroll
        for (int s = 0; s < 2; ++s) R.pa[i][s] = (v4u){cvtpk_s(sc[i][8 * s + 0], sc[i][8 * s + 1]), cvtpk_s(sc[i][8 * s + 2], sc[i][8 * s + 3]), cvtpk_s(sc[i][8 * s + 4], sc[i][8 * s + 5]), cvtpk_s(sc[i][8 * s + 6], sc[i][8 * s + 7])};
    }
    { auto rr = __builtin_amdgcn_permlane32_swap(__float_as_uint(l), __float_as_uint(l), false, false); l = __uint_as_float(rr[0]) + __uint_as_float(rr[1]); }
    R.l = l + __builtin_amdgcn_exp2f(sk - m);
}

__device__ __forceinline__ void prompt_unit(const Frame& F, int b, int kvh, int qb, const bf16* Q, const bf16* K, const bf16* V, bf16* O, const float* sinks) {
    const int lane = F.lane, wid = F.wave, r32 = lane & 31, hi = lane >> 5;
    LAS unsigned char* lds = F.lds + RING_OFF;
    const int q0 = qb * 64, jmin = (qb >= 2) ? 0 : 2 - qb;
    const long rowbase = (long)b * TPS;
    __syncthreads();
#pragma unroll
    for (int j = 0; j < 3; ++j) if (j >= jmin) {
        const long kr0 = rowbase + q0 - 128 + 64 * j;
        const v4u kv = *(const v4u*)(K + (kr0 + lane) * KVD + kvh * 64 + wid * 8);
        *(LAS v4u*)(lds + LDS_K + j * 8192 + wid * 1024 + lane * 16) = kv;
        const v4u vv = *(const v4u*)(V + (kr0 + 16 * (wid & 3) + (lane >> 2)) * KVD + kvh * 64 + (wid >> 2) * 32 + (lane & 3) * 8);
        *(LAS v4u*)(lds + LDS_V + j * 8192 + wid * 1024 + lane * 16) = vv;
    }
    const int g = wid >> 1, half = wid & 1, h = 4 * kvh + g;
    const bf16* Qw = Q + (rowbase + q0 + 32 * half) * DM + h * HD;
    bf16x8 qr[4];
#pragma unroll
    for (int d0 = 0; d0 < 4; ++d0) qr[d0] = *(const bf16x8*)(Qw + (long)r32 * DM + d0 * 16 + hi * 8);
    const float sk = sinks[h] * LOG2E;
    __syncthreads();
    f32x16 sc[5];
#pragma unroll
    for (int i = 0; i < 5; ++i) {
        const int kb = half + i, tile = kb >> 1, p = kb & 1;
        if (tile >= jmin) {
            const LAS unsigned char* kp = lds + LDS_K + tile * 8192 + p * 512 + hi * 1024 + r32 * 16;
            f32x16 a = {};
#pragma unroll
            for (int d0 = 0; d0 < 4; ++d0) a = __builtin_amdgcn_mfma_f32_32x32x16_bf16(*(const LAS bf16x8*)(kp + d0 * 2048), qr[d0], a, 0, 0, 0);
            sc[i] = a;
        } else {
#pragma unroll
            for (int r = 0; r < 16; ++r) sc[i][r] = NEG;
        }
    }
#pragma unroll
    for (int r = 0; r < 16; ++r) { const int kk = crow(r, hi); if (!(kk > r32)) sc[0][r] = NEG; if (!(kk <= r32)) sc[4][r] = NEG; }
    Soft S; softmax5(sc, sk, S);
    f32x16 o[2]; o[0] = f32x16{}; o[1] = f32x16{};
#pragma unroll
    for (int i = 0; i < 5; ++i) {
        const int kb = half + i, tile = kb >> 1, p = kb & 1;
        if (tile >= jmin) {
            const LAS unsigned char* vp = lds + LDS_V + tile * 8192 + ((lane >> 4) & 1) * 32 + (lane & 3) * 8 + (4 * hi + ((lane & 15) >> 2)) * 64;
#pragma unroll
            for (int s = 0; s < 2; ++s)
#pragma unroll
                for (int d0 = 0; d0 < 2; ++d0) {
                    const s16x4 lo = vtr(vp + d0 * 4096 + (2 * p + s) * 1024), hh = vtr(vp + d0 * 4096 + (2 * p + s) * 1024 + 512);
                    const bf16x8 vf = (bf16x8){lo[0], lo[1], lo[2], lo[3], hh[0], hh[1], hh[2], hh[3]};
                    o[d0] = __builtin_amdgcn_mfma_f32_32x32x16_bf16(__builtin_bit_cast(bf16x8, S.pa[i][s]), vf, o[d0], 0, 0, 0);
                }
        }
    }
    LAS float* wsf = (LAS float*)(lds + LDS_WS) + wid * 64;
    if (hi == 0) wsf[r32] = S.l;
    LDS_WAIT();
    LAS bf16* stg = (LAS bf16*)(lds + LDS_OST) + wid * 2048;
#pragma unroll
    for (int r = 0; r < 16; ++r) { const int orow = crow(r, hi); const float rl = __builtin_amdgcn_rcpf(wsf[orow]);
#pragma unroll
        for (int d0 = 0; d0 < 2; ++d0) stg[orow * 64 + d0 * 32 + r32] = (bf16)f2bf(o[d0][r] * rl); }
    LDS_WAIT();
    bf16* Ow = O + (rowbase + q0 + 32 * half) * DM + h * HD;
#pragma unroll
    for (int i = 0; i < 4; ++i) { const int row = i * 8 + (lane >> 3), ch = lane & 7; const v4u v = *(const LAS v4u*)(stg + row * 64 + ch * 8); *(v4u*)(Ow + (long)row * DM + ch * 8) = v; }
}

__device__ __forceinline__ void sample_unit(int lane, int b, int kvh, const bf16* Q, const bf16* Kn, const bf16* Vn, const float* ck, const float* cv, bf16* O, const float* sinks, LAS float* wsf) {
    const int r32 = lane & 31, hi = lane >> 5, qi = r32 & 7, h = 4 * kvh + (r32 >> 3);
    const long qrow = (long)MP + b * TSS + qi;
    bf16x8 qr[4];
#pragma unroll
    for (int d0 = 0; d0 < 4; ++d0) qr[d0] = *(const bf16x8*)(Q + qrow * DM + h * HD + d0 * 16 + hi * 8);
    const float sk = sinks[h] * LOG2E;
    f32x16 sc[5];
#pragma unroll
    for (int blk = 0; blk < 4; ++blk) {
        f32x16 a = {};
        const float* kp = ck + ((size_t)(b * 128 + 32 * blk + r32) * NKV + kvh) * HD + hi * 8;
#pragma unroll
        for (int d0 = 0; d0 < 4; ++d0) { const f32x4 x0 = *(const f32x4*)(kp + d0 * 16), x1 = *(const f32x4*)(kp + d0 * 16 + 4);
            const v4u kw = (v4u){cvtpk_s(x0[0], x0[1]), cvtpk_s(x0[2], x0[3]), cvtpk_s(x1[0], x1[1]), cvtpk_s(x1[2], x1[3])};
            a = __builtin_amdgcn_mfma_f32_32x32x16_bf16(__builtin_bit_cast(bf16x8, kw), qr[d0], a, 0, 0, 0); }
        sc[blk] = a;
    }
    {
        f32x16 a = {};
        const bf16* kp = Kn + ((long)MP + b * TSS + (r32 & 7)) * KVD + kvh * HD + hi * 8;
#pragma unroll
        for (int d0 = 0; d0 < 4; ++d0) { v4u kw = *(const v4u*)(kp + d0 * 16); if (r32 >= 8) kw = (v4u){0u, 0u, 0u, 0u};
            a = __builtin_amdgcn_mfma_f32_32x32x16_bf16(__builtin_bit_cast(bf16x8, kw), qr[d0], a, 0, 0, 0); }
        sc[4] = a;
    }
#pragma unroll
    for (int blk = 0; blk < 5; ++blk)
#pragma unroll
        for (int r = 0; r < 16; ++r) { const int j = 32 * blk + crow(r, hi); if (!(j >= qi + 1 && j <= 128 + qi)) sc[blk][r] = NEG; }
    Soft S; softmax5(sc, sk, S);
    f32x16 o[2]; o[0] = f32x16{}; o[1] = f32x16{};
#pragma unroll
    for (int blk = 0; blk < 4; ++blk)
#pragma unroll
        for (int s = 0; s < 2; ++s)
#pragma unroll
            for (int d0 = 0; d0 < 2; ++d0) {
                float vv[8];
#pragma unroll
                for (int jj = 0; jj < 8; ++jj) { const int key = 32 * blk + 16 * s + 8 * (jj >> 2) + 4 * hi + (jj & 3); vv[jj] = cv[((size_t)(b * 128 + key) * NKV + kvh) * HD + d0 * 32 + r32]; }
                const v4u vw = (v4u){cvtpk_s(vv[0], vv[1]), cvtpk_s(vv[2], vv[3]), cvtpk_s(vv[4], vv[5]), cvtpk_s(vv[6], vv[7])};
                o[d0] = __builtin_amdgcn_mfma_f32_32x32x16_bf16(__builtin_bit_cast(bf16x8, S.pa[blk][s]), __builtin_bit_cast(bf16x8, vw), o[d0], 0, 0, 0);
            }
#pragma unroll
    for (int d0 = 0; d0 < 2; ++d0) {
        unsigned short e[4];
#pragma unroll
        for (int jj = 0; jj < 4; ++jj) e[jj] = Vn[((long)MP + b * TSS + 4 * hi + jj) * KVD + kvh * HD + d0 * 32 + r32];
        const v4u vw = (v4u){(unsigned)e[0] | ((unsigned)e[1] << 16), (unsigned)e[2] | ((unsigned)e[3] << 16), 0u, 0u};
        o[d0] = __builtin_amdgcn_mfma_f32_32x32x16_bf16(__builtin_bit_cast(bf16x8, S.pa[4][0]), __builtin_bit_cast(bf16x8, vw), o[d0], 0, 0, 0);
    }
    if (hi == 0) wsf[r32] = S.l;
    LDS_WAIT();
#pragma unroll
    for (int r = 0; r < 16; ++r) { const int q = crow(r, hi); const float rl = __builtin_amdgcn_rcpf(wsf[q]);
        bf16* orow = O + ((long)MP + b * TSS + (q & 7)) * DM + (4 * kvh + (q >> 3)) * HD + r32;
#pragma unroll
        for (int d0 = 0; d0 < 2; ++d0) orow[d0 * 32] = (bf16)f2bf(o[d0][r] * rl); }
    LDS_WAIT();
}

__device__ __forceinline__ void attn_phase(const Frame& F, const Ptrs& P) {
    const bf16* Q = (const bf16*)(P.ws() + WS_Q); const bf16* K = (const bf16*)(P.ws() + WS_K); const bf16* V = (const bf16*)(P.ws() + WS_V); bf16* O = (bf16*)(P.ws() + WS_O);
    constexpr int NPU = NPB * NKV * 32;
    const int per = (NPU + F.G - 1) / F.G;
    for (int i = 0; i < per; ++i) { const int u = F.vcu * per + i; if (u < NPU) prompt_unit(F, u >> 7, (u >> 5) & 3, u & 31, Q, K, V, O, P.sinks()); }
    __syncthreads();
    LAS float* wsf = (LAS float*)(F.lds + RING_OFF + LDS_WS) + F.wave * 64;
    const int gw = F.vcu * NWAVES + F.wave, NGW = F.G * NWAVES;
    for (int u = gw; u < NSB * NKV; u += NGW) sample_unit(F.lane, u >> 2, u & 3, Q, K, V, P.ck(), P.cv(), O, P.sinks(), wsf);
    {
        constexpr int PER_B = 120 * KVD / 4;
        const int gt = F.vcu * NWAVES * 64 + F.tid, NT = F.G * NWAVES * 64;
        for (int e = gt; e < 2 * NSB * PER_B; e += NT) {
            const int which = e / (NSB * PER_B), r = e - which * (NSB * PER_B), b = r / PER_B, w = r - b * PER_B;
            const f32x4* src = (const f32x4*)(which ? P.cv() : P.ck()) + (size_t)b * (128 * KVD / 4) + (8 * KVD / 4) + w;
            f32x4* dst = (f32x4*)(P.out() + (which ? O_VS : O_KS)) + (size_t)b * (128 * KVD / 4) + w;
            *dst = *src;
        }
    }
}
}

__device__ __forceinline__ void final_phase(const Frame& F, const Ptrs& P) {
    float* X = P.out() + O_Y; const float* SSQ = (const float*)(P.ws() + WS_SSQ);
    const int gw = F.vcu * NWAVES + F.wave, NGW = F.G * NWAVES;
    f32x4 gv[4];
#pragma unroll
    for (int j = 0; j < 4; ++j) gv[j] = ((const f32x4*)P.nfin())[64 * j + F.lane];
    for (int m = gw; m < MT; m += NGW) {
        const float rs = pg8::row_rstd(SSQ, m);
        f32x4* xr = (f32x4*)(X + (size_t)m * DM) + F.lane;
#pragma unroll
        for (int j = 0; j < 4; ++j) xr[64 * j] = xr[64 * j] * rs * gv[j];
    }
}

__device__ __forceinline__ void fix_phase(const Frame& F, const Ptrs& P, const float* xold_s  , float accs) {
    const f32x4* slab4 = (const f32x4*)(P.ws() + WS_SLAB);
    float* X = P.out() + O_Y; bf16* XB = (bf16*)(P.ws() + WS_XB); float* SSQ = (float*)(P.ws() + WS_SSQ);
    LAS float* scr = (LAS float*)(F.lds + RING_OFF);
    const int wid = F.wave, wr = wid >> 2, wc = wid & 3, fr = F.lane & 15, fq = F.lane >> 4;
    for (int u = F.vcu; u < 128; u += F.G) {
        const int t = u >> 3, rg = u & 7, ai = rg >> 2, m = rg & 3, pn = t & 3;
        f32x4 sum[2][2];
#pragma unroll
        for (int bj = 0; bj < 2; ++bj)
#pragma unroll
            for (int n = 0; n < 2; ++n) sum[bj][n] = (f32x4){0.f, 0.f, 0.f, 0.f};
#pragma unroll 4
        for (int sp = 0; sp < NSPLIT; ++sp) {
            const f32x4* sl = slab4 + ((size_t)(sp * 16 + t) * 32 + ai * 16 + m * 2) * 512 + F.tid;
#pragma unroll
            for (int bj = 0; bj < 2; ++bj)
#pragma unroll
                for (int n = 0; n < 2; ++n) sum[bj][n] += sl[(size_t)(bj * 8 + n) * 512];
        }
        const int srow = (t >> 2) * 256 + ai * 128 + wr * 64 + m * 16 + fr, row = MP + srow, col0 = pn * 256 + wc * 32 + 4 * fq;
        const float* xo = xold_s + (size_t)srow * DM + col0; float* xn = X + (size_t)row * DM + col0; bf16* xbp = XB + (size_t)row * DM + col0;
        float sm = 0.f;
#pragma unroll
        for (int bj = 0; bj < 2; ++bj)
#pragma unroll
            for (int n = 0; n < 2; ++n) {
                const f32x4 v = *(const f32x4*)(xo + bj * 128 + n * 16) + sum[bj][n] * accs;
                *(f32x4*)(xn + bj * 128 + n * 16) = v;
                *(v2u*)(xbp + bj * 128 + n * 16) = (v2u){pg8::cvt_pk_bf16(v[0], v[1]), pg8::cvt_pk_bf16(v[2], v[3])};
                sm += (v[0] * v[0] + v[1] * v[1]) + (v[2] * v[2] + v[3] * v[3]);
            }
        sm += pg8::xor_shfl(sm, F.lane, 16); sm += pg8::xor_shfl(sm, F.lane, 32);
        __syncthreads();
        if (fq == 0) scr[(wr * 16 + fr) * 4 + wc] = sm;
        __syncthreads();
        if (F.tid < 32) { const f32x4 p = *(const LAS f32x4*)(scr + F.tid * 4); const int r2 = MP + (t >> 2) * 256 + ai * 128 + (F.tid >> 4) * 64 + m * 16 + (F.tid & 15);
            SSQ[(size_t)r2 * 4 + pn] = (p[0] + p[1]) + (p[2] + p[3]); }
    }
}

constexpr int NPHASES = 19;
__global__ void __launch_bounds__(NWAVES * 64, 2) mk_fwd(Args args) {
    extern __shared__ __attribute__((aligned(16))) unsigned char lds_raw[];
    {
        LAS unsigned char* l0 = (LAS unsigned char*)lds_raw;
        for (int u = threadIdx.x; u < (LDS_BYTES - LDSCTL_OFF) / 4; u += NWAVES * 64) ((LAS unsigned*)(l0 + LDSCTL_OFF))[u] = 0u;
        __syncthreads();
    }
    const int lo = args.ph_lo, hi = args.ph_hi;
    const int wave0 = __builtin_amdgcn_readfirstlane(threadIdx.x >> 6);
    if (hi - lo > 1) (void)xcd_barrier_post((unsigned*)(args.ws + WS_CTL) + CW_BAR, (volatile LAS unsigned*)((LAS unsigned char*)lds_raw + MISC_OFF) + 8);
    for (int it = 2 * lo; it < 2 * hi; ++it) {
        const int ph = it >> 1; const bool dup = (it & 1) != 0;
        if (dup && !((DUP_MASK >> ph) & 1)) continue;
        int wv_ = wave0; asm volatile("" : "+s"(wv_));
        unsigned z_ = 0u; asm volatile("" : "+v"(z_));
        int tid = wv_ * 64 + (int)__builtin_amdgcn_mbcnt_hi(~0u, __builtin_amdgcn_mbcnt_lo(~0u, z_)); asm volatile("" : "+v"(tid));
        int bx = blockIdx.x, G = gridDim.x; asm volatile("" : "+s"(bx), "+s"(G));
        ArgsP ap = (ArgsP)__builtin_amdgcn_kernarg_segment_ptr(); asm volatile("" : "+s"(ap));
        Frame F;
        F.lds = (LAS unsigned char*)lds_raw;
        F.tid = tid; F.lane = tid & 63; F.wave = __builtin_amdgcn_readfirstlane(tid >> 6);
        F.G = G; F.vcu = (G % 8 == 0) ? (bx % 8) * (G / 8) + bx / 8 : bx;
        Ptrs P; P.ap = ap;
        unsigned char* ws = P.ws();
        bf16* XB = (bf16*)(ws + WS_XB); bf16* Hb = (bf16*)(ws + WS_H); float* SSQ = (float*)(ws + WS_SSQ);
        float* X = P.out() + O_Y;
        const int kind = (ph < 16) ? (int)((0x1876321321543210ull >> (4 * ph)) & 15ull) : (int)((0x932u >> (4 * (ph - 16))) & 15u);
        const int f = (ph < 4) ? 0 : (ph < 9) ? 1 : (ph < 12) ? 2 : 3;
        if (kind == 0 && (PHMASK & 1)) {
            p0_prologue(F, P);
        } else if (kind == 1 && (PHMASK & 2)) {
            pg8::Gemm g{XB, (const bf16*)(ws + WS_W1 + f * W1_BYTES), MT, 2 * DFF, DM, DM, DM, 0};
            pg8::StaticOrder S; S.init(MT, 2 * DFF, F.G, bx);
            pg8::EpiSwiglu E{(dup && PROBE_NULL_EPI) ? nullptr : Hb, SSQ};
            pg8::gemm_phase<pg8::EpiSwiglu, pg8::StaticOrder, true, true>(F.lds + RING_OFF, g, S, E, F.tid);
        } else if ((kind == 2 || kind == 5 || kind == 8) && (PHMASK & 4)) {
            pg8::Gemm g; pg8::EpiRes E; int mrows = MT;
            E.xold_lo = X; E.xold_hi = X + (size_t)MP * DM; E.xnew = X; E.xb = XB; E.ssq = SSQ; E.bias = nullptr; E.accs = dup ? 0.f : 1.f;
            if (kind == 5) { g = pg8::Gemm{(const bf16*)(ws + WS_P), (const bf16*)(ws + WS_WPOOL), MT, DM, 256, DM, 256, 256}; }
            else if (kind == 8) { g = pg8::Gemm{(const bf16*)(ws + WS_O), (const bf16*)(ws + WS_WO), MT, DM, DM, DM, DM, 0}; E.bias = dup ? nullptr : P.bo(); }
            else { g = pg8::Gemm{Hb, (const bf16*)(ws + WS_W2 + f * W2_BYTES), MP, DM, DFF, DFF, DFF, 0}; mrows = MP;
                if (f == 0) { E.xold_lo = P.xp(); E.accs = 1.f; } }
            if (dup && PROBE_NULL_EPI) E.xnew = nullptr;
            pg8::StaticOrder S; S.init(mrows, DM, F.G, bx);
            pg8::gemm_phase<pg8::EpiRes, pg8::StaticOrder, true, true>(F.lds + RING_OFF, g, S, E, F.tid);
            if (kind == 2) {
                pg8::Gemm g2{Hb, (const bf16*)(ws + WS_W2 + f * W2_BYTES), MT, DM, 256, DFF, DFF, 0};
                pg8::SplitOrder S2{bx, 16 * NSPLIT};
                pg8::EpiSlab E2{(float*)(ws + WS_SLAB)};
                int tid2 = F.tid; asm volatile("" : "+v"(tid2));
                pg8::gemm_phase<pg8::EpiSlab, pg8::SplitOrder, true, true>(F.lds + RING_OFF, g2, S2, E2, tid2);
            }
        } else if (kind == 3 && (PHMASK & 128)) {
            fix_phase(F, P, (f == 0) ? P.xs() : X + (size_t)MP * DM, (dup && f != 0) ? 0.f : 1.f);
        } else if (kind == 4 && (PHMASK & 8)) {
            pool_phase(F, P);
        } else if (kind == 6 && (PHMASK & 16)) {
            pg8::Gemm g{XB, (const bf16*)(ws + WS_WQKV), MT, QKVN, DM, DM, DM, 0};
            pg8::StaticOrder S; S.init(MT, QKVN, F.G, bx);
            pg8::EpiQKV E{(bf16*)(ws + WS_Q), (bf16*)(ws + WS_K), (bf16*)(ws + WS_V), SSQ, P.bqkv(), (const float*)(ws + WS_ROPE), P.out()};
            pg8::gemm_phase<pg8::EpiQKV, pg8::StaticOrder, true, true>(F.lds + RING_OFF, g, S, E, F.tid);
        } else if (kind == 7 && (PHMASK & 32)) {
            att::attn_phase(F, P);
        } else if (kind == 9 && (PHMASK & 64)) {
            final_phase(F, P);
        }
        {
            ArgsP aq = (ArgsP)__builtin_amdgcn_kernarg_segment_ptr(); asm volatile("" : "+s"(aq));
            const int hi2 = aq->ph_hi, lo2 = aq->ph_lo;
            if ((it + 1 < 2 * hi2 - 1 || (DUP_MASK >> (hi2 - 1)) & 1) && hi2 - lo2 > 1) {
                XcdBarrier b2; b2.bar = (unsigned*)(aq->ws + WS_CTL) + CW_BAR; b2.x = xb_xcc_id(); b2.st = (volatile LAS unsigned*)((LAS unsigned char*)lds_raw + MISC_OFF) + 8;
                xcd_barrier(b2);
            }
        }
    }
}

extern "C" void kernel_launch(void* const* d_in, const int* in_sizes, int n_in, void* d_out, int out_size, void* d_ws, size_t ws_size, hipStream_t stream) {
    static int grid = 0;
    if (grid == 0) {
        if (n_in != 20 || (size_t)out_size != O_END || ws_size < WS_END) { fprintf(stderr, "kernel_launch: unexpected shapes (n_in %d out %d ws %zu)\n", n_in, out_size, ws_size); grid = -1; return; }
        int dev = 0, cus = 0, per_cu = 0;
        if (hipGetDevice(&dev) != hipSuccess || hipDeviceGetAttribute(&cus, hipDeviceAttributeMultiprocessorCount, dev) != hipSuccess) { grid = -1; return; }
        if (hipFuncSetAttribute((const void*)mk_fwd, hipFuncAttributeMaxDynamicSharedMemorySize, LDS_BYTES) != hipSuccess) { fprintf(stderr, "kernel_launch: hipFuncSetAttribute failed\n"); grid = -1; return; }
        if (hipOccupancyMaxActiveBlocksPerMultiprocessor(&per_cu, (const void*)mk_fwd, NWAVES * 64, LDS_BYTES) != hipSuccess || per_cu < 1)
            fprintf(stderr, "kernel_launch: occupancy query reports %d workgroups per CU\n", per_cu);
        (void)hipGetLastError();
        grid = cus;
    }
    if (grid < 0) return;
    (void)hipMemsetAsync((char*)d_ws + WS_CTL, 0, CTL_ZERO_BYTES, stream);
    Args a{};
    for (int i = 0; i < 20; ++i) a.in[i] = (const float*)d_in[i];
    a.out = (float*)d_out; a.ws = (unsigned char*)d_ws;
#if MK_ONE_LAUNCH
    a.ph_lo = 0; a.ph_hi = NPHASES;
    hipLaunchKernelGGL(mk_fwd, dim3(grid), dim3(NWAVES * 64), LDS_BYTES, stream, a);
#else
    for (int ph = 0; ph < NPHASES; ++ph) { a.ph_lo = ph; a.ph_hi = ph + 1; hipLaunchKernelGGL(mk_fwd, dim3(grid), dim3(NWAVES * 64), LDS_BYTES, stream, a); }
#endif
}
```

```cpp
#include <hip/hip_runtime.h>
#include <cstdio>
#include <cstdint>

#ifndef PHMASK
#define PHMASK 255
#endif
#ifndef PROBE_NULL_EPI
#define PROBE_NULL_EPI 0
#endif
#ifndef DUP_MASK
#define DUP_MASK 0
#endif
#ifndef MK_ONE_LAUNCH
#define MK_ONE_LAUNCH 1
#endif

constexpr int DM = 1024, DFF = 2816, NPB = 8, TPS = 2048, MP = NPB * TPS, NSB = 128, TSS = 8, MS = NSB * TSS, MT = MP + MS;
constexpr int QKVN = 1536, NHEAD = 16, NKV = 4, HD = 64, KVD = 256;
constexpr int PAST = 8192;
constexpr float RMS_EPS = 1e-6f;
constexpr float LOG2E = 1.4426950408889634f;
constexpr float QSCALE = 0.125f * LOG2E;
constexpr size_t O_Y = 0;
constexpr size_t O_POOLP = (size_t)MT * DM;
constexpr size_t O_POOLS = O_POOLP + (size_t)NPB * 15 * DM;
constexpr size_t O_KP = O_POOLS + (size_t)NSB * 15 * DM;
constexpr size_t O_VP = O_KP + (size_t)NPB * 128 * KVD;
constexpr size_t O_KS = O_VP + (size_t)NPB * 128 * KVD;
constexpr size_t O_VS = O_KS + (size_t)NSB * 128 * KVD;
constexpr size_t O_END = O_VS + (size_t)NSB * 128 * KVD;

namespace pg8 {
#define PG8_LAS __attribute__((address_space(3)))
typedef unsigned short bf16_t;
typedef short bf16x8 __attribute__((ext_vector_type(8)));
typedef float f32x4 __attribute__((ext_vector_type(4)));
typedef float f32x2 __attribute__((ext_vector_type(2)));
typedef unsigned u32x4 __attribute__((ext_vector_type(4)));
typedef unsigned u32x2 __attribute__((ext_vector_type(2)));
constexpr int BM = 256, BK = 64, HALF = 128, HTB = HALF * BK * 2, STAGE_BYTES = 8 * HTB, NXCD = 8, WGM = 8;
constexpr int EPI_SCR_OFF = STAGE_BYTES + 4096;

__host__ __device__ __forceinline__ int lds_byte(int r, int c) { const int st = (r >> 4) * 2 + (c >> 5), rr = r & 15, cc = c & 31, ob = rr * 64 + cc * 2; return st * 1024 + (ob ^ (((ob >> 9) & 1) << 5)); }
__host__ __device__ __forceinline__ void stage_rc(int b, int& R, int& C) { const int st = b / 1024, sb = b % 1024, swz = sb ^ (((sb >> 9) & 1) << 5); R = (st >> 1) * 16 + swz / 64; C = (st & 1) * 32 + (swz % 64) / 2; }
__host__ __device__ __forceinline__ int perm32(int rho) { const int n = rho >> 4, i = rho & 15; return 8 * (i >> 2) + 4 * n + (i & 3); }

struct Unit { int pm, pn, ks; };
struct Gemm { const bf16_t* A; const bf16_t* Bt; int M, N, K, lda, ldb, a_pn_cols; };

struct StaticOrder {
    int nM, nN, nwg, G, c;
    __host__ __device__ void init(int M, int N, int G_, int c_) { nM = M / BM; nN = N / BM; nwg = nM * nN; G = G_; c = c_; }
    __host__ __device__ bool next(int i, Unit& u) const {
        const long L = (long)i * G + c; if (L >= nwg) return false;
        int wgid = (int)L; { const int q = nwg / NXCD, r = nwg % NXCD, xcd = wgid % NXCD, off = wgid / NXCD; wgid = (xcd < r ? xcd * (q + 1) : r * (q + 1) + (xcd - r) * q) + off; }
        const int nig = WGM * nN, gid = wgid / nig, fm = gid * WGM, gsz = (nM - fm) < WGM ? (nM - fm) : WGM;
        u.pm = fm + ((wgid % nig) % gsz); u.pn = (wgid % nig) / gsz; u.ks = 0; return true;
    }
    __device__ __forceinline__ void a_ready(const Unit&) const {}
    __device__ __forceinline__ void done(const Unit&) const {}
};

struct SplitOrder {
    int c, n;
    __device__ __forceinline__ bool next(int i, Unit& u) const { if (i > 0 || c >= n) return false; u.pm = 64 + ((c & 15) >> 2); u.pn = c & 3; u.ks = c >> 4; return true; }
    __device__ __forceinline__ void a_ready(const Unit&) const {}
    __device__ __forceinline__ void done(const Unit&) const {}
};

__device__ __forceinline__ unsigned cvt_pk_bf16(float lo, float hi) { unsigned r; asm volatile("v_cvt_pk_bf16_f32 %0, %1, %2" : "=v"(r) : "v"(lo), "v"(hi)); return r; }

__device__ __forceinline__ float xor_shfl(float v, int lane, int mask) { return __builtin_bit_cast(float, __builtin_amdgcn_ds_bpermute((lane ^ mask) << 2, __builtin_bit_cast(int, v))); }
__device__ __forceinline__ float rstd_of(const f32x4 a) { return 1.0f / sqrtf(((a[0] + a[1]) + (a[2] + a[3])) * (1.0f / DM) + RMS_EPS); }
__device__ __forceinline__ float row_rstd(const float* ssq, int row) { return rstd_of(*(const f32x4*)(ssq + (size_t)row * 4)); }

struct EpiSwiglu {
    static constexpr bool PERM = true, AFTER_DRAIN = false;
    bf16_t* H; const float* ssq;
    __device__ __forceinline__ void operator()(const f32x4 (&acc)[2][2][4][2], const Unit& u, int wr, int wc, int fr, int fq, PG8_LAS unsigned char* xl, int tid) const {
        if (H == nullptr) return;
        const int row0 = u.pm * BM + wr * 64 + fr, col0 = u.pn * HALF + wc * 32 + 8 * fq;
        f32x4 sq[2][4];
#pragma unroll
        for (int ai = 0; ai < 2; ++ai)
#pragma unroll
            for (int m = 0; m < 4; ++m) sq[ai][m] = *(const f32x4*)(ssq + (size_t)(row0 + ai * HALF + m * 16) * 4);
#pragma unroll
        for (int ai = 0; ai < 2; ++ai)
#pragma unroll
            for (int m = 0; m < 4; ++m) {
                const int row = row0 + ai * HALF + m * 16;
                const float rs = rstd_of(sq[ai][m]);
                unsigned w[4];
#pragma unroll
                for (int n = 0; n < 2; ++n) {
                    float o[4];
#pragma unroll
                    for (int i = 0; i < 4; ++i) { const float g = acc[ai][0][m][n][i] * rs, up = acc[ai][1][m][n][i] * rs;
                        const float e = __builtin_amdgcn_exp2f(-g * LOG2E); o[i] = g * __builtin_amdgcn_rcpf(1.0f + e) * up; }
                    w[2 * n] = cvt_pk_bf16(o[0], o[1]); w[2 * n + 1] = cvt_pk_bf16(o[2], o[3]);
                }
                *(u32x4*)(H + (size_t)row * DFF + col0) = (u32x4){w[0], w[1], w[2], w[3]};
            }
    }
};
__device__ __forceinline__ f32x4 bf4_to_f32(const u32x2 w) { return (f32x4){__builtin_bit_cast(float, w.x << 16), __builtin_bit_cast(float, w.x & 0xffff0000u), __builtin_bit_cast(float, w.y << 16), __builtin_bit_cast(float, w.y & 0xffff0000u)}; }
struct EpiRes {
    static constexpr bool PERM = false, AFTER_DRAIN = false;
    bf16_t* xb; float* ssq; const float* bias; float accs;
    __device__ __forceinline__ void operator()(const f32x4 (&acc)[2][2][4][2], const Unit& u, int wr, int wc, int fr, int fq, PG8_LAS unsigned char* xl, int tid) const {
        if (xb == nullptr) return;
        const int row0 = u.pm * BM + wr * 64 + fr, col0 = u.pn * BM + wc * 32 + 4 * fq;
        PG8_LAS float* scr = (PG8_LAS float*)xl;
        f32x4 bv[2][2];
#pragma unroll
        for (int bj = 0; bj < 2; ++bj)
#pragma unroll
            for (int n = 0; n < 2; ++n) bv[bj][n] = bias ? *(const f32x4*)(bias + col0 + bj * HALF + n * 16) : (f32x4){0.f, 0.f, 0.f, 0.f};
        u32x2 xo[2][4][2][2];
#pragma unroll
        for (int ai = 0; ai < 2; ++ai)
#pragma unroll
            for (int m = 0; m < 4; ++m) {
                const bf16_t* xp = xb + (size_t)(row0 + ai * HALF + m * 16) * DM + col0;
#pragma unroll
                for (int bj = 0; bj < 2; ++bj)
#pragma unroll
                    for (int n = 0; n < 2; ++n) xo[ai][m][bj][n] = *(const u32x2*)(xp + bj * HALF + n * 16);
            }
#pragma unroll
        for (int ai = 0; ai < 2; ++ai)
#pragma unroll
            for (int m = 0; m < 4; ++m) {
                bf16_t* xp = xb + (size_t)(row0 + ai * HALF + m * 16) * DM + col0;
                float sm = 0.f;
#pragma unroll
                for (int bj = 0; bj < 2; ++bj)
#pragma unroll
                    for (int n = 0; n < 2; ++n) {
                        const f32x4 v = bf4_to_f32(xo[ai][m][bj][n]) + acc[ai][bj][m][n] * accs + bv[bj][n];
                        *(u32x2*)(xp + bj * HALF + n * 16) = (u32x2){cvt_pk_bf16(v[0], v[1]), cvt_pk_bf16(v[2], v[3])};
                        sm += (v[0] * v[0] + v[1] * v[1]) + (v[2] * v[2] + v[3] * v[3]);
                    }
                { const int ln = fr + 16 * fq; sm += xor_shfl(sm, ln, 16); sm += xor_shfl(sm, ln, 32); }
                if (fq == 0) scr[(ai * HALF + wr * 64 + m * 16 + fr) * 4 + wc] = sm;
            }
        asm volatile("s_waitcnt lgkmcnt(0)" ::: "memory"); __builtin_amdgcn_s_barrier(); asm volatile("" ::: "memory");
        if (tid < BM) { const f32x4 p = *(const PG8_LAS f32x4*)(scr + tid * 4); ssq[(size_t)(u.pm * BM + tid) * 4 + u.pn] = (p[0] + p[1]) + (p[2] + p[3]); }
    }
};
struct EpiSlab {
    static constexpr bool PERM = false, AFTER_DRAIN = false;
    float* slab;
    __device__ __forceinline__ void operator()(const f32x4 (&acc)[2][2][4][2], const Unit& u, int wr, int wc, int fr, int fq, PG8_LAS unsigned char* xl, int tid) const {
        const int unit = u.ks * 16 + (u.pm - 64) * 4 + u.pn;
        f32x4* dst = (f32x4*)slab + (size_t)unit * 32 * 512 + tid;
#pragma unroll
        for (int ai = 0; ai < 2; ++ai)
#pragma unroll
            for (int bj = 0; bj < 2; ++bj)
#pragma unroll
                for (int m = 0; m < 4; ++m)
#pragma unroll
                    for (int n = 0; n < 2; ++n) dst[(size_t)(ai * 16 + bj * 8 + m * 2 + n) * 512] = acc[ai][bj][m][n];
    }
};
struct EpiQKV {
    static constexpr bool PERM = true, AFTER_DRAIN = false;
    bf16_t* Q; bf16_t* K; bf16_t* V; const float* ssq; const float* bias; const float* rope; float* out;
    __device__ __forceinline__ void operator()(const f32x4 (&acc)[2][2][4][2], const Unit& u, int wr, int wc, int fr, int fq, PG8_LAS unsigned char* xl, int tid) const {
        const int row0 = u.pm * BM + wr * 64 + fr, pn = u.pn, dd0 = 8 * fq, nat0 = pn * 256 + wc * 64 + dd0;
        f32x4 bv[2][2];
#pragma unroll
        for (int bj = 0; bj < 2; ++bj)
#pragma unroll
            for (int n = 0; n < 2; ++n) bv[bj][n] = *(const f32x4*)(bias + nat0 + bj * 32 + 4 * n);
        float rs8[2][4];
        {
            f32x4 sq[2][4];
#pragma unroll
            for (int ai = 0; ai < 2; ++ai)
#pragma unroll
                for (int m = 0; m < 4; ++m) sq[ai][m] = *(const f32x4*)(ssq + (size_t)(row0 + ai * HALF + m * 16) * 4);
#pragma unroll
            for (int ai = 0; ai < 2; ++ai)
#pragma unroll
                for (int m = 0; m < 4; ++m) { rs8[ai][m] = rstd_of(sq[ai][m]); asm volatile("" : "+v"(rs8[ai][m])); }
        }
        asm volatile("" ::: "memory");
#pragma unroll
        for (int ah = 0; ah < 4; ++ah) {
            const int ai = ah >> 1;
            f32x4 rp[4][4];
            if (pn < 5) {
#pragma unroll
                for (int m = 2 * (ah & 1); m < 2 * (ah & 1) + 2; ++m) { const int row = row0 + ai * HALF + m * 16;
                    const int pidx = (row < MP) ? (row & (TPS - 1)) : TPS + ((row - MP) & (TSS - 1));
                    const f32x4* rq = (const f32x4*)(rope + ((size_t)pidx * 32 + dd0) * 2);
#pragma unroll
                    for (int j = 0; j < 4; ++j) rp[m][j] = rq[j]; }
            }
#pragma unroll
            for (int m = 2 * (ah & 1); m < 2 * (ah & 1) + 2; ++m) {
                const int row = row0 + ai * HALF + m * 16;
                const float rs = rs8[ai][m];
                f32x4 v[2][2];
#pragma unroll
                for (int bj = 0; bj < 2; ++bj)
#pragma unroll
                    for (int n = 0; n < 2; ++n) v[bj][n] = acc[ai][bj][m][n] * rs + bv[bj][n];
                if (pn < 5) {
#pragma unroll
                    for (int n = 0; n < 2; ++n) {
                        const f32x4 cs0 = rp[m][2 * n], cs1 = rp[m][2 * n + 1];
                        const float c[4] = {cs0[0], cs0[2], cs1[0], cs1[2]}, sn[4] = {cs0[1], cs0[3], cs1[1], cs1[3]};
                        const f32x4 x1 = v[0][n], x2 = v[1][n];
#pragma unroll
                        for (int i = 0; i < 4; ++i) { v[0][n][i] = x1[i] * c[i] - x2[i] * sn[i]; v[1][n][i] = x2[i] * c[i] + x1[i] * sn[i]; }
                    }
                }
                if (pn < 4) {
#pragma unroll
                    for (int bj = 0; bj < 2; ++bj) { const f32x4 a = v[bj][0] * QSCALE, b = v[bj][1] * QSCALE;
                        *(u32x4*)(Q + (size_t)row * DM + nat0 + bj * 32) = (u32x4){cvt_pk_bf16(a[0], a[1]), cvt_pk_bf16(a[2], a[3]), cvt_pk_bf16(b[0], b[1]), cvt_pk_bf16(b[2], b[3])}; }
                } else {
                    bf16_t* kv = (pn == 4) ? K : V;
                    const int c0 = wc * 64 + dd0;
#pragma unroll
                    for (int bj = 0; bj < 2; ++bj) { const f32x4 a = v[bj][0], b = v[bj][1];
                        *(u32x4*)(kv + (size_t)row * KVD + c0 + bj * 32) = (u32x4){cvt_pk_bf16(a[0], a[1]), cvt_pk_bf16(a[2], a[3]), cvt_pk_bf16(b[0], b[1]), cvt_pk_bf16(b[2], b[3])}; }
                    float* dst = nullptr;
                    if (row < MP) { const int t = row & (TPS - 1); if (t >= TPS - 128) dst = out + ((pn == 4) ? O_KP : O_VP) + ((size_t)(row >> 11) * 128 + (t - (TPS - 128))) * KVD + c0; }
                    else { const int r = row - MP; dst = out + ((pn == 4) ? O_KS : O_VS) + ((size_t)(r >> 3) * 128 + 120 + (r & 7)) * KVD + c0; }
                    if (dst) {
#pragma unroll
                        for (int bj = 0; bj < 2; ++bj)
#pragma unroll
                            for (int n = 0; n < 2; ++n) *(f32x4*)(dst + bj * 32 + 4 * n) = v[bj][n];
                    }
                }
            }
            asm volatile("" ::: "memory");
        }
    }
};

template <class Epi, class Sched, bool ALIGN_EPI = false, bool SP2 = false>
__device__ __forceinline__ void gemm_phase(PG8_LAS unsigned char* lds, const Gemm g, const Sched& S, const Epi& E, const int tid) {
    const int wid = __builtin_amdgcn_readfirstlane(tid >> 6), lane = tid & 63, wr = wid >> 2, wc = wid & 3, fr = lane & 15, fq = lane >> 4;
    const int K = g.K, nt = K / BK;
    unsigned voffA[2], voffB[2];
#pragma unroll
    for (int i = 0; i < 2; ++i) { int R, C; stage_rc(tid * 16 + i * 8192, R, C); const int Rb = Epi::PERM ? ((R & ~31) + perm32(R & 31)) : R;
        voffA[i] = (unsigned)(R * g.lda + C) * 2u; voffB[i] = (unsigned)(Rb * g.ldb + C) * 2u; }
    const size_t kstep = (size_t)(BK * 2);
    const size_t hstepA = (size_t)HALF * g.lda * 2, hstepB = (size_t)HALF * g.ldb * 2;
    const size_t tstepA = 2 * hstepA, tstepB = 2 * hstepB;
    const size_t pnA = (size_t)g.a_pn_cols * 2;
    const unsigned ldsw = (unsigned)wid * 1024u;
    const int aoff = lds_byte(wr * 64 + fr, fq * 8), boff = lds_byte(wc * 32 + fr, fq * 8);
#define PG8_SA(b, h) (((b) * 2 + (h)) * HTB)
#define PG8_SB(b, h) ((4 + (b) * 2 + (h)) * HTB)
#define PG8_STAGE(bufoff, gbase, voff) do { _Pragma("unroll") for (int _i = 0; _i < 2; ++_i) \
        __builtin_amdgcn_global_load_lds((const unsigned*)((const char*)(gbase) + (voff)[_i]), (PG8_LAS unsigned*)(lds + (bufoff) + ldsw + _i * 8192), 16, 0, 0); } while (0)
#define PG8_LDA(dst, b, h) do { _Pragma("unroll") for (int m = 0; m < 4; ++m) _Pragma("unroll") for (int k = 0; k < 2; ++k) dst[m][k] = *(const PG8_LAS bf16x8*)(lds + PG8_SA(b, h) + aoff + m * 2048 + k * 1024); } while (0)
#define PG8_LDB(dst, b, h) do { _Pragma("unroll") for (int n = 0; n < 2; ++n) _Pragma("unroll") for (int k = 0; k < 2; ++k) dst[n][k] = *(const PG8_LAS bf16x8*)(lds + PG8_SB(b, h) + boff + n * 2048 + k * 1024); } while (0)
#define PG8_MMA(ai, bj, At, Bt) do { __builtin_amdgcn_s_setprio(1); _Pragma("unroll") for (int m = 0; m < 4; ++m) _Pragma("unroll") for (int n = 0; n < 2; ++n) _Pragma("unroll") for (int k = 0; k < 2; ++k) \
        acc[ai][bj][m][n] = __builtin_amdgcn_mfma_f32_16x16x32_bf16(Bt[n][k], At[m][k], acc[ai][bj][m][n], 0, 0, 0); __builtin_amdgcn_s_setprio(0); } while (0)
#define PG8_WAIT_V(n) asm volatile("s_waitcnt vmcnt(" #n ")" ::: "memory")
#define PG8_WAIT_L(n) asm volatile("s_waitcnt lgkmcnt(" #n ")" ::: "memory")
#define PG8_BAR __builtin_amdgcn_s_barrier()
#define PG8_SCHED __builtin_amdgcn_sched_barrier(0)
    Unit cur, nxt; int ui = 0;
    if (!S.next(0, cur)) return;
    f32x4 acc[2][2][4][2];
#pragma unroll
    for (int a = 0; a < 2; ++a)
#pragma unroll
        for (int b = 0; b < 2; ++b)
#pragma unroll
            for (int m = 0; m < 4; ++m)
#pragma unroll
                for (int n = 0; n < 2; ++n) acc[a][b][m][n] = (f32x4){0.f, 0.f, 0.f, 0.f};
    bf16x8 At[4][2], B0[2][2], B1[2][2];
    const size_t ksb = (size_t)K * 2;
    const char* cA = (const char*)g.A + (size_t)cur.pm * tstepA + (size_t)cur.pn * pnA + (size_t)cur.ks * ksb; const char* cB = (const char*)g.Bt + (size_t)cur.pn * tstepB + (size_t)cur.ks * ksb;
    S.a_ready(cur);
    if constexpr (SP2) {
        PG8_STAGE(PG8_SB(0, 0), cB, voffB); PG8_STAGE(PG8_SB(0, 1), cB + hstepB, voffB); PG8_STAGE(PG8_SA(0, 0), cA, voffA); PG8_STAGE(PG8_SA(0, 1), cA + hstepA, voffA);
        if (wr == 1) PG8_BAR;
        PG8_WAIT_V(2); PG8_BAR;
        PG8_STAGE(PG8_SB(1, 0), cB + kstep, voffB); PG8_STAGE(PG8_SA(1, 0), cA + kstep, voffA); PG8_STAGE(PG8_SB(1, 1), cB + hstepB + kstep, voffB);
        PG8_WAIT_V(6); PG8_BAR;
    } else {
        PG8_STAGE(PG8_SB(0, 0), cB, voffB); PG8_STAGE(PG8_SA(0, 0), cA, voffA); PG8_STAGE(PG8_SB(0, 1), cB + hstepB, voffB); PG8_STAGE(PG8_SA(0, 1), cA + hstepA, voffA);
        if (wr == 1) PG8_BAR;
        PG8_WAIT_V(4); PG8_BAR;
        PG8_STAGE(PG8_SB(1, 0), cB + kstep, voffB); PG8_STAGE(PG8_SA(1, 0), cA + kstep, voffA); PG8_STAGE(PG8_SB(1, 1), cB + hstepB + kstep, voffB);
        PG8_WAIT_V(6); PG8_BAR;
    }
    for (;;) {
        const bool has_next = S.next(ui + 1, nxt);
        const char* nA = has_next ? (const char*)g.A + (size_t)nxt.pm * tstepA + (size_t)nxt.pn * pnA + (size_t)nxt.ks * ksb : cA; const char* nB = has_next ? (const char*)g.Bt + (size_t)nxt.pn * tstepB + (size_t)nxt.ks * ksb : cB;
        for (int t = 0; t < nt; t += 2) {
            const bool last = (t == nt - 2);
            const char* a1 = cA + (size_t)(t + 1) * kstep;
            const char* a2 = last ? nA : cA + (size_t)(t + 2) * kstep; const char* b2 = last ? nB : cB + (size_t)(t + 2) * kstep;
            const char* a3 = a2 + kstep; const char* b3 = b2 + kstep;
            if (last && has_next) S.a_ready(nxt);
            if constexpr (SP2) {
            PG8_LDB(B0, 0, 0); PG8_LDB(B1, 0, 1); PG8_SCHED; PG8_LDA(At, 0, 0); PG8_STAGE(PG8_SA(1, 1), a1 + hstepA, voffA);
            PG8_WAIT_V(8); PG8_WAIT_L(0); PG8_BAR; PG8_MMA(0, 0, At, B0); PG8_MMA(0, 1, At, B1); PG8_BAR; PG8_SCHED;
            PG8_LDA(At, 0, 1); PG8_STAGE(PG8_SB(0, 0), b2, voffB); PG8_STAGE(PG8_SB(0, 1), b2 + hstepB, voffB); PG8_STAGE(PG8_SA(0, 0), a2, voffA);
            PG8_WAIT_V(8); PG8_WAIT_L(0); PG8_BAR; PG8_MMA(1, 0, At, B0); PG8_MMA(1, 1, At, B1); PG8_BAR; PG8_SCHED;
            PG8_LDB(B0, 1, 0); PG8_LDB(B1, 1, 1); PG8_SCHED; PG8_LDA(At, 1, 0); PG8_STAGE(PG8_SA(0, 1), a2 + hstepA, voffA);
            PG8_WAIT_V(8); PG8_WAIT_L(0); PG8_BAR; PG8_MMA(0, 0, At, B0); PG8_MMA(0, 1, At, B1); PG8_BAR; PG8_SCHED;
            PG8_LDA(At, 1, 1); PG8_STAGE(PG8_SB(1, 0), b3, voffB); PG8_STAGE(PG8_SB(1, 1), b3 + hstepB, voffB); PG8_STAGE(PG8_SA(1, 0), a3, voffA);
            PG8_WAIT_V(8); PG8_WAIT_L(0); PG8_BAR; PG8_MMA(1, 0, At, B0); PG8_MMA(1, 1, At, B1); PG8_BAR; PG8_SCHED;
            } else {
            PG8_LDB(B0, 0, 0); PG8_SCHED; PG8_LDA(At, 0, 0); PG8_STAGE(PG8_SA(1, 1), a1 + hstepA, voffA);
            PG8_WAIT_L(8); PG8_BAR; PG8_WAIT_L(0); PG8_MMA(0, 0, At, B0); PG8_BAR; PG8_SCHED;
            PG8_LDB(B1, 0, 1); PG8_STAGE(PG8_SB(0, 0), b2, voffB);
            PG8_BAR; PG8_WAIT_L(0); PG8_MMA(0, 1, At, B1); PG8_BAR;
            PG8_LDA(At, 0, 1); PG8_STAGE(PG8_SA(0, 0), a2, voffA);
            PG8_BAR; PG8_WAIT_L(0); PG8_MMA(1, 0, At, B0); PG8_BAR; PG8_SCHED;
            PG8_STAGE(PG8_SB(0, 1), b2 + hstepB, voffB);
            PG8_WAIT_V(6); PG8_BAR; PG8_MMA(1, 1, At, B1); PG8_BAR;
            PG8_LDB(B0, 1, 0); PG8_SCHED; PG8_LDA(At, 1, 0); PG8_STAGE(PG8_SA(0, 1), a2 + hstepA, voffA);
            PG8_WAIT_L(8); PG8_BAR; PG8_WAIT_L(0); PG8_MMA(0, 0, At, B0); PG8_BAR; PG8_SCHED;
            PG8_LDB(B1, 1, 1); PG8_STAGE(PG8_SB(1, 0), b3, voffB);
            PG8_BAR; PG8_WAIT_L(0); PG8_MMA(0, 1, At, B1); PG8_BAR;
            PG8_LDA(At, 1, 1); PG8_STAGE(PG8_SA(1, 0), a3, voffA);
            PG8_BAR; PG8_WAIT_L(0); PG8_MMA(1, 0, At, B0); PG8_BAR; PG8_SCHED;
            PG8_STAGE(PG8_SB(1, 1), b3 + hstepB, voffB);
            PG8_WAIT_V(6); PG8_BAR; PG8_MMA(1, 1, At, B1); PG8_BAR;
            }
        }
        if constexpr (ALIGN_EPI) { if (wr == 0) PG8_BAR; }
        if constexpr (!Epi::AFTER_DRAIN) { int le = lane; asm volatile("" : "+v"(le)); E(acc, cur, wr, wc, le & 15, le >> 4, lds + EPI_SCR_OFF, tid); S.done(cur); }
        if (!has_next) break;
#pragma unroll
        for (int a = 0; a < 2; ++a)
#pragma unroll
            for (int b = 0; b < 2; ++b)
#pragma unroll
                for (int m = 0; m < 4; ++m)
#pragma unroll
                    for (int n = 0; n < 2; ++n) acc[a][b][m][n] = (f32x4){0.f, 0.f, 0.f, 0.f};
        cur = nxt; cA = nA; cB = nB; ++ui;
        if constexpr (ALIGN_EPI) { if (wr == 1) PG8_BAR; }
    }
    PG8_WAIT_V(0);
    if constexpr (!ALIGN_EPI) { if (wr == 0) PG8_BAR; }
    PG8_BAR;
#undef PG8_SA
#undef PG8_SB
#undef PG8_STAGE
#undef PG8_LDA
#undef PG8_LDB
#undef PG8_MMA
#undef PG8_WAIT_V
#undef PG8_WAIT_L
#undef PG8_BAR
#undef PG8_SCHED
}
}

#define GAS __attribute__((address_space(1)))
#define LAS __attribute__((address_space(3)))
typedef unsigned short bf16;
typedef unsigned v4u __attribute__((ext_vector_type(4)));
typedef unsigned v2u __attribute__((ext_vector_type(2)));
typedef float f32x4 __attribute__((ext_vector_type(4)));
typedef float f32x2 __attribute__((ext_vector_type(2)));
typedef float f32x16 __attribute__((ext_vector_type(16)));
typedef short bf16x8 __attribute__((ext_vector_type(8)));
typedef short s16x4 __attribute__((ext_vector_type(4)));
typedef GAS unsigned gu32;
#define RLX_AGENT __ATOMIC_RELAXED, __HIP_MEMORY_SCOPE_AGENT
#define LDS_WAIT() asm volatile("s_waitcnt lgkmcnt(0)" ::: "memory")
#define VM_WAIT() asm volatile("s_waitcnt vmcnt(0)" ::: "memory")
__device__ __forceinline__ unsigned f2bf(float f) { unsigned u = __builtin_bit_cast(unsigned, f); return (u + 0x7fffu + ((u >> 16) & 1u)) >> 16; }
__device__ __forceinline__ unsigned pk2(float lo, float hi) { return f2bf(lo) | (f2bf(hi) << 16); }
__device__ __forceinline__ float bf2f(unsigned short b) { return __builtin_bit_cast(float, (unsigned)b << 16); }

constexpr int NWAVES = 8;
constexpr size_t MiB = 1u << 20;
constexpr size_t WS_CTL = 0, CTL_ZERO_BYTES = 64 * 1024;
constexpr size_t WS_ROPE = 1 * MiB;
constexpr size_t WS_SSQ = 2 * MiB;
constexpr size_t WS_WQKV = 4 * MiB, WS_WO = 7 * MiB, WS_WPOOL = 9 * MiB;
constexpr size_t WS_W1 = 10 * MiB, W1_BYTES = (size_t)2 * DFF * DM * 2;
constexpr size_t WS_W2 = 54 * MiB, W2_BYTES = (size_t)DM * DFF * 2;
constexpr size_t WS_XB = 76 * MiB;
constexpr size_t WS_H = 110 * MiB;
constexpr size_t WS_P = WS_H, WS_Q = WS_H, WS_O = WS_H + 34 * MiB, WS_K = WS_H + 68 * MiB, WS_V = WS_H + 77 * MiB;
constexpr size_t WS_SLAB = 204 * MiB;
constexpr int NSPLIT = 11;
constexpr size_t WS_END = 248 * MiB;
static_assert(WS_W1 + 4 * W1_BYTES <= WS_W2 && WS_W2 + 4 * W2_BYTES <= WS_XB && WS_XB + (size_t)MT * DM * 2 <= WS_H && WS_H + (size_t)MT * DFF * 2 <= WS_END, "ws map");
static_assert(WS_V + (size_t)MT * KVD * 2 <= WS_END && WS_K + (size_t)MT * KVD * 2 <= WS_V && WS_O + (size_t)MT * DM * 2 <= WS_K, "ws map 2");
constexpr int CW_BAR = 4096;
constexpr int RING_OFF = 0, RING_BYTES = 131072;
constexpr int LDSCTL_OFF = RING_BYTES, MISC_OFF = LDSCTL_OFF + 320;
constexpr int LDS_BYTES = 147456;

#define XB_TMO      128
#define XB_XCNT(j)  (256  + 64 * (j))
#define XB_XSUB(j)  (1280 + 64 * (j))
#define XB_XGEN(j)  (2304 + 64 * (j))
#define XB_TOP      3328
#define XB_TOPGEN   3392
#define XCD_BAR_WORDS 3456
#define XB_SPIN_CAP (1u << 18)
__device__ __forceinline__ unsigned xb_ld(unsigned* p)              { return __hip_atomic_load(p, __ATOMIC_RELAXED, __HIP_MEMORY_SCOPE_AGENT); }
__device__ __forceinline__ unsigned xb_add(unsigned* p, unsigned v) { return __hip_atomic_fetch_add(p, v, __ATOMIC_RELAXED, __HIP_MEMORY_SCOPE_AGENT); }
__device__ __forceinline__ unsigned xb_xcc_id() { return (unsigned)__builtin_amdgcn_s_getreg((3 << 11) | 20) & 0xFu; }
#define XB_SPIN(cond, bar) do { unsigned _sp = 0; while (cond) { __builtin_amdgcn_s_sleep(1); \
    if ((++_sp & 255u) == 0u) { if (xb_ld(&(bar)[XB_TMO])) break; if (_sp > XB_SPIN_CAP) { atomicAdd(&(bar)[XB_TMO], 1u); break; } } } } while (0)
struct XcdBarrier { unsigned* bar; unsigned x; volatile LAS unsigned* st; };
__device__ __forceinline__ XcdBarrier xcd_barrier_post(unsigned* bar, volatile LAS unsigned* st) {
    XcdBarrier b; b.bar = bar; b.x = xb_xcc_id(); b.st = st;
    if (threadIdx.x == 0) (void)xb_add(&bar[XB_XCNT(b.x)], 1u);
    return b;
}
__device__ __forceinline__ void xcd_barrier_complete(unsigned* bar, unsigned x, unsigned& nloc, unsigned& nx) {
    const unsigned G = gridDim.x * gridDim.y * gridDim.z;
    unsigned sum, cnt, mine, sp = 0u;
    for (;;) {
        sum = 0u; cnt = 0u; mine = 0u;
#pragma unroll
        for (unsigned j = 0; j < 16; ++j) { const unsigned c = xb_ld(&bar[XB_XCNT(j)]); sum += c; cnt += (c > 0u) ? 1u : 0u; mine = (j == x) ? c : mine; }
        if (sum == G) break;
        __builtin_amdgcn_s_sleep(1);
        if ((++sp & 255u) == 0u) { if (xb_ld(&bar[XB_TMO])) break; if (sp > XB_SPIN_CAP) { atomicAdd(&bar[XB_TMO], 1u); break; } }
    }
    nloc = mine > 0u ? mine : 1u; nx = cnt > 0u ? cnt : 1u;
}
__device__ __forceinline__ void xcd_barrier(const XcdBarrier& b) {
    asm volatile("s_waitcnt vmcnt(0)" ::: "memory");
    __syncthreads();
    if (threadIdx.x == 0) {
        unsigned* bar = b.bar;
        __builtin_amdgcn_s_waitcnt(0);
        unsigned nloc = b.st[0], nx = b.st[1];
        if (nloc == 0u) { xcd_barrier_complete(bar, b.x, nloc, nx); b.st[0] = nloc; b.st[1] = nx; }
        const unsigned old = xb_add(&bar[XB_XSUB(b.x)], 1u);
        const unsigned gen = old / nloc;
        if (old + 1u == (gen + 1u) * nloc) {
            __builtin_amdgcn_fence(__ATOMIC_RELEASE, "agent");
            asm volatile("s_waitcnt vmcnt(0)" ::: "memory");
            const unsigned og = xb_add(&bar[XB_TOP], 1u);
            const unsigned tg = og / nx;
            if (og + 1u == (tg + 1u) * nx) xb_add(&bar[XB_TOPGEN], 1u);
            else XB_SPIN(xb_ld(&bar[XB_TOPGEN]) == tg, bar);
            __builtin_amdgcn_fence(__ATOMIC_ACQUIRE, "agent");
            xb_add(&bar[XB_XGEN(b.x)], 1u);
            asm volatile("s_waitcnt vmcnt(0)" ::: "memory");
        } else {
            XB_SPIN(xb_ld(&bar[XB_XGEN(b.x)]) == gen, bar);
            __builtin_amdgcn_fence(__ATOMIC_ACQUIRE, "agent");
            asm volatile("s_waitcnt vmcnt(0)" ::: "memory");
        }
    }
    __syncthreads();
}

struct Frame {
    LAS unsigned char* lds;
    int tid, lane, wave, vcu, G;
};
__device__ __forceinline__ float wave_sum(float v, int lane) {
#pragma unroll
    for (int o = 1; o < 64; o <<= 1) v += pg8::xor_shfl(v, lane, o);
    return v;
}

__device__ __forceinline__ void transpose_item64(const float* W, int ldw, bf16* WT, int K, int drow0, int scolA, int scolB, int k0, const float* kscale, const float* nscale, float cscale, LAS unsigned char* T, int lane) {
    const int kq = lane >> 4, nq = lane & 15;
    const float* src = W + (size_t)(k0 + 4 * kq) * ldw + ((nq < 8) ? scolA + 4 * nq : scolB + 4 * (nq - 8));
    f32x4 v[4][4];
#pragma unroll
    for (int j = 0; j < 4; ++j)
#pragma unroll
        for (int i = 0; i < 4; ++i) v[j][i] = *(const f32x4*)(src + (size_t)(16 * j + i) * ldw);
    f32x4 ns = (f32x4){cscale, cscale, cscale, cscale};
    if (nscale) ns = *(const f32x4*)(nscale + drow0 + 4 * nq) * cscale;
#pragma unroll
    for (int j = 0; j < 4; ++j) {
        f32x4 ks = (f32x4){1.f, 1.f, 1.f, 1.f};
        if (kscale) ks = *(const f32x4*)(kscale + k0 + 16 * j + 4 * kq);
#pragma unroll
        for (int c = 0; c < 4; ++c) {
            const float sc = ns[c];
            v2u pk; pk.x = pk2(v[j][0][c] * ks[0] * sc, v[j][1][c] * ks[1] * sc); pk.y = pk2(v[j][2][c] * ks[2] * sc, v[j][3][c] * ks[3] * sc);
            const int n = 4 * nq + c, ch = (2 * j + (kq >> 1)) ^ (nq & 7);
            *(LAS v2u*)(T + n * 128 + ch * 16 + (kq & 1) * 8) = pk;
        }
    }
    LDS_WAIT(); asm volatile("" ::: "memory");
    const int c8 = lane & 7;
#pragma unroll
    for (int jj = 0; jj < 8; ++jj) { const int n = (lane >> 3) + 8 * jj;
        const v4u o = *(const LAS v4u*)(T + n * 128 + ((c8 ^ ((n >> 2) & 7)) * 16));
        *(GAS v4u*)(WT + (size_t)(drow0 + n) * K + k0 + 8 * c8) = o; }
    LDS_WAIT(); asm volatile("" ::: "memory");
}
struct Args { const float* in[20]; float* out; unsigned char* ws; int ph_lo, ph_hi; };
typedef const __attribute__((address_space(4))) Args* ArgsP;
struct Ptrs {
    ArgsP ap;
#define PTR_ACC(name, idx) __device__ __forceinline__ const float* name() const { return ap->in[idx]; }
    PTR_ACC(xp, 0) PTR_ACC(xs, 1) PTR_ACC(spool, 2) PTR_ACC(ck, 3) PTR_ACC(cv, 4) PTR_ACC(n1, 5) PTR_ACC(w1in, 6) PTR_ACC(w1out, 7) PTR_ACC(nmix, 8) PTR_ACC(n2, 9)
    PTR_ACC(w2in, 10) PTR_ACC(w2out, 11) PTR_ACC(poolw, 12) PTR_ACC(pscale, 13) PTR_ACC(wqkv, 14) PTR_ACC(bqkv, 15) PTR_ACC(wo, 16) PTR_ACC(bo, 17) PTR_ACC(sinks, 18) PTR_ACC(nfin, 19)
#undef PTR_ACC
    __device__ __forceinline__ float* out() const { return ap->out; }
    __device__ __forceinline__ unsigned char* ws() const { return ap->ws; }
};
__device__ __forceinline__ void p0_prologue(const Frame& F, const Ptrs& P) {
    LAS unsigned char* T = F.lds + RING_OFF + F.wave * 8192;
    const int gw = F.vcu * NWAVES + F.wave, NGW = F.G * NWAVES;
    constexpr int I_W1 = (DM / 64) * (2 * DFF / 64), I_W2 = (DFF / 64) * (DM / 64), I_FFN = I_W1 + I_W2;
    constexpr int I_QKV = (DM / 64) * (QKVN / 64), I_WO = (DM / 64) * (DM / 64), I_POOL = 4 * 4 * 4;
    constexpr int NITEMS = 4 * I_FFN + I_QKV + I_WO + I_POOL;
    unsigned char* ws = P.ws();
    for (int it = gw; it < NITEMS; it += NGW) {
        int r = it;
        if (r < 4 * I_FFN) {
            const int f = r / I_FFN; r -= f * I_FFN; const int layer = f >> 1, second = f & 1;
            if (r < I_W1) { const int nblk = 2 * DFF / 64, kb = r / nblk, nb = r % nblk, j = 64 * nb;
                const float* win = (second ? P.w2in() : P.w1in()) + (size_t)layer * DM * 2 * DFF;
                const float* gn = (second ? P.n2() : P.n1()) + layer * DM;
                const int scol = ((j >> 7) & 1) * DFF + (j >> 8) * 128 + (j & 127);
                transpose_item64(win, 2 * DFF, (bf16*)(ws + WS_W1 + f * W1_BYTES), DM, j, scol, scol + 32, 64 * kb, gn, nullptr, 1.0f, T, F.lane);
            } else { r -= I_W1; const int nblk = DM / 64, kb = r / nblk, nb = r % nblk;
                const float* wout = (second ? P.w2out() : P.w1out()) + (size_t)layer * DFF * DM;
                transpose_item64(wout, DM, (bf16*)(ws + WS_W2 + f * W2_BYTES), DFF, 64 * nb, 64 * nb, 64 * nb + 32, 64 * kb, nullptr, nullptr, 0.5f, T, F.lane); }
            continue;
        }
        r -= 4 * I_FFN;
        if (r < I_QKV) { const int nblk = QKVN / 64, kb = r / nblk, nb = r % nblk, j = 64 * nb;
            const int scol = (j >> 8) * 256 + ((j >> 5) & 3) * 64 + ((j >> 7) & 1) * 32;
            transpose_item64(P.wqkv(), QKVN, (bf16*)(ws + WS_WQKV), DM, j, scol, scol + 64, 64 * kb, P.nmix() + DM, nullptr, 1.0f, T, F.lane); continue; }
        r -= I_QKV;
        if (r < I_WO) { const int nblk = DM / 64, kb = r / nblk, nb = r % nblk;
            transpose_item64(P.wo(), DM, (bf16*)(ws + WS_WO), DM, 64 * nb, 64 * nb, 64 * nb + 32, 64 * kb, nullptr, nullptr, 1.0f, T, F.lane); continue; }
        r -= I_WO;
        { const int gi = r >> 4, kb = (r >> 2) & 3, nb = r & 3;
            transpose_item64(P.poolw() + (size_t)gi * 65536, 256, (bf16*)(ws + WS_WPOOL), 256, gi * 256 + 64 * nb, 64 * nb, 64 * nb + 32, 64 * kb, nullptr, P.pscale(), 1.0f, T, F.lane); }
    }
    {
        float* rope = (float*)(ws + WS_ROPE);
        const double r1 = 1.0 / sqrt(sqrt(sqrt(10.0)));
        for (int e = (F.vcu * NWAVES * 64) + F.tid; e < (TPS + TSS) * 32; e += F.G * NWAVES * 64) {
            const int pidx = e >> 5, d = e & 31; const int pos = pidx < TPS ? pidx : PAST + (pidx - TPS);
            double inv = 1.0; for (int i = 0; i < d; ++i) inv *= r1;
            double turns = (double)pos * inv * 0.15915494309189535; turns -= floor(turns);
            const float a = (float)(turns * 6.283185307179586);
            rope[2 * e] = cosf(a); rope[2 * e + 1] = sinf(a);
        }
    }
    {
        bf16* XB = (bf16*)(ws + WS_XB); float* SSQ = (float*)(ws + WS_SSQ);
        const float* xp = P.xp(); const float* xs = P.xs();
        for (int m0 = 4 * gw; m0 < MT; m0 += 4 * NGW) {
            f32x4 v[4][4];
#pragma unroll
            for (int r = 0; r < 4; ++r) { const int m = m0 + r; const float* xrow = (m < MP) ? xp + (size_t)m * DM : xs + (size_t)(m - MP) * DM;
#pragma unroll
                for (int j = 0; j < 4; ++j) v[r][j] = ((const GAS f32x4*)xrow)[64 * j + F.lane]; }
#pragma unroll
            for (int r = 0; r < 4; ++r) { const int m = m0 + r; float sq = 0.f;
#pragma unroll
                for (int j = 0; j < 4; ++j) sq += (v[r][j][0] * v[r][j][0] + v[r][j][1] * v[r][j][1]) + (v[r][j][2] * v[r][j][2] + v[r][j][3] * v[r][j][3]);
                sq = wave_sum(sq, F.lane);
                GAS unsigned long long* o8 = (GAS unsigned long long*)(XB + (size_t)m * DM) + F.lane;
#pragma unroll
                for (int j = 0; j < 4; ++j) o8[64 * j] = (unsigned long long)pk2(v[r][j][0], v[r][j][1]) | ((unsigned long long)pk2(v[r][j][2], v[r][j][3]) << 32);
                if (F.lane < 4) SSQ[(size_t)m * 4 + F.lane] = (F.lane == 0) ? sq : 0.f; }
        }
    }
}

template <int WG, int NROWS>
__device__ __forceinline__ void pool_rows(const bf16* X, int r0, int tpos0, const float* hist_raw  , bool hist_x, const LAS float* rs  ,
                                          f32x2 g, int c0, bf16* Pm, float* np_out  , int np_t0) {
    f32x2 h[16];
#pragma unroll
    for (int k = 0; k < 16; ++k) h[k] = (f32x2){0.f, 0.f};
    if (hist_x) {
#pragma unroll
        for (int k = 1; k < 16; ++k) { const unsigned w = *(const unsigned*)(X + (size_t)(r0 - 16 + k) * DM + c0); const f32x2 x = (f32x2){__builtin_bit_cast(float, w << 16), __builtin_bit_cast(float, w & 0xffff0000u)}; h[k] = x * rs[k - 1] * g; }
    } else if (hist_raw) {
#pragma unroll
        for (int k = 1; k < 16; ++k) h[k] = *(const f32x2*)(hist_raw + (size_t)(k - 1) * DM + c0);
    }
    for (int blk = 0; blk < (NROWS + 15) / 16; ++blk) {
#pragma unroll
        for (int k = 0; k < 16; ++k) {
            if (blk * 16 + k < NROWS) {
                const int lr = blk * 16 + k, row = r0 + lr, tpos = tpos0 + lr;
                const unsigned w = *(const unsigned*)(X + (size_t)row * DM + c0); const f32x2 x = (f32x2){__builtin_bit_cast(float, w << 16), __builtin_bit_cast(float, w & 0xffff0000u)};
                const f32x2 u = x * rs[15 + lr] * g;
                h[k] = u;
                f32x2 s = u;
#pragma unroll
                for (int j = 1; j < WG; ++j) s += h[(k - j) & 15];
                const int cnt = (tpos + 1 < WG) ? tpos + 1 : WG;
                const f32x2 p = s * (1.0f / (float)cnt) - u;
                *(unsigned*)(Pm + (size_t)row * DM + c0) = pk2(p[0], p[1]);
                if (tpos >= np_t0) *(f32x2*)(np_out + (size_t)(tpos - np_t0) * DM + c0) = u;
            }
        }
    }
}
template <int NROWS>
__device__ __forceinline__ void pool_unit(const Frame& F, const Ptrs& P, int r0, int tpos0, const float* hist_raw, bool hist_x, float* np_out, int np_t0) {
    const bf16* X = (const bf16*)(P.ws() + WS_XB); const float* SSQ = (const float*)(P.ws() + WS_SSQ); bf16* Pm = (bf16*)(P.ws() + WS_P);
    LAS float* rs = (LAS float*)(F.lds + RING_OFF);
    __syncthreads();
    if (F.tid < 15 + NROWS) { const int row = r0 - 15 + F.tid; rs[F.tid] = (F.tid >= 15 || hist_x) ? pg8::row_rstd(SSQ, row) : 0.f; }
    __syncthreads();
    const int c0 = 2 * F.tid; const f32x2 g = *(const f32x2*)(P.nmix() + c0);
    const int gi = F.tid >> 7;
    if (gi == 0) pool_rows<2, NROWS>(X, r0, tpos0, hist_raw, hist_x, rs, g, c0, Pm, np_out, np_t0);
    else if (gi == 1) pool_rows<4, NROWS>(X, r0, tpos0, hist_raw, hist_x, rs, g, c0, Pm, np_out, np_t0);
    else if (gi == 2) pool_rows<8, NROWS>(X, r0, tpos0, hist_raw, hist_x, rs, g, c0, Pm, np_out, np_t0);
    else pool_rows<16, NROWS>(X, r0, tpos0, hist_raw, hist_x, rs, g, c0, Pm, np_out, np_t0);
}
__device__ __forceinline__ void pool_phase(const Frame& F, const Ptrs& P) {
    for (int u = F.vcu; u < MP / 64; u += F.G) {
        const int r0 = u * 64, b = r0 >> 11, t0 = r0 & (TPS - 1);
        pool_unit<64>(F, P, r0, t0, nullptr, t0 > 0, P.out() + O_POOLP + (size_t)b * 15 * DM, TPS - 15);
    }
    for (int b = F.vcu; b < NSB; b += F.G) {
        const float* sp = P.spool() + (size_t)b * 15 * DM; float* np = P.out() + O_POOLS + (size_t)b * 15 * DM;
        for (int e = F.tid; e < 7 * DM / 4; e += NWAVES * 64) ((f32x4*)np)[e] = ((const f32x4*)(sp + 8 * DM))[e];
        pool_unit<8>(F, P, MP + b * TSS, PAST, sp, false, np, PAST - 7);
    }
}

namespace att {
constexpr int LDS_K = 0, LDS_V = 3 * 8192, LDS_WS = 6 * 8192, LDS_OST = LDS_WS + NWAVES * 256, LDS_TOTAL = LDS_OST + NWAVES * 4096;
__device__ __forceinline__ int crow(int r, int hi) { return (r & 3) + 8 * (r >> 2) + 4 * hi; }
__device__ __forceinline__ unsigned cvtpk_s(float lo, float hi) { typedef float f2 __attribute__((ext_vector_type(2))); typedef __bf16 b2 __attribute__((ext_vector_type(2))); f2 v = {lo, hi}; b2 b = __builtin_convertvector(v, b2); return __builtin_bit_cast(unsigned, b); }
typedef short v4i16_t __attribute__((ext_vector_type(4)));
__device__ __forceinline__ s16x4 vtr(const LAS unsigned char* p) { return __builtin_bit_cast(s16x4, __builtin_amdgcn_ds_read_tr16_b64_v4i16((LAS v4i16_t*)p)); }
constexpr float NEG = -1.0e30f;

struct Soft { v4u pa[5][2]; float l; };
__device__ __forceinline__ void softmax5(f32x16 (&sc)[5], float sk, Soft& R) {
    float m = sk;
#pragma unroll
    for (int i = 0; i < 5; ++i)
#pragma unroll
        for (int r = 0; r < 16; ++r) m = fmaxf(m, sc[i][r]);
    { auto rr = __builtin_amdgcn_permlane32_swap(__float_as_uint(m), __float_as_uint(m), false, false); m = fmaxf(__uint_as_float(rr[0]), __uint_as_float(rr[1])); }
    float l = 0.f;
#pragma unroll
    for (int i = 0; i < 5; ++i) {
#pragma unroll
        for (int r = 0; r < 16; ++r) { const float p = __builtin_amdgcn_exp2f(sc[i][r] - m); sc[i][r] = p; l += p; }
#pragma unroll
        for (int s = 0; s < 2; ++s) R.pa[i][s] = (v4u){cvtpk_s(sc[i][8 * s + 0], sc[i][8 * s + 1]), cvtpk_s(sc[i][8 * s + 2], sc[i][8 * s + 3]), cvtpk_s(sc[i][8 * s + 4], sc[i][8 * s + 5]), cvtpk_s(sc[i][8 * s + 6], sc[i][8 * s + 7])};
    }
    { auto rr = __builtin_amdgcn_permlane32_swap(__float_as_uint(l), __float_as_uint(l), false, false); l = __uint_as_float(rr[0]) + __uint_as_float(rr[1]); }
    R.l = l + __builtin_amdgcn_exp2f(sk - m);
}

__device__ __forceinline__ void prompt_unit(const Frame& F, int b, int kvh, int qb, const bf16* Q, const bf16* K, const bf16* V, bf16* O, const float* sinks) {
    const int lane = F.lane, wid = F.wave, r32 = lane & 31, hi = lane >> 5;
    LAS unsigned char* lds = F.lds + RING_OFF;
    const int q0 = qb * 64, jmin = (qb >= 2) ? 0 : 2 - qb;
    const long rowbase = (long)b * TPS;
    __syncthreads();
#pragma unroll
    for (int j = 0; j < 3; ++j) if (j >= jmin) {
        const long kr0 = rowbase + q0 - 128 + 64 * j;
        const v4u kv = *(const v4u*)(K + (kr0 + lane) * KVD + kvh * 64 + wid * 8);
        *(LAS v4u*)(lds + LDS_K + j * 8192 + wid * 1024 + lane * 16) = kv;
        const v4u vv = *(const v4u*)(V + (kr0 + 16 * (wid & 3) + (lane >> 2)) * KVD + kvh * 64 + (wid >> 2) * 32 + (lane & 3) * 8);
        *(LAS v4u*)(lds + LDS_V + j * 8192 + wid * 1024 + lane * 16) = vv;
    }
    const int g = wid >> 1, half = wid & 1, h = 4 * kvh + g;
    const bf16* Qw = Q + (rowbase + q0 + 32 * half) * DM + h * HD;
    bf16x8 qr[4];
#pragma unroll
    for (int d0 = 0; d0 < 4; ++d0) qr[d0] = *(const bf16x8*)(Qw + (long)r32 * DM + d0 * 16 + hi * 8);
    const float sk = sinks[h] * LOG2E;
    __syncthreads();
    f32x16 sc[5];
#pragma unroll
    for (int i = 0; i < 5; ++i) {
        const int kb = half + i, tile = kb >> 1, p = kb & 1;
        if (tile >= jmin) {
            const LAS unsigned char* kp = lds + LDS_K + tile * 8192 + p * 512 + hi * 1024 + r32 * 16;
            f32x16 a = {};
#pragma unroll
            for (int d0 = 0; d0 < 4; ++d0) a = __builtin_amdgcn_mfma_f32_32x32x16_bf16(*(const LAS bf16x8*)(kp + d0 * 2048), qr[d0], a, 0, 0, 0);
            sc[i] = a;
        } else {
#pragma unroll
            for (int r = 0; r < 16; ++r) sc[i][r] = NEG;
        }
    }
#pragma unroll
    for (int r = 0; r < 16; ++r) { const int kk = crow(r, hi); if (!(kk > r32)) sc[0][r] = NEG; if (!(kk <= r32)) sc[4][r] = NEG; }
    Soft S; softmax5(sc, sk, S);
    f32x16 o[2]; o[0] = f32x16{}; o[1] = f32x16{};
#pragma unroll
    for (int i = 0; i < 5; ++i) {
        const int kb = half + i, tile = kb >> 1, p = kb & 1;
        if (tile >= jmin) {
            const LAS unsigned char* vp = lds + LDS_V + tile * 8192 + ((lane >> 4) & 1) * 32 + (lane & 3) * 8 + (4 * hi + ((lane & 15) >> 2)) * 64;
#pragma unroll
            for (int s = 0; s < 2; ++s)
#pragma unroll
                for (int d0 = 0; d0 < 2; ++d0) {
                    const s16x4 lo = vtr(vp + d0 * 4096 + (2 * p + s) * 1024), hh = vtr(vp + d0 * 4096 + (2 * p + s) * 1024 + 512);
                    const bf16x8 vf = (bf16x8){lo[0], lo[1], lo[2], lo[3], hh[0], hh[1], hh[2], hh[3]};
                    o[d0] = __builtin_amdgcn_mfma_f32_32x32x16_bf16(__builtin_bit_cast(bf16x8, S.pa[i][s]), vf, o[d0], 0, 0, 0);
                }
        }
    }
    LAS float* wsf = (LAS float*)(lds + LDS_WS) + wid * 64;
    if (hi == 0) wsf[r32] = S.l;
    LDS_WAIT();
    LAS bf16* stg = (LAS bf16*)(lds + LDS_OST) + wid * 2048;
#pragma unroll
    for (int r = 0; r < 16; ++r) { const int orow = crow(r, hi); const float rl = __builtin_amdgcn_rcpf(wsf[orow]);
#pragma unroll
        for (int d0 = 0; d0 < 2; ++d0) stg[orow * 64 + d0 * 32 + r32] = (bf16)f2bf(o[d0][r] * rl); }
    LDS_WAIT();
    bf16* Ow = O + (rowbase + q0 + 32 * half) * DM + h * HD;
#pragma unroll
    for (int i = 0; i < 4; ++i) { const int row = i * 8 + (lane >> 3), ch = lane & 7; const v4u v = *(const LAS v4u*)(stg + row * 64 + ch * 8); *(v4u*)(Ow + (long)row * DM + ch * 8) = v; }
}

__device__ __forceinline__ void sample_unit(int lane, int b, int kvh, const bf16* Q, const bf16* Kn, const bf16* Vn, const float* ck, const float* cv, bf16* O, const float* sinks, LAS float* wsf) {
    const int r32 = lane & 31, hi = lane >> 5, qi = r32 & 7, h = 4 * kvh + (r32 >> 3);
    const long qrow = (long)MP + b * TSS + qi;
    bf16x8 qr[4];
#pragma unroll
    for (int d0 = 0; d0 < 4; ++d0) qr[d0] = *(const bf16x8*)(Q + qrow * DM + h * HD + d0 * 16 + hi * 8);
    const float sk = sinks[h] * LOG2E;
    f32x16 sc[5];
#pragma unroll
    for (int blk = 0; blk < 4; ++blk) {
        f32x16 a = {};
        const float* kp = ck + ((size_t)(b * 128 + 32 * blk + r32) * NKV + kvh) * HD + hi * 8;
#pragma unroll
        for (int d0 = 0; d0 < 4; ++d0) { const f32x4 x0 = *(const f32x4*)(kp + d0 * 16), x1 = *(const f32x4*)(kp + d0 * 16 + 4);
            const v4u kw = (v4u){cvtpk_s(x0[0], x0[1]), cvtpk_s(x0[2], x0[3]), cvtpk_s(x1[0], x1[1]), cvtpk_s(x1[2], x1[3])};
            a = __builtin_amdgcn_mfma_f32_32x32x16_bf16(__builtin_bit_cast(bf16x8, kw), qr[d0], a, 0, 0, 0); }
        sc[blk] = a;
    }
    {
        f32x16 a = {};
        const bf16* kp = Kn + ((long)MP + b * TSS + (r32 & 7)) * KVD + kvh * HD + hi * 8;
#pragma unroll
        for (int d0 = 0; d0 < 4; ++d0) { v4u kw = *(const v4u*)(kp + d0 * 16); if (r32 >= 8) kw = (v4u){0u, 0u, 0u, 0u};
            a = __builtin_amdgcn_mfma_f32_32x32x16_bf16(__builtin_bit_cast(bf16x8, kw), qr[d0], a, 0, 0, 0); }
        sc[4] = a;
    }
#pragma unroll
    for (int blk = 0; blk < 5; ++blk)
#pragma unroll
        for (int r = 0; r < 16; ++r) { const int j = 32 * blk + crow(r, hi); if (!(j >= qi + 1 && j <= 128 + qi)) sc[blk][r] = NEG; }
    Soft S; softmax5(sc, sk, S);
    f32x16 o[2]; o[0] = f32x16{}; o[1] = f32x16{};
#pragma unroll
    for (int blk = 0; blk < 4; ++blk)
#pragma unroll
        for (int s = 0; s < 2; ++s)
#pragma unroll
            for (int d0 = 0; d0 < 2; ++d0) {
                float vv[8];
#pragma unroll
                for (int jj = 0; jj < 8; ++jj) { const int key = 32 * blk + 16 * s + 8 * (jj >> 2) + 4 * hi + (jj & 3); vv[jj] = cv[((size_t)(b * 128 + key) * NKV + kvh) * HD + d0 * 32 + r32]; }
                const v4u vw = (v4u){cvtpk_s(vv[0], vv[1]), cvtpk_s(vv[2], vv[3]), cvtpk_s(vv[4], vv[5]), cvtpk_s(vv[6], vv[7])};
                o[d0] = __builtin_amdgcn_mfma_f32_32x32x16_bf16(__builtin_bit_cast(bf16x8, S.pa[blk][s]), __builtin_bit_cast(bf16x8, vw), o[d0], 0, 0, 0);
            }
#pragma unroll
    for (int d0 = 0; d0 < 2; ++d0) {
        unsigned short e[4];
#pragma unroll
        for (int jj = 0; jj < 4; ++jj) e[jj] = Vn[((long)MP + b * TSS + 4 * hi + jj) * KVD + kvh * HD + d0 * 32 + r32];
        const v4u vw = (v4u){(unsigned)e[0] | ((unsigned)e[1] << 16), (unsigned)e[2] | ((unsigned)e[3] << 16), 0u, 0u};
        o[d0] = __builtin_amdgcn_mfma_f32_32x32x16_bf16(__builtin_bit_cast(bf16x8, S.pa[4][0]), __builtin_bit_cast(bf16x8, vw), o[d0], 0, 0, 0);
    }
    if (hi == 0) wsf[r32] = S.l;
    LDS_WAIT();
#pragma unroll
    for (int r = 0; r < 16; ++r) { const int q = crow(r, hi); const float rl = __builtin_amdgcn_rcpf(wsf[q]);
        bf16* orow = O + ((long)MP + b * TSS + (q & 7)) * DM + (4 * kvh + (q >> 3)) * HD + r32;
#pragma unroll
        for (int d0 = 0; d0 < 2; ++d0) orow[d0 * 32] = (bf16)f2bf(o[d0][r] * rl); }
    LDS_WAIT();
}

__device__ __forceinline__ void attn_phase(const Frame& F, const Ptrs& P) {
    const bf16* Q = (const bf16*)(P.ws() + WS_Q); const bf16* K = (const bf16*)(P.ws() + WS_K); const bf16* V = (const bf16*)(P.ws() + WS_V); bf16* O = (bf16*)(P.ws() + WS_O);
    constexpr int NPU = NPB * NKV * 32;
    const int per = (NPU + F.G - 1) / F.G;
    for (int i = 0; i < per; ++i) { const int u = F.vcu * per + i; if (u < NPU) prompt_unit(F, u >> 7, (u >> 5) & 3, u & 31, Q, K, V, O, P.sinks()); }
    __syncthreads();
    LAS float* wsf = (LAS float*)(F.lds + RING_OFF + LDS_WS) + F.wave * 64;
    const int gw = F.vcu * NWAVES + F.wave, NGW = F.G * NWAVES;
    for (int u = gw; u < NSB * NKV; u += NGW) sample_unit(F.lane, u >> 2, u & 3, Q, K, V, P.ck(), P.cv(), O, P.sinks(), wsf);
    {
        constexpr int PER_B = 120 * KVD / 4;
        const int gt = F.vcu * NWAVES * 64 + F.tid, NT = F.G * NWAVES * 64;
        for (int e = gt; e < 2 * NSB * PER_B; e += NT) {
            const int which = e / (NSB * PER_B), r = e - which * (NSB * PER_B), b = r / PER_B, w = r - b * PER_B;
            const f32x4* src = (const f32x4*)(which ? P.cv() : P.ck()) + (size_t)b * (128 * KVD / 4) + (8 * KVD / 4) + w;
            f32x4* dst = (f32x4*)(P.out() + (which ? O_VS : O_KS)) + (size_t)b * (128 * KVD / 4) + w;
            *dst = *src;
        }
    }
}
}

__device__ __forceinline__ void final_phase(const Frame& F, const Ptrs& P) {
    float* Y = P.out() + O_Y; const bf16* XB = (const bf16*)(P.ws() + WS_XB); const float* SSQ = (const float*)(P.ws() + WS_SSQ);
    const int gw = F.vcu * NWAVES + F.wave, NGW = F.G * NWAVES;
    f32x4 gv[4];
#pragma unroll
    for (int j = 0; j < 4; ++j) gv[j] = ((const f32x4*)P.nfin())[64 * j + F.lane];
    for (int m0 = 4 * gw; m0 < MT; m0 += 4 * NGW) {
        v2u w[4][4]; float rs[4];
#pragma unroll
        for (int r = 0; r < 4; ++r) { rs[r] = pg8::row_rstd(SSQ, m0 + r);
#pragma unroll
            for (int j = 0; j < 4; ++j) w[r][j] = ((const v2u*)(XB + (size_t)(m0 + r) * DM))[64 * j + F.lane]; }
#pragma unroll
        for (int r = 0; r < 4; ++r)
#pragma unroll
            for (int j = 0; j < 4; ++j) ((f32x4*)(Y + (size_t)(m0 + r) * DM))[64 * j + F.lane] = pg8::bf4_to_f32(w[r][j]) * rs[r] * gv[j];
    }
}

__device__ __forceinline__ void fix_phase(const Frame& F, const Ptrs& P, float accs) {
    const f32x4* slab4 = (const f32x4*)(P.ws() + WS_SLAB);
    bf16* XB = (bf16*)(P.ws() + WS_XB); float* SSQ = (float*)(P.ws() + WS_SSQ);
    LAS float* scr = (LAS float*)(F.lds + RING_OFF);
    const int wid = F.wave, wr = wid >> 2, wc = wid & 3, fr = F.lane & 15, fq = F.lane >> 4;
    for (int u = F.vcu; u < 128; u += F.G) {
        const int t = u >> 3, rg = u & 7, ai = rg >> 2, m = rg & 3, pn = t & 3;
        const int row = MP + (t >> 2) * 256 + ai * 128 + wr * 64 + m * 16 + fr, col0 = pn * 256 + wc * 32 + 4 * fq;
        bf16* xbp = XB + (size_t)row * DM + col0;
        v2u xo[2][2];
#pragma unroll
        for (int bj = 0; bj < 2; ++bj)
#pragma unroll
            for (int n = 0; n < 2; ++n) xo[bj][n] = *(const v2u*)(xbp + bj * 128 + n * 16);
        f32x4 sum[2][2];
#pragma unroll
        for (int bj = 0; bj < 2; ++bj)
#pragma unroll
            for (int n = 0; n < 2; ++n) sum[bj][n] = (f32x4){0.f, 0.f, 0.f, 0.f};
#pragma unroll 4
        for (int sp = 0; sp < NSPLIT; ++sp) {
            const f32x4* sl = slab4 + ((size_t)(sp * 16 + t) * 32 + ai * 16 + m * 2) * 512 + F.tid;
#pragma unroll
            for (int bj = 0; bj < 2; ++bj)
#pragma unroll
                for (int n = 0; n < 2; ++n) sum[bj][n] += sl[(size_t)(bj * 8 + n) * 512];
        }
        float sm = 0.f;
#pragma unroll
        for (int bj = 0; bj < 2; ++bj)
#pragma unroll
            for (int n = 0; n < 2; ++n) {
                const f32x4 v = pg8::bf4_to_f32(xo[bj][n]) + sum[bj][n] * accs;
                *(v2u*)(xbp + bj * 128 + n * 16) = (v2u){pg8::cvt_pk_bf16(v[0], v[1]), pg8::cvt_pk_bf16(v[2], v[3])};
                sm += (v[0] * v[0] + v[1] * v[1]) + (v[2] * v[2] + v[3] * v[3]);
            }
        sm += pg8::xor_shfl(sm, F.lane, 16); sm += pg8::xor_shfl(sm, F.lane, 32);
        __syncthreads();
        if (fq == 0) scr[(wr * 16 + fr) * 4 + wc] = sm;
        __syncthreads();
        if (F.tid < 32) { const f32x4 p = *(const LAS f32x4*)(scr + F.tid * 4); const int r2 = MP + (t >> 2) * 256 + ai * 128 + (F.tid >> 4) * 64 + m * 16 + (F.tid & 15);
            SSQ[(size_t)r2 * 4 + pn] = (p[0] + p[1]) + (p[2] + p[3]); }
    }
}

constexpr int NPHASES = 19;
__global__ void __launch_bounds__(NWAVES * 64, 2) mk_fwd(Args args) {
    extern __shared__ __attribute__((aligned(16))) unsigned char lds_raw[];
    {
        LAS unsigned char* l0 = (LAS unsigned char*)lds_raw;
        for (int u = threadIdx.x; u < (LDS_BYTES - LDSCTL_OFF) / 4; u += NWAVES * 64) ((LAS unsigned*)(l0 + LDSCTL_OFF))[u] = 0u;
        __syncthreads();
    }
    const int lo = args.ph_lo, hi = args.ph_hi;
    const int wave0 = __builtin_amdgcn_readfirstlane(threadIdx.x >> 6);
    if (hi - lo > 1) (void)xcd_barrier_post((unsigned*)(args.ws + WS_CTL) + CW_BAR, (volatile LAS unsigned*)((LAS unsigned char*)lds_raw + MISC_OFF) + 8);
    for (int it = 2 * lo; it < 2 * hi; ++it) {
        const int ph = it >> 1; const bool dup = (it & 1) != 0;
        if (dup && !((DUP_MASK >> ph) & 1)) continue;
        int wv_ = wave0; asm volatile("" : "+s"(wv_));
        unsigned z_ = 0u; asm volatile("" : "+v"(z_));
        int tid = wv_ * 64 + (int)__builtin_amdgcn_mbcnt_hi(~0u, __builtin_amdgcn_mbcnt_lo(~0u, z_)); asm volatile("" : "+v"(tid));
        int bx = blockIdx.x, G = gridDim.x; asm volatile("" : "+s"(bx), "+s"(G));
        ArgsP ap = (ArgsP)__builtin_amdgcn_kernarg_segment_ptr(); asm volatile("" : "+s"(ap));
        Frame F;
        F.lds = (LAS unsigned char*)lds_raw;
        F.tid = tid; F.lane = tid & 63; F.wave = __builtin_amdgcn_readfirstlane(tid >> 6);
        F.G = G; F.vcu = (G % 8 == 0) ? (bx % 8) * (G / 8) + bx / 8 : bx;
        Ptrs P; P.ap = ap;
        unsigned char* ws = P.ws();
        bf16* XB = (bf16*)(ws + WS_XB); bf16* Hb = (bf16*)(ws + WS_H); float* SSQ = (float*)(ws + WS_SSQ);
        const int kind = (ph < 16) ? (int)((0x1876321321543210ull >> (4 * ph)) & 15ull) : (int)((0x932u >> (4 * (ph - 16))) & 15u);
        const int f = (ph < 4) ? 0 : (ph < 9) ? 1 : (ph < 12) ? 2 : 3;
        if (kind == 0 && (PHMASK & 1)) {
            p0_prologue(F, P);
        } else if (kind == 1 && (PHMASK & 2)) {
            pg8::Gemm g{XB, (const bf16*)(ws + WS_W1 + f * W1_BYTES), MT, 2 * DFF, DM, DM, DM, 0};
            pg8::StaticOrder S; S.init(MT, 2 * DFF, F.G, bx);
            pg8::EpiSwiglu E{(dup && PROBE_NULL_EPI) ? nullptr : Hb, SSQ};
            pg8::gemm_phase<pg8::EpiSwiglu, pg8::StaticOrder, true, true>(F.lds + RING_OFF, g, S, E, F.tid);
        } else if ((kind == 2 || kind == 5 || kind == 8) && (PHMASK & 4)) {
            pg8::Gemm g; pg8::EpiRes E; int mrows = MT;
            E.xb = XB; E.ssq = SSQ; E.bias = nullptr; E.accs = dup ? 0.f : 1.f;
            if (kind == 5) { g = pg8::Gemm{(const bf16*)(ws + WS_P), (const bf16*)(ws + WS_WPOOL), MT, DM, 256, DM, 256, 256}; }
            else if (kind == 8) { g = pg8::Gemm{(const bf16*)(ws + WS_O), (const bf16*)(ws + WS_WO), MT, DM, DM, DM, DM, 0}; E.bias = dup ? nullptr : P.bo(); }
            else { g = pg8::Gemm{Hb, (const bf16*)(ws + WS_W2 + f * W2_BYTES), MP, DM, DFF, DFF, DFF, 0}; mrows = MP;
            }
            if (dup && PROBE_NULL_EPI) E.xb = nullptr;
            pg8::StaticOrder S; S.init(mrows, DM, F.G, bx);
            pg8::gemm_phase<pg8::EpiRes, pg8::StaticOrder, true, true>(F.lds + RING_OFF, g, S, E, F.tid);
            if (kind == 2) {
                pg8::Gemm g2{Hb, (const bf16*)(ws + WS_W2 + f * W2_BYTES), MT, DM, 256, DFF, DFF, 0};
                pg8::SplitOrder S2{bx, 16 * NSPLIT};
                pg8::EpiSlab E2{(float*)(ws + WS_SLAB)};
                int tid2 = F.tid; asm volatile("" : "+v"(tid2));
                pg8::gemm_phase<pg8::EpiSlab, pg8::SplitOrder, true, true>(F.lds + RING_OFF, g2, S2, E2, tid2);
            }
        } else if (kind == 3 && (PHMASK & 128)) {
            fix_phase(F, P, dup ? 0.f : 1.f);
        } else if (kind == 4 && (PHMASK & 8)) {
            pool_phase(F, P);
        } else if (kind == 6 && (PHMASK & 16)) {
            pg8::Gemm g{XB, (const bf16*)(ws + WS_WQKV), MT, QKVN, DM, DM, DM, 0};
            pg8::StaticOrder S; S.init(MT, QKVN, F.G, bx);
            pg8::EpiQKV E{(bf16*)(ws + WS_Q), (bf16*)(ws + WS_K), (bf16*)(ws + WS_V), SSQ, P.bqkv(), (const float*)(ws + WS_ROPE), P.out()};
            pg8::gemm_phase<pg8::EpiQKV, pg8::StaticOrder, true, true>(F.lds + RING_OFF, g, S, E, F.tid);
        } else if (kind == 7 && (PHMASK & 32)) {
            att::attn_phase(F, P);
        } else if (kind == 9 && (PHMASK & 64)) {
            final_phase(F, P);
        }
        {
            ArgsP aq = (ArgsP)__builtin_amdgcn_kernarg_segment_ptr(); asm volatile("" : "+s"(aq));
            const int hi2 = aq->ph_hi, lo2 = aq->ph_lo;
            if ((it + 1 < 2 * hi2 - 1 || (DUP_MASK >> (hi2 - 1)) & 1) && hi2 - lo2 > 1) {
                XcdBarrier b2; b2.bar = (unsigned*)(aq->ws + WS_CTL) + CW_BAR; b2.x = xb_xcc_id(); b2.st = (volatile LAS unsigned*)((LAS unsigned char*)lds_raw + MISC_OFF) + 8;
                xcd_barrier(b2);
            }
        }
    }
}

extern "C" void kernel_launch(void* const* d_in, const int* in_sizes, int n_in, void* d_out, int out_size, void* d_ws, size_t ws_size, hipStream_t stream) {
    static int grid = 0;
    if (grid == 0) {
        if (n_in != 20 || (size_t)out_size != O_END || ws_size < WS_END) { fprintf(stderr, "kernel_launch: unexpected shapes (n_in %d out %d ws %zu)\n", n_in, out_size, ws_size); grid = -1; return; }
        int dev = 0, cus = 0, per_cu = 0;
        if (hipGetDevice(&dev) != hipSuccess || hipDeviceGetAttribute(&cus, hipDeviceAttributeMultiprocessorCount, dev) != hipSuccess) { grid = -1; return; }
        if (hipFuncSetAttribute((const void*)mk_fwd, hipFuncAttributeMaxDynamicSharedMemorySize, LDS_BYTES) != hipSuccess) { fprintf(stderr, "kernel_launch: hipFuncSetAttribute failed\n"); grid = -1; return; }
        if (hipOccupancyMaxActiveBlocksPerMultiprocessor(&per_cu, (const void*)mk_fwd, NWAVES * 64, LDS_BYTES) != hipSuccess || per_cu < 1)
            fprintf(stderr, "kernel_launch: occupancy query reports %d workgroups per CU\n", per_cu);
        (void)hipGetLastError();
        grid = cus;
    }
    if (grid < 0) return;
    (void)hipMemsetAsync((char*)d_ws + WS_CTL, 0, CTL_ZERO_BYTES, stream);
    Args a{};
    for (int i = 0; i < 20; ++i) a.in[i] = (const float*)d_in[i];
    a.out = (float*)d_out; a.ws = (unsigned char*)d_ws;
#if MK_ONE_LAUNCH
    a.ph_lo = 0; a.ph_hi = NPHASES;
    hipLaunchKernelGGL(mk_fwd, dim3(grid), dim3(NWAVES * 64), LDS_BYTES, stream, a);
#else
    for (int ph = 0; ph < NPHASES; ++ph) { a.ph_lo = ph; a.ph_hi = ph + 1; hipLaunchKernelGGL(mk_fwd, dim3(grid), dim3(NWAVES * 64), LDS_BYTES, stream, a); }
#endif
}
```

```cpp
#include <hip/hip_runtime.h>
#include <cstdio>
#include <cstdint>

#ifndef PHMASK
#define PHMASK 255
#endif
#ifndef PROBE_NULL_EPI
#define PROBE_NULL_EPI 0
#endif
#ifndef PROBE_POOL
#define PROBE_POOL 0
#endif
#ifndef DUP_MASK
#define DUP_MASK 0
#endif
#ifndef MK_ONE_LAUNCH
#define MK_ONE_LAUNCH 1
#endif

constexpr int DM = 1024, DFF = 2816, NPB = 8, TPS = 2048, MP = NPB * TPS, NSB = 128, TSS = 8, MS = NSB * TSS, MT = MP + MS;
constexpr int QKVN = 1536, NHEAD = 16, NKV = 4, HD = 64, KVD = 256;
constexpr int PAST = 8192;
constexpr float RMS_EPS = 1e-6f;
constexpr float LOG2E = 1.4426950408889634f;
constexpr float QSCALE = 0.125f * LOG2E;
constexpr size_t O_Y = 0;
constexpr size_t O_POOLP = (size_t)MT * DM;
constexpr size_t O_POOLS = O_POOLP + (size_t)NPB * 15 * DM;
constexpr size_t O_KP = O_POOLS + (size_t)NSB * 15 * DM;
constexpr size_t O_VP = O_KP + (size_t)NPB * 128 * KVD;
constexpr size_t O_KS = O_VP + (size_t)NPB * 128 * KVD;
constexpr size_t O_VS = O_KS + (size_t)NSB * 128 * KVD;
constexpr size_t O_END = O_VS + (size_t)NSB * 128 * KVD;

namespace pg8 {
#define PG8_LAS __attribute__((address_space(3)))
typedef unsigned short bf16_t;
typedef short bf16x8 __attribute__((ext_vector_type(8)));
typedef float f32x4 __attribute__((ext_vector_type(4)));
typedef float f32x2 __attribute__((ext_vector_type(2)));
typedef unsigned u32x4 __attribute__((ext_vector_type(4)));
typedef unsigned u32x2 __attribute__((ext_vector_type(2)));
constexpr int BM = 256, BK = 64, HALF = 128, HTB = HALF * BK * 2, STAGE_BYTES = 8 * HTB, NXCD = 8, WGM = 8;
constexpr int XA_OFF = STAGE_BYTES;
constexpr int EPI_SCR_OFF = STAGE_BYTES + 8192;

__host__ __device__ __forceinline__ int lds_byte(int r, int c) { const int st = (r >> 4) * 2 + (c >> 5), rr = r & 15, cc = c & 31, ob = rr * 64 + cc * 2; return st * 1024 + (ob ^ (((ob >> 9) & 1) << 5)); }
__host__ __device__ __forceinline__ void stage_rc(int b, int& R, int& C) { const int st = b / 1024, sb = b % 1024, swz = sb ^ (((sb >> 9) & 1) << 5); R = (st >> 1) * 16 + swz / 64; C = (st & 1) * 32 + (swz % 64) / 2; }
__host__ __device__ __forceinline__ int perm32(int rho) { const int n = rho >> 4, i = rho & 15; return 8 * (i >> 2) + 4 * n + (i & 3); }

struct Unit { int pm, pn, ks; };
struct Gemm { const bf16_t* A; const bf16_t* Bt; int M, N, K, lda, ldb, a_pn_cols; const bf16_t* AX; };

struct StaticOrder {
    int nM, nN, nwg, G, c;
    __host__ __device__ void init(int M, int N, int G_, int c_) { nM = M / BM; nN = N / BM; nwg = nM * nN; G = G_; c = c_; }
    __host__ __device__ bool next(int i, Unit& u) const {
        const long L = (long)i * G + c; if (L >= nwg) return false;
        int wgid = (int)L; { const int q = nwg / NXCD, r = nwg % NXCD, xcd = wgid % NXCD, off = wgid / NXCD; wgid = (xcd < r ? xcd * (q + 1) : r * (q + 1) + (xcd - r) * q) + off; }
        const int nig = WGM * nN, gid = wgid / nig, fm = gid * WGM, gsz = (nM - fm) < WGM ? (nM - fm) : WGM;
        u.pm = fm + ((wgid % nig) % gsz); u.pn = (wgid % nig) / gsz; u.ks = 0; return true;
    }
    __device__ __forceinline__ void a_ready(const Unit&) const {}
    __device__ __forceinline__ void done(const Unit&) const {}
};

struct SplitOrder {
    int c, n;
    __device__ __forceinline__ bool next(int i, Unit& u) const { if (i > 0 || c >= n) return false; u.pm = 64 + ((c & 15) >> 2); u.pn = c & 3; u.ks = c >> 4; return true; }
    __device__ __forceinline__ void a_ready(const Unit&) const {}
    __device__ __forceinline__ void done(const Unit&) const {}
};

__device__ __forceinline__ unsigned cvt_pk_bf16(float lo, float hi) { unsigned r; asm volatile("v_cvt_pk_bf16_f32 %0, %1, %2" : "=v"(r) : "v"(lo), "v"(hi)); return r; }

__device__ __forceinline__ float xor_shfl(float v, int lane, int mask) { return __builtin_bit_cast(float, __builtin_amdgcn_ds_bpermute((lane ^ mask) << 2, __builtin_bit_cast(int, v))); }
__device__ __forceinline__ float rstd_of(const f32x4 a) { return __builtin_amdgcn_rsqf(((a[0] + a[1]) + (a[2] + a[3])) * (1.0f / DM) + RMS_EPS); }
__device__ __forceinline__ float row_rstd(const float* ssq, int row) { return rstd_of(*(const f32x4*)(ssq + (size_t)row * 4)); }

struct EpiSwiglu {
    static constexpr bool PERM = true, AFTER_DRAIN = false, XROWS = false;
    bf16_t* H; const float* ssq; bool nostore;
    __device__ __forceinline__ void operator()(const f32x4 (&acc)[2][2][4][2], const Unit& u, int wr, int wc, int fr, int fq, PG8_LAS unsigned char* xl, int tid) const {
        if (H == nullptr) return;
        const int row0 = u.pm * BM + wr * 64 + fr, col0 = u.pn * HALF + wc * 32 + 8 * fq;
        f32x4 sq[2][4];
#pragma unroll
        for (int ai = 0; ai < 2; ++ai)
#pragma unroll
            for (int m = 0; m < 4; ++m) sq[ai][m] = *(const f32x4*)(ssq + (size_t)(row0 + ai * HALF + m * 16) * 4);
#pragma unroll
        for (int ai = 0; ai < 2; ++ai)
#pragma unroll
            for (int m = 0; m < 4; ++m) {
                const int row = row0 + ai * HALF + m * 16;
                const float rs = rstd_of(sq[ai][m]);
                const f32x2 c1 = (f32x2){-rs * LOG2E, -rs * LOG2E}, c2 = (f32x2){rs * rs, rs * rs}, one = (f32x2){1.0f, 1.0f};
                unsigned w[4];
#pragma unroll
                for (int n = 0; n < 2; ++n)
#pragma unroll
                    for (int hh = 0; hh < 2; ++hh) {
                        const f32x2 ag = (f32x2){acc[ai][0][m][n][2 * hh], acc[ai][0][m][n][2 * hh + 1]}, au = (f32x2){acc[ai][1][m][n][2 * hh], acc[ai][1][m][n][2 * hh + 1]};
                        const f32x2 t = ag * c1;
                        const f32x2 d = (f32x2){__builtin_amdgcn_exp2f(t[0]), __builtin_amdgcn_exp2f(t[1])} + one;
                        const f32x2 r = (f32x2){__builtin_amdgcn_rcpf(d[0]), __builtin_amdgcn_rcpf(d[1])};
                        const f32x2 o = ((ag * au) * c2) * r;
                        w[2 * n + hh] = cvt_pk_bf16(o[0], o[1]);
                    }
                if (!nostore) *(u32x4*)(H + (size_t)row * DFF + col0) = (u32x4){w[0], w[1], w[2], w[3]}; else asm volatile("" :: "v"(w[0]), "v"(w[1]), "v"(w[2]), "v"(w[3]));
            }
    }
};
__device__ __forceinline__ f32x4 bf4_to_f32(const u32x2 w) { return (f32x4){__builtin_bit_cast(float, w.x << 16), __builtin_bit_cast(float, w.x & 0xffff0000u), __builtin_bit_cast(float, w.y << 16), __builtin_bit_cast(float, w.y & 0xffff0000u)}; }
struct EpiRes {
    static constexpr bool PERM = true, AFTER_DRAIN = false, XROWS = true;
    bf16_t* xb; float* ssq; const float* bias; float accs;
    __device__ __forceinline__ void xrows(const f32x4 (&accx)[2], const Unit& u, int wr, int wc, int fr, int fq, PG8_LAS unsigned char* xl, int tid) const {
        if (xb == nullptr) return;
        const int row = MP + 16 * u.pm + fr, col0 = u.pn * BM + wr * HALF + wc * 32 + 8 * fq;
        bf16_t* xp = xb + (size_t)row * DM + col0;
        const u32x4 w = *(const u32x4*)xp;
        f32x4 a0 = accx[0], a1 = accx[1];
#if DUP_MASK != 0
        a0 = a0 * accs; a1 = a1 * accs;
#endif
        if (bias) { a0 += *(const f32x4*)(bias + col0); a1 += *(const f32x4*)(bias + col0 + 4); }
        const f32x4 v0 = bf4_to_f32((u32x2){w.x, w.y}) + a0, v1 = bf4_to_f32((u32x2){w.z, w.w}) + a1;
        *(u32x4*)xp = (u32x4){cvt_pk_bf16(v0[0], v0[1]), cvt_pk_bf16(v0[2], v0[3]), cvt_pk_bf16(v1[0], v1[1]), cvt_pk_bf16(v1[2], v1[3])};
        float sm = ((v0[0] * v0[0] + v0[1] * v0[1]) + (v0[2] * v0[2] + v0[3] * v0[3])) + ((v1[0] * v1[0] + v1[1] * v1[1]) + (v1[2] * v1[2] + v1[3] * v1[3]));
        { const int ln = fr + 16 * fq; sm += xor_shfl(sm, ln, 16); sm += xor_shfl(sm, ln, 32); }
        if (fq == 0) ((PG8_LAS float*)(xl + 4096))[fr * 8 + wr * 4 + wc] = sm;
    }
    __device__ __forceinline__ void operator()(const f32x4 (&acc)[2][2][4][2], const Unit& u, int wr, int wc, int fr, int fq, PG8_LAS unsigned char* xl, int tid) const {
        if (xb == nullptr) return;
        const int row0 = u.pm * BM + wr * 64 + fr, col0 = u.pn * BM + wc * 32 + 8 * fq;
        PG8_LAS float* scr = (PG8_LAS float*)xl;
        f32x4 bv[2][2];
#pragma unroll
        for (int bj = 0; bj < 2; ++bj)
#pragma unroll
            for (int n = 0; n < 2; ++n) bv[bj][n] = bias ? *(const f32x4*)(bias + col0 + bj * HALF + 4 * n) : (f32x4){0.f, 0.f, 0.f, 0.f};
#pragma unroll
        for (int ai = 0; ai < 2; ++ai) {
            u32x4 xo[4][2];
#pragma unroll
            for (int m = 0; m < 4; ++m) {
                const bf16_t* xp = xb + (size_t)(row0 + ai * HALF + m * 16) * DM + col0;
#pragma unroll
                for (int bj = 0; bj < 2; ++bj) xo[m][bj] = *(const u32x4*)(xp + bj * HALF);
            }
#pragma unroll
            for (int m = 0; m < 4; ++m) {
                bf16_t* xp = xb + (size_t)(row0 + ai * HALF + m * 16) * DM + col0;
                f32x2 s2 = (f32x2){0.f, 0.f};
#pragma unroll
                for (int bj = 0; bj < 2; ++bj) {
                    const u32x4 w = xo[m][bj];
                    f32x4 a0 = acc[ai][bj][m][0], a1 = acc[ai][bj][m][1];
#if DUP_MASK != 0
                    a0 = a0 * accs; a1 = a1 * accs;
#endif
                    if (bias) { a0 += bv[bj][0]; a1 += bv[bj][1]; }
                    const f32x2 v00 = (f32x2){__builtin_bit_cast(float, w.x << 16), __builtin_bit_cast(float, w.x & 0xffff0000u)} + (f32x2){a0[0], a0[1]};
                    const f32x2 v01 = (f32x2){__builtin_bit_cast(float, w.y << 16), __builtin_bit_cast(float, w.y & 0xffff0000u)} + (f32x2){a0[2], a0[3]};
                    const f32x2 v10 = (f32x2){__builtin_bit_cast(float, w.z << 16), __builtin_bit_cast(float, w.z & 0xffff0000u)} + (f32x2){a1[0], a1[1]};
                    const f32x2 v11 = (f32x2){__builtin_bit_cast(float, w.w << 16), __builtin_bit_cast(float, w.w & 0xffff0000u)} + (f32x2){a1[2], a1[3]};
                    *(u32x4*)(xp + bj * HALF) = (u32x4){cvt_pk_bf16(v00[0], v00[1]), cvt_pk_bf16(v01[0], v01[1]), cvt_pk_bf16(v10[0], v10[1]), cvt_pk_bf16(v11[0], v11[1])};
                    s2 = v00 * v00 + s2; s2 = v01 * v01 + s2; s2 = v10 * v10 + s2; s2 = v11 * v11 + s2;
                }
                float sm = s2[0] + s2[1];
                { const int ln = fr + 16 * fq; sm += xor_shfl(sm, ln, 16); sm += xor_shfl(sm, ln, 32); }
                if (fq == 0) scr[(ai * HALF + wr * 64 + m * 16 + fr) * 4 + wc] = sm;
            }
            asm volatile("" ::: "memory");
        }
        asm volatile("s_waitcnt lgkmcnt(0)" ::: "memory"); __builtin_amdgcn_s_barrier(); asm volatile("" ::: "memory");
        if (tid < BM) { const f32x4 p = *(const PG8_LAS f32x4*)(scr + tid * 4); ssq[(size_t)(u.pm * BM + tid) * 4 + u.pn] = (p[0] + p[1]) + (p[2] + p[3]); }
        if (tid < 16) { const PG8_LAS f32x4* q = (const PG8_LAS f32x4*)(xl + 4096) + tid * 2; const f32x4 p0 = q[0], p1 = q[1];
            ssq[(size_t)(MP + 16 * u.pm + tid) * 4 + u.pn] = ((p0[0] + p0[1]) + (p0[2] + p0[3])) + ((p1[0] + p1[1]) + (p1[2] + p1[3])); }
    }
};
template <int NSPL>
struct EpiSlab {
    static constexpr bool PERM = true, AFTER_DRAIN = false, XROWS = false;
    float* slab; unsigned* cnt; unsigned* tmo; bf16_t* xb; float* ssq; const float* bias; float accs;
    __device__ __forceinline__ void operator()(const f32x4 (&acc)[2][2][4][2], const Unit& u, int wr, int wc, int fr, int fq, PG8_LAS unsigned char* xl, int tid) const {
        const int tile = (u.pm - 64) * 4 + u.pn, unit = u.ks * 16 + tile;
        const __amdgpu_buffer_rsrc_t rs = __builtin_amdgcn_make_buffer_rsrc(slab, 0, 16 * NSPL * 32 * 512 * 16, 0x00020000);
        const int voff = (unit * 32 * 512 + tid) * 16;
#pragma unroll
        for (int ai = 0; ai < 2; ++ai)
#pragma unroll
            for (int bj = 0; bj < 2; ++bj)
#pragma unroll
                for (int m = 0; m < 4; ++m)
#pragma unroll
                    for (int n = 0; n < 2; ++n) __builtin_amdgcn_raw_buffer_store_b128(__builtin_bit_cast(u32x4, acc[ai][bj][m][n]), rs, voff + (ai * 16 + bj * 8 + m * 2 + n) * 512 * 16, 0, 16  );
        asm volatile("s_waitcnt vmcnt(0)" ::: "memory");
        asm volatile("s_waitcnt lgkmcnt(0)" ::: "memory"); __builtin_amdgcn_s_barrier(); asm volatile("" ::: "memory");
        unsigned* c = cnt + tile * 64;
        if (tid == 0) __hip_atomic_fetch_add(c, 1u, __ATOMIC_RELAXED, __HIP_MEMORY_SCOPE_AGENT);
        if (u.ks >= 8) return;
        if (tid < 64) {
            const unsigned long long t0 = __builtin_amdgcn_s_memrealtime();
            while ((unsigned)__builtin_amdgcn_readfirstlane(__hip_atomic_load(c, __ATOMIC_RELAXED, __HIP_MEMORY_SCOPE_AGENT)) < (unsigned)NSPL) {
                if (__builtin_amdgcn_s_memrealtime() - t0 > 2000000ull) { if (tid == 0) __hip_atomic_store(tmo, 1u, __ATOMIC_RELAXED, __HIP_MEMORY_SCOPE_AGENT); break; }
                __builtin_amdgcn_s_sleep(2); }
            __builtin_amdgcn_fence(__ATOMIC_ACQUIRE, "agent");
            asm volatile("s_waitcnt vmcnt(0)" ::: "memory");
        }
        asm volatile("" ::: "memory"); __builtin_amdgcn_s_barrier(); asm volatile("" ::: "memory");
        for (int rg = u.ks; rg < 8; rg += NSPL) {
        const int ai = rg >> 2, m = rg & 3;
        const int row = u.pm * BM + ai * HALF + wr * 64 + m * 16 + fr, col0 = u.pn * BM + wc * 32 + 8 * fq;
        bf16_t* xp = xb + (size_t)row * DM + col0;
        u32x4 xo[2];
#pragma unroll
        for (int bj = 0; bj < 2; ++bj) xo[bj] = *(const u32x4*)(xp + bj * HALF);
        f32x4 sum[2][2];
#pragma unroll
        for (int bj = 0; bj < 2; ++bj)
#pragma unroll
            for (int n = 0; n < 2; ++n) sum[bj][n] = (f32x4){0.f, 0.f, 0.f, 0.f};
#pragma unroll
        for (int sp = 0; sp < NSPL; ++sp) {
            const int so = (((sp * 16 + tile) * 32 + ai * 16 + m * 2) * 512 + tid) * 16;
#pragma unroll
            for (int bj = 0; bj < 2; ++bj)
#pragma unroll
                for (int n = 0; n < 2; ++n) sum[bj][n] += __builtin_bit_cast(f32x4, __builtin_amdgcn_raw_buffer_load_b128(rs, so + (bj * 8 + n) * 512 * 16, 0, 16  ));
        }
        PG8_LAS float* scr = (PG8_LAS float*)xl;
        float sm = 0.f;
#pragma unroll
        for (int bj = 0; bj < 2; ++bj) {
            f32x4 v0 = bf4_to_f32((u32x2){xo[bj].x, xo[bj].y}) + sum[bj][0] * accs, v1 = bf4_to_f32((u32x2){xo[bj].z, xo[bj].w}) + sum[bj][1] * accs;
            if (bias) { v0 += *(const f32x4*)(bias + col0 + bj * HALF); v1 += *(const f32x4*)(bias + col0 + bj * HALF + 4); }
            *(u32x4*)(xp + bj * HALF) = (u32x4){cvt_pk_bf16(v0[0], v0[1]), cvt_pk_bf16(v0[2], v0[3]), cvt_pk_bf16(v1[0], v1[1]), cvt_pk_bf16(v1[2], v1[3])};
            sm += ((v0[0] * v0[0] + v0[1] * v0[1]) + (v0[2] * v0[2] + v0[3] * v0[3])) + ((v1[0] * v1[0] + v1[1] * v1[1]) + (v1[2] * v1[2] + v1[3] * v1[3]));
        }
        { const int ln = fr + 16 * fq; sm += xor_shfl(sm, ln, 16); sm += xor_shfl(sm, ln, 32); }
        if (fq == 0) scr[(wr * 16 + fr) * 4 + wc] = sm;
        asm volatile("s_waitcnt lgkmcnt(0)" ::: "memory"); __builtin_amdgcn_s_barrier(); asm volatile("" ::: "memory");
        if (tid < 32) { const f32x4 p = *(const PG8_LAS f32x4*)(scr + tid * 4);
            ssq[(size_t)(u.pm * BM + ai * HALF + (tid >> 4) * 64 + m * 16 + (tid & 15)) * 4 + u.pn] = (p[0] + p[1]) + (p[2] + p[3]); }
        asm volatile("s_waitcnt lgkmcnt(0)" ::: "memory"); __builtin_amdgcn_s_barrier(); asm volatile("" ::: "memory");
        }
    }
};
struct EpiQKV {
    static constexpr bool PERM = true, AFTER_DRAIN = false, XROWS = false;
    bf16_t* Q; bf16_t* K; bf16_t* V; const float* ssq; const float* bias; const float* rope; float* out;
    __device__ __forceinline__ void operator()(const f32x4 (&acc)[2][2][4][2], const Unit& u, int wr, int wc, int fr, int fq, PG8_LAS unsigned char* xl, int tid) const {
        const int row0 = u.pm * BM + wr * 64 + fr, pn = u.pn, dd0 = 8 * fq, nat0 = pn * 256 + wc * 64 + dd0;
        f32x4 bv[2][2];
#pragma unroll
        for (int bj = 0; bj < 2; ++bj)
#pragma unroll
            for (int n = 0; n < 2; ++n) bv[bj][n] = *(const f32x4*)(bias + nat0 + bj * 32 + 4 * n);
        float rs8[2][4];
        {
            f32x4 sq[2][4];
#pragma unroll
            for (int ai = 0; ai < 2; ++ai)
#pragma unroll
                for (int m = 0; m < 4; ++m) sq[ai][m] = *(const f32x4*)(ssq + (size_t)(row0 + ai * HALF + m * 16) * 4);
#pragma unroll
            for (int ai = 0; ai < 2; ++ai)
#pragma unroll
                for (int m = 0; m < 4; ++m) { rs8[ai][m] = rstd_of(sq[ai][m]); asm volatile("" : "+v"(rs8[ai][m])); }
        }
        asm volatile("" ::: "memory");
#pragma unroll
        for (int ah = 0; ah < 4; ++ah) {
            const int ai = ah >> 1;
            f32x4 rp[4][4];
            if (pn < 5) {
#pragma unroll
                for (int m = 2 * (ah & 1); m < 2 * (ah & 1) + 2; ++m) { const int row = row0 + ai * HALF + m * 16;
                    const int pidx = (row < MP) ? (row & (TPS - 1)) : TPS + ((row - MP) & (TSS - 1));
                    const f32x4* rq = (const f32x4*)(rope + ((size_t)pidx * 32 + dd0) * 2);
#pragma unroll
                    for (int j = 0; j < 4; ++j) rp[m][j] = rq[j]; }
            }
#pragma unroll
            for (int m = 2 * (ah & 1); m < 2 * (ah & 1) + 2; ++m) {
                const int row = row0 + ai * HALF + m * 16;
                const float rs = rs8[ai][m];
                f32x4 v[2][2];
#pragma unroll
                for (int bj = 0; bj < 2; ++bj)
#pragma unroll
                    for (int n = 0; n < 2; ++n) v[bj][n] = acc[ai][bj][m][n] * rs + bv[bj][n];
                if (pn < 5) {
#pragma unroll
                    for (int n = 0; n < 2; ++n) {
                        const f32x4 cs0 = rp[m][2 * n], cs1 = rp[m][2 * n + 1];
                        const float c[4] = {cs0[0], cs0[2], cs1[0], cs1[2]}, sn[4] = {cs0[1], cs0[3], cs1[1], cs1[3]};
                        const f32x4 x1 = v[0][n], x2 = v[1][n];
#pragma unroll
                        for (int i = 0; i < 4; ++i) { v[0][n][i] = x1[i] * c[i] - x2[i] * sn[i]; v[1][n][i] = x2[i] * c[i] + x1[i] * sn[i]; }
                    }
                }
                if (pn < 4) {
#pragma unroll
                    for (int bj = 0; bj < 2; ++bj) { const f32x4 a = v[bj][0] * QSCALE, b = v[bj][1] * QSCALE;
                        *(u32x4*)(Q + (size_t)row * DM + nat0 + bj * 32) = (u32x4){cvt_pk_bf16(a[0], a[1]), cvt_pk_bf16(a[2], a[3]), cvt_pk_bf16(b[0], b[1]), cvt_pk_bf16(b[2], b[3])}; }
                } else {
                    bf16_t* kv = (pn == 4) ? K : V;
                    const int c0 = wc * 64 + dd0;
#pragma unroll
                    for (int bj = 0; bj < 2; ++bj) { const f32x4 a = v[bj][0], b = v[bj][1];
                        *(u32x4*)(kv + (size_t)row * KVD + c0 + bj * 32) = (u32x4){cvt_pk_bf16(a[0], a[1]), cvt_pk_bf16(a[2], a[3]), cvt_pk_bf16(b[0], b[1]), cvt_pk_bf16(b[2], b[3])}; }
                    float* dst = nullptr;
                    if (row < MP) { const int t = row & (TPS - 1); if (t >= TPS - 128) dst = out + ((pn == 4) ? O_KP : O_VP) + ((size_t)(row >> 11) * 128 + (t - (TPS - 128))) * KVD + c0; }
                    else { const int r = row - MP; dst = out + ((pn == 4) ? O_KS : O_VS) + ((size_t)(r >> 3) * 128 + 120 + (r & 7)) * KVD + c0; }
                    if (dst) {
#pragma unroll
                        for (int bj = 0; bj < 2; ++bj)
#pragma unroll
                            for (int n = 0; n < 2; ++n) *(f32x4*)(dst + bj * 32 + 4 * n) = v[bj][n];
                    }
                }
            }
            asm volatile("" ::: "memory");
        }
    }
};

template <class Epi, class Sched, bool ALIGN_EPI = false, bool SP2 = false>
__device__ __forceinline__ void gemm_phase(PG8_LAS unsigned char* lds, const Gemm g, const Sched& S, const Epi& E, const int tid) {
    const int wid = __builtin_amdgcn_readfirstlane(tid >> 6), lane = tid & 63, wr = wid >> 2, wc = wid & 3, fr = lane & 15, fq = lane >> 4;
    const int K = g.K, nt = K / BK;
    unsigned voffA[2], voffB[2];
#pragma unroll
    for (int i = 0; i < 2; ++i) { int R, C; stage_rc(tid * 16 + i * 8192, R, C); const int Rb = Epi::PERM ? ((R & ~31) + perm32(R & 31)) : R;
        voffA[i] = (unsigned)(R * g.lda + C) * 2u; voffB[i] = (unsigned)(Rb * g.ldb + C) * 2u; }
    const size_t kstep = (size_t)(BK * 2);
    const size_t hstepA = (size_t)HALF * g.lda * 2, hstepB = (size_t)HALF * g.ldb * 2;
    const size_t tstepA = 2 * hstepA, tstepB = 2 * hstepB;
    const size_t pnA = (size_t)g.a_pn_cols * 2;
    const unsigned ldsw = (unsigned)wid * 1024u;
    const int aoff = lds_byte(wr * 64 + fr, fq * 8), boff = lds_byte(wc * 32 + fr, fq * 8);
#define PG8_SA(b, h) (((b) * 2 + (h)) * HTB)
#define PG8_SB(b, h) ((4 + (b) * 2 + (h)) * HTB)
#define PG8_STAGE(bufoff, gbase, voff) do { _Pragma("unroll") for (int _i = 0; _i < 2; ++_i) \
        __builtin_amdgcn_global_load_lds((const unsigned*)((const char*)(gbase) + (voff)[_i]), (PG8_LAS unsigned*)(lds + (bufoff) + ldsw + _i * 8192), 16, 0, 0); } while (0)
#define PG8_LDA(dst, b, h) do { _Pragma("unroll") for (int m = 0; m < 4; ++m) _Pragma("unroll") for (int k = 0; k < 2; ++k) dst[m][k] = *(const PG8_LAS bf16x8*)(lds + PG8_SA(b, h) + aoff + m * 2048 + k * 1024); } while (0)
#define PG8_LDB(dst, b, h) do { _Pragma("unroll") for (int n = 0; n < 2; ++n) _Pragma("unroll") for (int k = 0; k < 2; ++k) dst[n][k] = *(const PG8_LAS bf16x8*)(lds + PG8_SB(b, h) + boff + n * 2048 + k * 1024); } while (0)
#define PG8_MMA(ai, bj, At, Bt) do { __builtin_amdgcn_s_setprio(1); _Pragma("unroll") for (int m = 0; m < 4; ++m) _Pragma("unroll") for (int n = 0; n < 2; ++n) _Pragma("unroll") for (int k = 0; k < 2; ++k) \
        acc[ai][bj][m][n] = __builtin_amdgcn_mfma_f32_16x16x32_bf16(Bt[n][k], At[m][k], acc[ai][bj][m][n], 0, 0, 0); __builtin_amdgcn_s_setprio(0); } while (0)
#define PG8_WAIT_V(n) asm volatile("s_waitcnt vmcnt(" #n ")" ::: "memory")
#define PG8_WAIT_L(n) asm volatile("s_waitcnt lgkmcnt(" #n ")" ::: "memory")
#define PG8_BAR __builtin_amdgcn_s_barrier()
#define PG8_SCHED __builtin_amdgcn_sched_barrier(0)
    Unit cur, nxt; int ui = 0;
    if (!S.next(0, cur)) return;
    f32x4 accx[2] = {(f32x4){0.f, 0.f, 0.f, 0.f}, (f32x4){0.f, 0.f, 0.f, 0.f}}; bf16x8 axf[2];
    const unsigned voffX = (unsigned)((lane & 15) * g.lda + 32 * wid + 8 * (lane >> 4)) * 2u;
    const size_t xstep = (size_t)16 * g.lda * 2;
#define PG8_XSTAGE(b, xbase) do { if constexpr (Epi::XROWS) { if (wid < 2) \
        __builtin_amdgcn_global_load_lds((const unsigned*)((const char*)(xbase) + voffX), (PG8_LAS unsigned*)(lds + XA_OFF + (b) * 2048 + ldsw), 16, 0, 0); } } while (0)
#define PG8_LDX(b) do { if constexpr (Epi::XROWS) { _Pragma("unroll") for (int k = 0; k < 2; ++k) axf[k] = *(const PG8_LAS bf16x8*)(lds + XA_OFF + (b) * 2048 + k * 1024 + lane * 16); } } while (0)
#define PG8_MMX() do { if constexpr (Epi::XROWS) { __builtin_amdgcn_s_setprio(1); if (wr == 0) { _Pragma("unroll") for (int n = 0; n < 2; ++n) _Pragma("unroll") for (int k = 0; k < 2; ++k) accx[n] = __builtin_amdgcn_mfma_f32_16x16x32_bf16(B0[n][k], axf[k], accx[n], 0, 0, 0); } \
        else { _Pragma("unroll") for (int n = 0; n < 2; ++n) _Pragma("unroll") for (int k = 0; k < 2; ++k) accx[n] = __builtin_amdgcn_mfma_f32_16x16x32_bf16(B1[n][k], axf[k], accx[n], 0, 0, 0); } __builtin_amdgcn_s_setprio(0); } } while (0)
    f32x4 acc[2][2][4][2];
#pragma unroll
    for (int a = 0; a < 2; ++a)
#pragma unroll
        for (int b = 0; b < 2; ++b)
#pragma unroll
            for (int m = 0; m < 4; ++m)
#pragma unroll
                for (int n = 0; n < 2; ++n) acc[a][b][m][n] = (f32x4){0.f, 0.f, 0.f, 0.f};
    bf16x8 At[4][2], B0[2][2], B1[2][2];
    const size_t ksb = (size_t)K * 2;
    const char* cA = (const char*)g.A + (size_t)cur.pm * tstepA + (size_t)cur.pn * pnA + (size_t)cur.ks * ksb; const char* cB = (const char*)g.Bt + (size_t)cur.pn * tstepB + (size_t)cur.ks * ksb;
    const char* cX = Epi::XROWS ? (const char*)g.AX + (size_t)cur.pm * xstep : nullptr;
    S.a_ready(cur);
    if constexpr (SP2) {
        PG8_STAGE(PG8_SB(0, 0), cB, voffB); PG8_STAGE(PG8_SB(0, 1), cB + hstepB, voffB); PG8_STAGE(PG8_SA(0, 0), cA, voffA); PG8_XSTAGE(0, cX); PG8_STAGE(PG8_SA(0, 1), cA + hstepA, voffA);
        if (wr == 1) PG8_BAR;
        PG8_WAIT_V(2); PG8_BAR;
        PG8_STAGE(PG8_SB(1, 0), cB + kstep, voffB); PG8_STAGE(PG8_SA(1, 0), cA + kstep, voffA); PG8_XSTAGE(1, cX + kstep); PG8_STAGE(PG8_SB(1, 1), cB + hstepB + kstep, voffB);
        PG8_WAIT_V(6); PG8_BAR;
    } else {
        PG8_STAGE(PG8_SB(0, 0), cB, voffB); PG8_STAGE(PG8_SA(0, 0), cA, voffA); PG8_STAGE(PG8_SB(0, 1), cB + hstepB, voffB); PG8_STAGE(PG8_SA(0, 1), cA + hstepA, voffA);
        if (wr == 1) PG8_BAR;
        PG8_WAIT_V(4); PG8_BAR;
        PG8_STAGE(PG8_SB(1, 0), cB + kstep, voffB); PG8_STAGE(PG8_SA(1, 0), cA + kstep, voffA); PG8_STAGE(PG8_SB(1, 1), cB + hstepB + kstep, voffB);
        PG8_WAIT_V(6); PG8_BAR;
    }
    for (;;) {
        const bool has_next = S.next(ui + 1, nxt);
        const char* nA = has_next ? (const char*)g.A + (size_t)nxt.pm * tstepA + (size_t)nxt.pn * pnA + (size_t)nxt.ks * ksb : cA; const char* nB = has_next ? (const char*)g.Bt + (size_t)nxt.pn * tstepB + (size_t)nxt.ks * ksb : cB;
        const char* nX = (Epi::XROWS && has_next) ? (const char*)g.AX + (size_t)nxt.pm * xstep : cX;
        for (int t = 0; t < nt; t += 2) {
            const bool last = (t == nt - 2);
            const char* a1 = cA + (size_t)(t + 1) * kstep;
            const char* a2 = last ? nA : cA + (size_t)(t + 2) * kstep; const char* b2 = last ? nB : cB + (size_t)(t + 2) * kstep;
            const char* a3 = a2 + kstep; const char* b3 = b2 + kstep;
            const char* x2 = last ? nX : cX + (size_t)(t + 2) * kstep; const char* x3 = x2 + kstep;
            if (last && has_next) S.a_ready(nxt);
            if constexpr (SP2) {
            PG8_LDB(B0, 0, 0); PG8_LDB(B1, 0, 1); PG8_SCHED; PG8_LDA(At, 0, 0); PG8_LDX(0); PG8_STAGE(PG8_SA(1, 1), a1 + hstepA, voffA);
            PG8_WAIT_V(8); PG8_WAIT_L(0); PG8_BAR; PG8_MMA(0, 0, At, B0); PG8_MMA(0, 1, At, B1); PG8_MMX(); PG8_BAR; PG8_SCHED;
            PG8_LDA(At, 0, 1); PG8_STAGE(PG8_SB(0, 0), b2, voffB); PG8_STAGE(PG8_SB(0, 1), b2 + hstepB, voffB); PG8_STAGE(PG8_SA(0, 0), a2, voffA); PG8_XSTAGE(0, x2);
            PG8_WAIT_V(8); PG8_WAIT_L(0); PG8_BAR; PG8_MMA(1, 0, At, B0); PG8_MMA(1, 1, At, B1); PG8_BAR; PG8_SCHED;
            PG8_LDB(B0, 1, 0); PG8_LDB(B1, 1, 1); PG8_SCHED; PG8_LDA(At, 1, 0); PG8_LDX(1); PG8_STAGE(PG8_SA(0, 1), a2 + hstepA, voffA);
            PG8_WAIT_V(8); PG8_WAIT_L(0); PG8_BAR; PG8_MMA(0, 0, At, B0); PG8_MMA(0, 1, At, B1); PG8_MMX(); PG8_BAR; PG8_SCHED;
            PG8_LDA(At, 1, 1); PG8_STAGE(PG8_SB(1, 0), b3, voffB); PG8_STAGE(PG8_SB(1, 1), b3 + hstepB, voffB); PG8_STAGE(PG8_SA(1, 0), a3, voffA); PG8_XSTAGE(1, x3);
            PG8_WAIT_V(8); PG8_WAIT_L(0); PG8_BAR; PG8_MMA(1, 0, At, B0); PG8_MMA(1, 1, At, B1); PG8_BAR; PG8_SCHED;
            } else {
            PG8_LDB(B0, 0, 0); PG8_SCHED; PG8_LDA(At, 0, 0); PG8_STAGE(PG8_SA(1, 1), a1 + hstepA, voffA);
            PG8_WAIT_L(8); PG8_BAR; PG8_WAIT_L(0); PG8_MMA(0, 0, At, B0); PG8_BAR; PG8_SCHED;
            PG8_LDB(B1, 0, 1); PG8_STAGE(PG8_SB(0, 0), b2, voffB);
            PG8_BAR; PG8_WAIT_L(0); PG8_MMA(0, 1, At, B1); PG8_BAR;
            PG8_LDA(At, 0, 1); PG8_STAGE(PG8_SA(0, 0), a2, voffA);
            PG8_BAR; PG8_WAIT_L(0); PG8_MMA(1, 0, At, B0); PG8_BAR; PG8_SCHED;
            PG8_STAGE(PG8_SB(0, 1), b2 + hstepB, voffB);
            PG8_WAIT_V(6); PG8_BAR; PG8_MMA(1, 1, At, B1); PG8_BAR;
            PG8_LDB(B0, 1, 0); PG8_SCHED; PG8_LDA(At, 1, 0); PG8_STAGE(PG8_SA(0, 1), a2 + hstepA, voffA);
            PG8_WAIT_L(8); PG8_BAR; PG8_WAIT_L(0); PG8_MMA(0, 0, At, B0); PG8_BAR; PG8_SCHED;
            PG8_LDB(B1, 1, 1); PG8_STAGE(PG8_SB(1, 0), b3, voffB);
            PG8_BAR; PG8_WAIT_L(0); PG8_MMA(0, 1, At, B1); PG8_BAR;
            PG8_LDA(At, 1, 1); PG8_STAGE(PG8_SA(1, 0), a3, voffA);
            PG8_BAR; PG8_WAIT_L(0); PG8_MMA(1, 0, At, B0); PG8_BAR; PG8_SCHED;
            PG8_STAGE(PG8_SB(1, 1), b3 + hstepB, voffB);
            PG8_WAIT_V(6); PG8_BAR; PG8_MMA(1, 1, At, B1); PG8_BAR;
            }
        }
        if constexpr (ALIGN_EPI) { if (wr == 0) PG8_BAR; }
        if constexpr (!Epi::AFTER_DRAIN) { unsigned zz = 0u; asm volatile("" : "+v"(zz)); int le = (int)__builtin_amdgcn_mbcnt_hi(~0u, __builtin_amdgcn_mbcnt_lo(~0u, zz)); asm volatile("" : "+v"(le)); if constexpr (Epi::XROWS) E.xrows(accx, cur, wr, wc, le & 15, le >> 4, lds + EPI_SCR_OFF, wid * 64 + le); E(acc, cur, wr, wc, le & 15, le >> 4, lds + EPI_SCR_OFF, wid * 64 + le); S.done(cur); }
        if (!has_next) break;
#pragma unroll
        for (int a = 0; a < 2; ++a)
#pragma unroll
            for (int b = 0; b < 2; ++b)
#pragma unroll
                for (int m = 0; m < 4; ++m)
#pragma unroll
                    for (int n = 0; n < 2; ++n) acc[a][b][m][n] = (f32x4){0.f, 0.f, 0.f, 0.f};
        accx[0] = (f32x4){0.f, 0.f, 0.f, 0.f}; accx[1] = accx[0];
        cur = nxt; cA = nA; cB = nB; cX = nX; ++ui;
        if constexpr (ALIGN_EPI) { if (wr == 1) PG8_BAR; }
    }
    PG8_WAIT_V(0);
    if constexpr (!ALIGN_EPI) { if (wr == 0) PG8_BAR; }
    PG8_BAR;
#undef PG8_XSTAGE
#undef PG8_LDX
#undef PG8_MMX
#undef PG8_SA
#undef PG8_SB
#undef PG8_STAGE
#undef PG8_LDA
#undef PG8_LDB
#undef PG8_MMA
#undef PG8_WAIT_V
#undef PG8_WAIT_L
#undef PG8_BAR
#undef PG8_SCHED
}
}

#define GAS __attribute__((address_space(1)))
#define LAS __attribute__((address_space(3)))
typedef unsigned short bf16;
typedef unsigned v4u __attribute__((ext_vector_type(4)));
typedef unsigned v2u __attribute__((ext_vector_type(2)));
typedef float f32x4 __attribute__((ext_vector_type(4)));
typedef float f32x2 __attribute__((ext_vector_type(2)));
typedef float f32x16 __attribute__((ext_vector_type(16)));
typedef short bf16x8 __attribute__((ext_vector_type(8)));
typedef short s16x4 __attribute__((ext_vector_type(4)));
typedef GAS unsigned gu32;
#define RLX_AGENT __ATOMIC_RELAXED, __HIP_MEMORY_SCOPE_AGENT
#define LDS_WAIT() asm volatile("s_waitcnt lgkmcnt(0)" ::: "memory")
#define VM_WAIT() asm volatile("s_waitcnt vmcnt(0)" ::: "memory")
__device__ __forceinline__ unsigned f2bf(float f) { unsigned u = __builtin_bit_cast(unsigned, f); return (u + 0x7fffu + ((u >> 16) & 1u)) >> 16; }
__device__ __forceinline__ unsigned pk2(float lo, float hi) { return f2bf(lo) | (f2bf(hi) << 16); }
__device__ __forceinline__ float bf2f(unsigned short b) { return __builtin_bit_cast(float, (unsigned)b << 16); }

constexpr int NWAVES = 8;
constexpr size_t MiB = 1u << 20;
constexpr size_t WS_CTL = 0, CTL_ZERO_BYTES = 64 * 1024;
constexpr size_t WS_ROPE = 1 * MiB;
constexpr size_t WS_SSQ = 2 * MiB;
constexpr size_t WS_WQKV = 4 * MiB, WS_WO = 7 * MiB, WS_WPOOL = 9 * MiB;
constexpr size_t WS_W1 = 10 * MiB, W1_BYTES = (size_t)2 * DFF * DM * 2;
constexpr size_t WS_W2 = 54 * MiB, W2_BYTES = (size_t)DM * DFF * 2;
constexpr size_t WS_XB = 76 * MiB;
constexpr size_t WS_H = 110 * MiB;
constexpr size_t WS_Q = WS_H, WS_O = WS_H + 34 * MiB, WS_K = WS_H + 68 * MiB, WS_V = WS_H + 77 * MiB;
constexpr size_t WS_XB2 = 204 * MiB;
constexpr size_t WS_SSQ2 = 3 * MiB;
constexpr int NSPLIT = 11, NSPLIT_O = 4;
constexpr size_t WS_END = 238 * MiB;
static_assert(WS_W1 + 4 * W1_BYTES <= WS_W2 && WS_W2 + 4 * W2_BYTES <= WS_XB && WS_XB + (size_t)MT * DM * 2 <= WS_H && WS_H + (size_t)MT * DFF * 2 <= WS_END, "ws map");
static_assert(WS_V + (size_t)MT * KVD * 2 <= WS_END && WS_K + (size_t)MT * KVD * 2 <= WS_V && WS_O + (size_t)MT * DM * 2 <= WS_K, "ws map 2");
constexpr int CW_TMO = 64, CW_TILE = 8192;
constexpr int CW_BAR = 4096;
constexpr int RING_OFF = 0, RING_BYTES = 131072;
constexpr int LDSCTL_OFF = 146432, MISC_OFF = LDSCTL_OFF + 320;
constexpr int LDS_BYTES = 147456;
static_assert((2 * 6 * 8192 + 8 * 256 + 8 * 4096) <= LDSCTL_OFF && (131072 + 8192 + 4096) <= LDSCTL_OFF && MISC_OFF + 64 <= LDS_BYTES, "LDS map");

#define XB_TMO      128
#define XB_XCNT(j)  (256  + 64 * (j))
#define XB_XSUB(j)  (1280 + 64 * (j))
#define XB_XGEN(j)  (2304 + 64 * (j))
#define XB_TOP      3328
#define XB_TOPGEN   3392
#define XCD_BAR_WORDS 3456
#define XB_SPIN_CAP (1u << 18)
__device__ __forceinline__ unsigned xb_ld(unsigned* p)              { return __hip_atomic_load(p, __ATOMIC_RELAXED, __HIP_MEMORY_SCOPE_AGENT); }
__device__ __forceinline__ unsigned xb_add(unsigned* p, unsigned v) { return __hip_atomic_fetch_add(p, v, __ATOMIC_RELAXED, __HIP_MEMORY_SCOPE_AGENT); }
__device__ __forceinline__ unsigned xb_xcc_id() { return (unsigned)__builtin_amdgcn_s_getreg((3 << 11) | 20) & 0xFu; }
#define XB_SPIN(cond, bar) do { unsigned _sp = 0; while (cond) { __builtin_amdgcn_s_sleep(1); \
    if ((++_sp & 255u) == 0u) { if (xb_ld(&(bar)[XB_TMO])) break; if (_sp > XB_SPIN_CAP) { atomicAdd(&(bar)[XB_TMO], 1u); break; } } } } while (0)
struct XcdBarrier { unsigned* bar; unsigned x; volatile LAS unsigned* st; };
__device__ __forceinline__ XcdBarrier xcd_barrier_post(unsigned* bar, volatile LAS unsigned* st) {
    XcdBarrier b; b.bar = bar; b.x = xb_xcc_id(); b.st = st;
    if (threadIdx.x == 0) (void)xb_add(&bar[XB_XCNT(b.x)], 1u);
    return b;
}
__device__ __forceinline__ void xcd_barrier_complete(unsigned* bar, unsigned x, unsigned& nloc, unsigned& nx) {
    const unsigned G = gridDim.x * gridDim.y * gridDim.z;
    unsigned sum, cnt, mine, sp = 0u;
    for (;;) {
        sum = 0u; cnt = 0u; mine = 0u;
#pragma unroll
        for (unsigned j = 0; j < 16; ++j) { const unsigned c = xb_ld(&bar[XB_XCNT(j)]); sum += c; cnt += (c > 0u) ? 1u : 0u; mine = (j == x) ? c : mine; }
        if (sum == G) break;
        __builtin_amdgcn_s_sleep(1);
        if ((++sp & 255u) == 0u) { if (xb_ld(&bar[XB_TMO])) break; if (sp > XB_SPIN_CAP) { atomicAdd(&bar[XB_TMO], 1u); break; } }
    }
    nloc = mine > 0u ? mine : 1u; nx = cnt > 0u ? cnt : 1u;
}
__device__ __forceinline__ void xcd_barrier(const XcdBarrier& b) {
    asm volatile("s_waitcnt vmcnt(0)" ::: "memory");
    __syncthreads();
    if (threadIdx.x == 0) {
        unsigned* bar = b.bar;
        __builtin_amdgcn_s_waitcnt(0);
        unsigned nloc = b.st[0], nx = b.st[1];
        if (nloc == 0u) { xcd_barrier_complete(bar, b.x, nloc, nx); b.st[0] = nloc; b.st[1] = nx; }
        const unsigned old = xb_add(&bar[XB_XSUB(b.x)], 1u);
        const unsigned gen = old / nloc;
        if (old + 1u == (gen + 1u) * nloc) {
            __builtin_amdgcn_fence(__ATOMIC_RELEASE, "agent");
            asm volatile("s_waitcnt vmcnt(0)" ::: "memory");
            const unsigned og = xb_add(&bar[XB_TOP], 1u);
            const unsigned tg = og / nx;
            if (og + 1u == (tg + 1u) * nx) xb_add(&bar[XB_TOPGEN], 1u);
            else XB_SPIN(xb_ld(&bar[XB_TOPGEN]) == tg, bar);
            __builtin_amdgcn_fence(__ATOMIC_ACQUIRE, "agent");
            xb_add(&bar[XB_XGEN(b.x)], 1u);
            asm volatile("s_waitcnt vmcnt(0)" ::: "memory");
        } else {
            XB_SPIN(xb_ld(&bar[XB_XGEN(b.x)]) == gen, bar);
            __builtin_amdgcn_fence(__ATOMIC_ACQUIRE, "agent");
            asm volatile("s_waitcnt vmcnt(0)" ::: "memory");
        }
    }
    __syncthreads();
}

struct Frame {
    LAS unsigned char* lds;
    int tid, lane, wave, vcu, G;
};
__device__ __forceinline__ int fresh_tid(int wave0) {
    int wv = wave0; asm volatile("" : "+s"(wv)); unsigned z = 0u; asm volatile("" : "+v"(z));
    int t = wv * 64 + (int)__builtin_amdgcn_mbcnt_hi(~0u, __builtin_amdgcn_mbcnt_lo(~0u, z)); asm volatile("" : "+v"(t)); return t;
}
__device__ __forceinline__ Frame phase_frame(const Frame& F0, int wave0) {
    Frame F = F0; const int t = fresh_tid(wave0); F.tid = t; F.lane = t & 63; F.wave = __builtin_amdgcn_readfirstlane(t >> 6); return F;
}
__device__ __forceinline__ float wave_sum(float v, int lane) {
#pragma unroll
    for (int o = 1; o < 64; o <<= 1) v += pg8::xor_shfl(v, lane, o);
    return v;
}

__device__ __forceinline__ void transpose_item64(const float* W, int ldw, bf16* WT, int K, int drow0, int scolA, int scolB, int k0, const float* kscale, const float* nscale, float cscale, LAS unsigned char* T, int lane) {
    const int kq = lane >> 4, nq = lane & 15;
    const float* src = W + (size_t)(k0 + 4 * kq) * ldw + ((nq < 8) ? scolA + 4 * nq : scolB + 4 * (nq - 8));
    f32x4 v[4][4];
#pragma unroll
    for (int j = 0; j < 4; ++j)
#pragma unroll
        for (int i = 0; i < 4; ++i) v[j][i] = __builtin_nontemporal_load((const f32x4*)(src + (size_t)(16 * j + i) * ldw));
    f32x4 ns = (f32x4){cscale, cscale, cscale, cscale};
    if (nscale) ns = *(const f32x4*)(nscale + drow0 + 4 * nq) * cscale;
#pragma unroll
    for (int j = 0; j < 4; ++j) {
        f32x4 ks = (f32x4){1.f, 1.f, 1.f, 1.f};
        if (kscale) ks = *(const f32x4*)(kscale + k0 + 16 * j + 4 * kq);
#pragma unroll
        for (int c = 0; c < 4; ++c) {
            const float sc = ns[c];
            v2u pk; pk.x = pk2(v[j][0][c] * ks[0] * sc, v[j][1][c] * ks[1] * sc); pk.y = pk2(v[j][2][c] * ks[2] * sc, v[j][3][c] * ks[3] * sc);
            const int n = 4 * nq + c, ch = (2 * j + (kq >> 1)) ^ (nq & 7);
            *(LAS v2u*)(T + n * 128 + ch * 16 + (kq & 1) * 8) = pk;
        }
    }
    LDS_WAIT(); asm volatile("" ::: "memory");
    const int c8 = lane & 7;
#pragma unroll
    for (int jj = 0; jj < 8; ++jj) { const int n = (lane >> 3) + 8 * jj;
        const v4u o = *(const LAS v4u*)(T + n * 128 + ((c8 ^ ((n >> 2) & 7)) * 16));
        *(GAS v4u*)(WT + (size_t)(drow0 + n) * K + k0 + 8 * c8) = o; }
    LDS_WAIT(); asm volatile("" ::: "memory");
}
struct Args { const float* in[20]; float* out; unsigned char* ws; int ph_lo, ph_hi; };
typedef const __attribute__((address_space(4))) Args* ArgsP;
struct Ptrs {
    ArgsP ap;
#define PTR_ACC(name, idx) __device__ __forceinline__ const float* name() const { return ap->in[idx]; }
    PTR_ACC(xp, 0) PTR_ACC(xs, 1) PTR_ACC(spool, 2) PTR_ACC(ck, 3) PTR_ACC(cv, 4) PTR_ACC(n1, 5) PTR_ACC(w1in, 6) PTR_ACC(w1out, 7) PTR_ACC(nmix, 8) PTR_ACC(n2, 9)
    PTR_ACC(w2in, 10) PTR_ACC(w2out, 11) PTR_ACC(poolw, 12) PTR_ACC(pscale, 13) PTR_ACC(wqkv, 14) PTR_ACC(bqkv, 15) PTR_ACC(wo, 16) PTR_ACC(bo, 17) PTR_ACC(sinks, 18) PTR_ACC(nfin, 19)
#undef PTR_ACC
    __device__ __forceinline__ float* out() const { return ap->out; }
    __device__ __forceinline__ unsigned char* ws() const { return ap->ws; }
};
constexpr int I_W1 = (DM / 64) * (2 * DFF / 64), I_W2 = (DFF / 64) * (DM / 64), I_FFN = I_W1 + I_W2;
constexpr int I_QKV = (DM / 64) * (QKVN / 64), I_WO = (DM / 64) * (DM / 64), I_POOL = 4 * 4 * 4;
constexpr int IT_QKV = 4 * I_FFN, IT_WO = IT_QKV + I_QKV, IT_POOL = IT_WO + I_WO, NITEMS = IT_POOL + I_POOL;
__device__ __forceinline__ void convert_items(const Frame& F, const Ptrs& P, int lo, int hi, int gw, int ngw) {
    LAS unsigned char* T = F.lds + RING_OFF + F.wave * 8192;
    unsigned char* ws = P.ws();
    for (int it = lo + gw; it < hi; it += ngw) {
        int r = it;
        if (r < 4 * I_FFN) {
            const int f = r / I_FFN; r -= f * I_FFN; const int layer = f >> 1, second = f & 1;
            if (r < I_W1) { const int nblk = 2 * DFF / 64, kb = r / nblk, nb = r % nblk, j = 64 * nb;
                const float* win = (second ? P.w2in() : P.w1in()) + (size_t)layer * DM * 2 * DFF;
                const float* gn = (second ? P.n2() : P.n1()) + layer * DM;
                const int scol = ((j >> 7) & 1) * DFF + (j >> 8) * 128 + (j & 127);
                transpose_item64(win, 2 * DFF, (bf16*)(ws + WS_W1 + f * W1_BYTES), DM, j, scol, scol + 32, 64 * kb, gn, nullptr, 1.0f, T, F.lane);
            } else { r -= I_W1; const int nblk = DM / 64, kb = r / nblk, nb = r % nblk;
                const float* wout = (second ? P.w2out() : P.w1out()) + (size_t)layer * DFF * DM;
                transpose_item64(wout, DM, (bf16*)(ws + WS_W2 + f * W2_BYTES), DFF, 64 * nb, 64 * nb, 64 * nb + 32, 64 * kb, nullptr, nullptr, 0.5f, T, F.lane); }
            continue;
        }
        r -= 4 * I_FFN;
        if (r < I_QKV) { const int nblk = QKVN / 64, kb = r / nblk, nb = r % nblk, j = 64 * nb;
            const int scol = (j >> 8) * 256 + ((j >> 5) & 3) * 64 + ((j >> 7) & 1) * 32;
            transpose_item64(P.wqkv(), QKVN, (bf16*)(ws + WS_WQKV), DM, j, scol, scol + 64, 64 * kb, P.nmix() + DM, nullptr, 1.0f, T, F.lane); continue; }
        r -= I_QKV;
        if (r < I_WO) { const int nblk = DM / 64, kb = r / nblk, nb = r % nblk;
            transpose_item64(P.wo(), DM, (bf16*)(ws + WS_WO), DM, 64 * nb, 64 * nb, 64 * nb + 32, 64 * kb, nullptr, nullptr, 1.0f, T, F.lane); continue; }
        r -= I_WO;
        { const int gi = r >> 4, kb = (r >> 2) & 3, nb = r & 3;
            transpose_item64(P.poolw() + (size_t)gi * 65536, 256, (bf16*)(ws + WS_WPOOL), 256, gi * 256 + 64 * nb, 64 * nb, 64 * nb + 32, 64 * kb, nullptr, P.pscale(), 1.0f, T, F.lane); }
    }
}
__device__ __forceinline__ void p0_prologue(const Frame& F, const Ptrs& P) {
    const int gw = F.vcu * NWAVES + F.wave, NGW = F.G * NWAVES;
    unsigned char* ws = P.ws();
    convert_items(F, P, 0, I_W1, gw, NGW);
    convert_items(F, P, IT_POOL, NITEMS, gw, NGW);
    {
        float* rope = (float*)(ws + WS_ROPE);
        const double r1 = 1.0 / sqrt(sqrt(sqrt(10.0)));
        for (int e = (F.vcu * NWAVES * 64) + F.tid; e < (TPS + TSS) * 32; e += F.G * NWAVES * 64) {
            const int pidx = e >> 5, d = e & 31; const int pos = pidx < TPS ? pidx : PAST + (pidx - TPS);
            double inv = 1.0; for (int i = 0; i < d; ++i) inv *= r1;
            double turns = (double)pos * inv * 0.15915494309189535; turns -= floor(turns);
            const float a = (float)(turns * 6.283185307179586);
            rope[2 * e] = cosf(a); rope[2 * e + 1] = sinf(a);
        }
    }
    {
        bf16* XB = (bf16*)(ws + WS_XB); float* SSQ = (float*)(ws + WS_SSQ);
        const float* xp = P.xp(); const float* xs = P.xs();
        for (int m0 = 4 * gw; m0 < MT; m0 += 4 * NGW) {
            f32x4 v[4][4];
#pragma unroll
            for (int r = 0; r < 4; ++r) { const int m = m0 + r; const float* xrow = (m < MP) ? xp + (size_t)m * DM : xs + (size_t)(m - MP) * DM;
#pragma unroll
                for (int j = 0; j < 4; ++j) v[r][j] = __builtin_nontemporal_load((const GAS f32x4*)xrow + 64 * j + F.lane); }
#pragma unroll
            for (int r = 0; r < 4; ++r) { const int m = m0 + r; float sq = 0.f;
#pragma unroll
                for (int j = 0; j < 4; ++j) sq += (v[r][j][0] * v[r][j][0] + v[r][j][1] * v[r][j][1]) + (v[r][j][2] * v[r][j][2] + v[r][j][3] * v[r][j][3]);
                sq = wave_sum(sq, F.lane);
                GAS unsigned long long* o8 = (GAS unsigned long long*)(XB + (size_t)m * DM) + F.lane;
#pragma unroll
                for (int j = 0; j < 4; ++j) o8[64 * j] = (unsigned long long)pk2(v[r][j][0], v[r][j][1]) | ((unsigned long long)pk2(v[r][j][2], v[r][j][3]) << 32);
                if (F.lane < 4) SSQ[(size_t)m * 4 + F.lane] = (F.lane == 0) ? sq : 0.f; }
        }
    }
}

namespace poolf {
constexpr int A_OFF = 0, APITCH = 528  , RS_OFF = 128 * APITCH, SCR_OFF = RS_OFF + 1024;
__device__ __forceinline__ f32x2 bf2_to_f32(unsigned w) { return (f32x2){__builtin_bit_cast(float, w << 16), __builtin_bit_cast(float, w & 0xffff0000u)}; }
__device__ __forceinline__ void put_p(LAS unsigned char* A, int lr, int kc, f32x2 p) { *(LAS unsigned*)(A + lr * APITCH + kc * 2) = pk2(p[0], p[1]); }
template <int WG>
__device__ __forceinline__ void fill_p(const bf16* X, int r0, bool sample, const float* spool, const LAS float* rs, f32x2 g, int c0, int kc, int rq, LAS unsigned char* A, float* outp) {
    f32x2 h[16];
    if (!sample) {
        const int lr0 = rq * 32, t0 = (r0 + lr0) & (TPS - 1), b = (r0 + lr0) >> 11;
#pragma unroll
        for (int k = 0; k < 16; ++k) h[k] = (f32x2){0.f, 0.f};
        if (t0 > 0) {
            unsigned xh[16];
#pragma unroll
            for (int k = 1; k < 16; ++k) xh[k] = *(const unsigned*)(X + (size_t)(r0 + lr0 - 16 + k) * DM + c0);
#pragma unroll
            for (int k = 1; k < 16; ++k) h[k] = bf2_to_f32(xh[k]) * rs[lr0 - 1 + k] * g;
        }
        unsigned xw[2][16];
#pragma unroll
        for (int blk = 0; blk < 2; ++blk)
#pragma unroll
            for (int k = 0; k < 16; ++k) xw[blk][k] = *(const unsigned*)(X + (size_t)(r0 + lr0 + blk * 16 + k) * DM + c0);
#pragma unroll
        for (int blk = 0; blk < 2; ++blk) {
#pragma unroll
            for (int k = 0; k < 16; ++k) {
                const int lr = lr0 + blk * 16 + k, tpos = t0 + blk * 16 + k;
                const f32x2 u = bf2_to_f32(xw[blk][k]) * rs[lr + 15] * g;
                h[k] = u;
                f32x2 sm = u;
#pragma unroll
                for (int j = 1; j < WG; ++j) sm += h[(k - j) & 15];
                const int cnt = (tpos + 1 < WG) ? tpos + 1 : WG;
                put_p(A, lr, kc, sm * (1.0f / (float)cnt) - u);
                if (tpos >= TPS - 15) *(f32x2*)(outp + O_POOLP + ((size_t)b * 15 + (tpos - (TPS - 15))) * DM + c0) = u;
            }
        }
    } else {
        unsigned xw[8];
#pragma unroll
        for (int i = 0; i < 8; ++i) xw[i] = *(const unsigned*)(X + (size_t)(r0 + rq * 8 + i) * DM + c0);
        const int seq = ((r0 - MP) >> 3) + rq;
        const float* sp = spool + (size_t)seq * 15 * DM + c0; float* np = outp + O_POOLS + (size_t)seq * 15 * DM + c0;
        h[0] = (f32x2){0.f, 0.f};
#pragma unroll
        for (int k = 1; k < 16; ++k) h[k] = *(const f32x2*)(sp + (size_t)(k - 1) * DM);
#pragma unroll
        for (int k = 9; k < 16; ++k) *(f32x2*)(np + (size_t)(k - 9) * DM) = h[k];
#pragma unroll
        for (int i = 0; i < 8; ++i) {
            const int lr = rq * 8 + i;
            const f32x2 u = bf2_to_f32(xw[i]) * rs[lr + 15] * g;
            h[i] = u;
            f32x2 sm = u;
#pragma unroll
            for (int j = 1; j < WG; ++j) sm += h[(i - j) & 15];
            put_p(A, lr, kc, sm * (1.0f / (float)WG) - u);
            *(f32x2*)(np + (size_t)(7 + i) * DM) = u;
        }
    }
}
template <int MF>
__device__ __forceinline__ void unit(const Frame& F, const Ptrs& P, int r0, int gi, int pmode) {
    constexpr bool sample = (MF == 1); constexpr int ROWS = 32 * MF;
    unsigned char* ws = P.ws();
    const bf16* Xin = (const bf16*)(ws + WS_XB); bf16* Xout = (bf16*)(ws + WS_XB2);
    const float* SSQin = (const float*)(ws + WS_SSQ); float* SSQout = (float*)(ws + WS_SSQ2);
    const bf16* Wp = (const bf16*)(ws + WS_WPOOL);
    LAS unsigned char* A = F.lds + RING_OFF + A_OFF; LAS float* rs = (LAS float*)(F.lds + RING_OFF + RS_OFF); LAS float* scr = (LAS float*)(F.lds + RING_OFF + SCR_OFF);
    const int lane = F.lane, wid = F.wave, l15 = lane & 15, kg = lane >> 4;
    constexpr int MR = 2 * MF;
    const bf16* Bw = Wp + (size_t)(gi * 256 + wid * 32 + 8 * (l15 >> 2) + (l15 & 3)) * 256 + 8 * kg;
    bf16x8 bfa[4][2], bfb[4][2];
    __syncthreads();
    if (F.tid < 15 + ROWS) { const int row = r0 - 15 + F.tid; rs[F.tid] = (row >= 0 && (F.tid >= 15 || !sample)) ? pg8::row_rstd(SSQin, row) : 0.f; }
    __syncthreads();
    if (pmode != 2) {
        const int cp = F.tid & 127, rq = F.tid >> 7, kc = 2 * cp, c0 = gi * 256 + kc;
        const f32x2 g = *(const f32x2*)(P.nmix() + c0);
        if (gi == 0) fill_p<2>(Xin, r0, sample, P.spool(), rs, g, c0, kc, rq, A, P.out());
        else if (gi == 1) fill_p<4>(Xin, r0, sample, P.spool(), rs, g, c0, kc, rq, A, P.out());
        else if (gi == 2) fill_p<8>(Xin, r0, sample, P.spool(), rs, g, c0, kc, rq, A, P.out());
        else fill_p<16>(Xin, r0, sample, P.spool(), rs, g, c0, kc, rq, A, P.out());
    }
    if (pmode == 1) return;
#pragma unroll
    for (int ks = 0; ks < 4; ++ks)
#pragma unroll
        for (int n = 0; n < 2; ++n) { bfa[ks][n] = *(const bf16x8*)(Bw + (size_t)(4 * n) * 256 + ks * 32); bfb[ks][n] = *(const bf16x8*)(Bw + (size_t)(4 * n) * 256 + (4 + ks) * 32); }
    v4u xo[MR];
#pragma unroll
    for (int m = 0; m < MR; ++m) xo[m] = *(const v4u*)(Xin + (size_t)(r0 + m * 16 + l15) * DM + gi * 256 + wid * 32 + 8 * kg);
    __syncthreads();
    f32x4 acc[MR][2];
#pragma unroll
    for (int m = 0; m < MR; ++m)
#pragma unroll
        for (int n = 0; n < 2; ++n) acc[m][n] = (f32x4){0.f, 0.f, 0.f, 0.f};
#pragma unroll
    for (int ks = 0; ks < 8; ++ks) {
        bf16x8 af[MR];
#pragma unroll
        for (int m = 0; m < MR; ++m) af[m] = *(const LAS bf16x8*)(A + (m * 16 + l15) * APITCH + (4 * ks + kg) * 16);
#pragma unroll
        for (int m = 0; m < MR; ++m)
#pragma unroll
            for (int n = 0; n < 2; ++n) acc[m][n] = __builtin_amdgcn_mfma_f32_16x16x32_bf16(ks < 4 ? bfa[ks & 3][n] : bfb[ks & 3][n], af[m], acc[m][n], 0, 0, 0);
    }
#pragma unroll
    for (int m = 0; m < MR; ++m) {
        const int rl = m * 16 + l15; const size_t off = (size_t)(r0 + rl) * DM + gi * 256 + wid * 32 + 8 * kg;
        const f32x4 v0 = pg8::bf4_to_f32((v2u){xo[m].x, xo[m].y}) + acc[m][0], v1 = pg8::bf4_to_f32((v2u){xo[m].z, xo[m].w}) + acc[m][1];
        if (pmode != 2) *(v4u*)(Xout + off) = (v4u){pg8::cvt_pk_bf16(v0[0], v0[1]), pg8::cvt_pk_bf16(v0[2], v0[3]), pg8::cvt_pk_bf16(v1[0], v1[1]), pg8::cvt_pk_bf16(v1[2], v1[3])};
        float sm = ((v0[0] * v0[0] + v0[1] * v0[1]) + (v0[2] * v0[2] + v0[3] * v0[3])) + ((v1[0] * v1[0] + v1[1] * v1[1]) + (v1[2] * v1[2] + v1[3] * v1[3]));
        sm += pg8::xor_shfl(sm, lane, 16); sm += pg8::xor_shfl(sm, lane, 32);
        if (kg == 0) scr[rl * 8 + wid] = sm;
    }
    __syncthreads();
    if (F.tid < ROWS) { const f32x4 p = *(const LAS f32x4*)(scr + F.tid * 8), q = *(const LAS f32x4*)(scr + F.tid * 8 + 4); const float t = ((p[0] + p[1]) + (p[2] + p[3])) + ((q[0] + q[1]) + (q[2] + q[3]));
        if (pmode != 2) SSQout[(size_t)(r0 + F.tid) * 4 + gi] = t; else if (t == 1.2345e33f) SSQout[0] = t; }
}
__device__ __forceinline__ void phase(const Frame& F, const Ptrs& P, int pmode) {
    constexpr int NPU = (MP / 128) * 4, NSU = (MS / 32) * 4;
    for (int u = F.vcu; u < NPU; u += F.G) unit<4>(F, P, (u >> 2) * 128, u & 3, pmode);
    { const Frame F2 = phase_frame(F, F.wave); for (int u = F2.vcu; u < NSU; u += F2.G) unit<1>(F2, P, MP + (u >> 2) * 32, u & 3, pmode); }
}
}


namespace att {
constexpr int BUF_BYTES = 6 * 8192, LDS_V = 3 * 8192, LDS_WS = 2 * BUF_BYTES, LDS_OST = LDS_WS + NWAVES * 256, LDS_TOTAL = LDS_OST + NWAVES * 4096;
__device__ __forceinline__ int crow(int r, int hi) { return (r & 3) + 8 * (r >> 2) + 4 * hi; }
__device__ __forceinline__ unsigned cvtpk_s(float lo, float hi) { typedef float f2 __attribute__((ext_vector_type(2))); typedef __bf16 b2 __attribute__((ext_vector_type(2))); f2 v = {lo, hi}; b2 b = __builtin_convertvector(v, b2); return __builtin_bit_cast(unsigned, b); }
typedef short v4i16_t __attribute__((ext_vector_type(4)));
__device__ __forceinline__ s16x4 vtr(const LAS unsigned char* p) { return __builtin_bit_cast(s16x4, __builtin_amdgcn_ds_read_tr16_b64_v4i16((LAS v4i16_t*)p)); }
constexpr float NEG = -1.0e30f;

struct Soft { v4u pa[5][2]; float l; };
__device__ __forceinline__ void softmax5(f32x16 (&sc)[5], float sk, Soft& R) {
    float m = sk;
#pragma unroll
    for (int i = 0; i < 5; ++i)
#pragma unroll
        for (int r = 0; r < 16; ++r) m = fmaxf(m, sc[i][r]);
    { auto rr = __builtin_amdgcn_permlane32_swap(__float_as_uint(m), __float_as_uint(m), false, false); m = fmaxf(__uint_as_float(rr[0]), __uint_as_float(rr[1])); }
    float l = 0.f;
#pragma unroll
    for (int i = 0; i < 5; ++i) {
#pragma unroll
        for (int r = 0; r < 16; ++r) { const float p = __builtin_amdgcn_exp2f(sc[i][r] - m); sc[i][r] = p; l += p; }
#pragma unroll
        for (int s = 0; s < 2; ++s) R.pa[i][s] = (v4u){cvtpk_s(sc[i][8 * s + 0], sc[i][8 * s + 1]), cvtpk_s(sc[i][8 * s + 2], sc[i][8 * s + 3]), cvtpk_s(sc[i][8 * s + 4], sc[i][8 * s + 5]), cvtpk_s(sc[i][8 * s + 6], sc[i][8 * s + 7])};
    }
    { auto rr = __builtin_amdgcn_permlane32_swap(__float_as_uint(l), __float_as_uint(l), false, false); l = __uint_as_float(rr[0]) + __uint_as_float(rr[1]); }
    R.l = l + __builtin_amdgcn_exp2f(sk - m);
}
__device__ __forceinline__ f32x16 qk_block(const LAS unsigned char* kt, int p, const bf16x8 (&qr)[4], int r32, int hi) {
    const LAS unsigned char* kp = kt + p * 512 + hi * 1024 + r32 * 16;
    f32x16 a = {};
#pragma unroll
    for (int d0 = 0; d0 < 4; ++d0) a = __builtin_amdgcn_mfma_f32_32x32x16_bf16(*(const LAS bf16x8*)(kp + d0 * 2048), qr[d0], a, 0, 0, 0);
    return a;
}
__device__ __forceinline__ void pv_step(f32x16 (&o)[2], const LAS unsigned char* vt, int ks, const v4u pa, int lane, int hi) {
    const LAS unsigned char* vp = vt + ((lane >> 4) & 1) * 32 + (lane & 3) * 8 + (4 * hi + ((lane & 15) >> 2)) * 64 + ks * 1024;
#pragma unroll
    for (int d0 = 0; d0 < 2; ++d0) {
        const s16x4 lo = vtr(vp + d0 * 4096), hh = vtr(vp + d0 * 4096 + 512);
        const bf16x8 vf = (bf16x8){lo[0], lo[1], lo[2], lo[3], hh[0], hh[1], hh[2], hh[3]};
        o[d0] = __builtin_amdgcn_mfma_f32_32x32x16_bf16(__builtin_bit_cast(bf16x8, pa), vf, o[d0], 0, 0, 0);
    }
}

struct KVRegs { v4u k[3], v[3]; };
__device__ __forceinline__ void prompt_load(KVRegs& R, int u, const bf16* K, const bf16* V, int lane, int wid) {
    const int b = u >> 7, kvh = (u >> 5) & 3, qb = u & 31, q0 = qb * 64, jmin = (qb >= 2) ? 0 : 2 - qb;
#pragma unroll
    for (int j = 0; j < 3; ++j) if (j >= jmin) {
        const long kr0 = (long)b * TPS + q0 - 128 + 64 * j;
        R.k[j] = *(const v4u*)(K + (kr0 + lane) * KVD + kvh * 64 + wid * 8);
        R.v[j] = *(const v4u*)(V + (kr0 + 16 * (wid & 3) + (lane >> 2)) * KVD + kvh * 64 + (wid >> 2) * 32 + (lane & 3) * 8);
    }
}
__device__ __forceinline__ void prompt_store(const KVRegs& R, int u, LAS unsigned char* buf, int lane, int wid) {
    const int qb = u & 31, jmin = (qb >= 2) ? 0 : 2 - qb;
#pragma unroll
    for (int j = 0; j < 3; ++j) if (j >= jmin) {
        *(LAS v4u*)(buf + j * 8192 + wid * 1024 + lane * 16) = R.k[j];
        *(LAS v4u*)(buf + LDS_V + j * 8192 + wid * 1024 + lane * 16) = R.v[j];
    }
}
__device__ __forceinline__ void prompt_compute(const Frame& F, int u, const LAS unsigned char* buf, const bf16* Q, bf16* O, const float* sinks) {
    const int lane = F.lane, wid = F.wave, r32 = lane & 31, hi = lane >> 5;
    const int b = u >> 7, kvh = (u >> 5) & 3, qb = u & 31, q0 = qb * 64, jmin = (qb >= 2) ? 0 : 2 - qb;
    const long rowbase = (long)b * TPS;
    const int g = wid >> 1, half = wid & 1, h = 4 * kvh + g;
    const bf16* Qw = Q + (rowbase + q0 + 32 * half) * DM + h * HD;
    bf16x8 qr[4];
#pragma unroll
    for (int d0 = 0; d0 < 4; ++d0) qr[d0] = *(const bf16x8*)(Qw + (long)r32 * DM + d0 * 16 + hi * 8);
    const float sk = sinks[h] * LOG2E;
    f32x16 sc[5];
#pragma unroll
    for (int i = 0; i < 5; ++i) {
        const int kb = half + i, tile = kb >> 1, p = kb & 1;
        if (tile >= jmin) sc[i] = qk_block(buf + tile * 8192, p, qr, r32, hi);
        else {
#pragma unroll
            for (int r = 0; r < 16; ++r) sc[i][r] = NEG;
        }
    }
#pragma unroll
    for (int r = 0; r < 16; ++r) { const int kk = crow(r, hi); if (!(kk > r32)) sc[0][r] = NEG; if (!(kk <= r32)) sc[4][r] = NEG; }
    Soft S; softmax5(sc, sk, S);
    f32x16 o[2]; o[0] = f32x16{}; o[1] = f32x16{};
#pragma unroll
    for (int i = 0; i < 5; ++i) {
        const int kb = half + i, tile = kb >> 1, p = kb & 1;
        if (tile >= jmin) {
#pragma unroll
            for (int s = 0; s < 2; ++s) pv_step(o, buf + LDS_V + tile * 8192, 2 * p + s, S.pa[i][s], lane, hi);
        }
    }
    LAS unsigned char* lds = F.lds + RING_OFF;
    LAS float* wsf = (LAS float*)(lds + LDS_WS) + wid * 64;
    if (hi == 0) wsf[r32] = S.l;
    LDS_WAIT();
    LAS bf16* stg = (LAS bf16*)(lds + LDS_OST) + wid * 2048;
#pragma unroll
    for (int r = 0; r < 16; ++r) { const int orow = crow(r, hi); const float rl = __builtin_amdgcn_rcpf(wsf[orow]);
#pragma unroll
        for (int d0 = 0; d0 < 2; ++d0) stg[orow * 64 + d0 * 32 + r32] = (bf16)f2bf(o[d0][r] * rl); }
    LDS_WAIT();
    bf16* Ow = O + (rowbase + q0 + 32 * half) * DM + h * HD;
#pragma unroll
    for (int i = 0; i < 4; ++i) { const int row = i * 8 + (lane >> 3), ch = lane & 7; const v4u v = *(const LAS v4u*)(stg + row * 64 + ch * 8); *(v4u*)(Ow + (long)row * DM + ch * 8) = v; }
    LDS_WAIT();
}

__device__ __forceinline__ void sample_pair(const Frame& F, int b, int hp, const bf16* Q, const bf16* Kn, const bf16* Vn, const float* ck, const float* cv, float* out, bf16* O, const float* sinks) {
    const int lane = F.lane, wid = F.wave, s = wid >> 2, tg = F.tid & 255, kvh = 2 * hp + s;
    LAS unsigned char* lds = F.lds + RING_OFF;
    LAS unsigned char* buf = lds + s * BUF_BYTES;
    __syncthreads();
    {
        const int q = tg & 15;
        f32x4 kx[8], vx[8];
#pragma unroll
        for (int it = 0; it < 8; ++it) { const int key = it * 16 + (tg >> 4); const size_t off = ((size_t)(b * 128 + key) * NKV + kvh) * HD + 4 * q;
            kx[it] = __builtin_nontemporal_load((const f32x4*)(ck + off)); vx[it] = __builtin_nontemporal_load((const f32x4*)(cv + off)); }
#pragma unroll
        for (int it = 0; it < 8; ++it) { const int key = it * 16 + (tg >> 4), tile = key >> 6, kk = key & 63;
            if (key >= 8) { const size_t oo = ((size_t)(b * 128 + key - 8) * NKV + kvh) * HD + 4 * q; __builtin_nontemporal_store(kx[it], (f32x4*)(out + O_KS + oo)); __builtin_nontemporal_store(vx[it], (f32x4*)(out + O_VS + oo)); }
            *(LAS v2u*)(buf + tile * 8192 + (q >> 1) * 1024 + kk * 16 + (q & 1) * 8) = (v2u){cvtpk_s(kx[it][0], kx[it][1]), cvtpk_s(kx[it][2], kx[it][3])};
            *(LAS v2u*)(buf + LDS_V + tile * 8192 + (q >> 3) * 4096 + (kk >> 4) * 1024 + (kk & 15) * 64 + ((4 * q) & 31) * 2) = (v2u){cvtpk_s(vx[it][0], vx[it][1]), cvtpk_s(vx[it][2], vx[it][3])}; }
        const int i8 = tg >> 4;
        v2u kn = (v2u){0u, 0u}, vn = (v2u){0u, 0u};
        if (i8 < 8) { const size_t off = ((size_t)MP + b * TSS + i8) * KVD + kvh * HD + 4 * q; kn = *(const v2u*)(Kn + off); vn = *(const v2u*)(Vn + off); }
        *(LAS v2u*)(buf + 2 * 8192 + (q >> 1) * 1024 + i8 * 16 + (q & 1) * 8) = kn;
        *(LAS v2u*)(buf + LDS_V + 2 * 8192 + (q >> 3) * 4096 + i8 * 64 + ((4 * q) & 31) * 2) = vn;
    }
    __syncthreads();
    if ((wid & 3) == 0) {
        const int r32 = lane & 31, hi = lane >> 5, qi = r32 & 7, h = 4 * kvh + (r32 >> 3);
        const long qrow = (long)MP + b * TSS + qi;
        bf16x8 qr[4];
#pragma unroll
        for (int d0 = 0; d0 < 4; ++d0) qr[d0] = *(const bf16x8*)(Q + qrow * DM + h * HD + d0 * 16 + hi * 8);
        const float sk = sinks[h] * LOG2E;
        f32x16 sc[5];
#pragma unroll
        for (int blk = 0; blk < 5; ++blk) sc[blk] = qk_block(buf + (blk >> 1) * 8192, blk & 1, qr, r32, hi);
#pragma unroll
        for (int blk = 0; blk < 5; ++blk)
#pragma unroll
            for (int r = 0; r < 16; ++r) { const int j = 32 * blk + crow(r, hi); if (!(j >= qi + 1 && j <= 128 + qi)) sc[blk][r] = NEG; }
        Soft S; softmax5(sc, sk, S);
        f32x16 o[2]; o[0] = f32x16{}; o[1] = f32x16{};
#pragma unroll
        for (int blk = 0; blk < 4; ++blk)
#pragma unroll
            for (int st = 0; st < 2; ++st) pv_step(o, buf + LDS_V + (blk >> 1) * 8192, 2 * (blk & 1) + st, S.pa[blk][st], lane, hi);
        pv_step(o, buf + LDS_V + 2 * 8192, 0, S.pa[4][0], lane, hi);
        LAS float* wsf = (LAS float*)(lds + LDS_WS) + wid * 64;
        if (hi == 0) wsf[r32] = S.l;
        LDS_WAIT();
#pragma unroll
        for (int r = 0; r < 16; ++r) { const int qq = crow(r, hi); const float rl = __builtin_amdgcn_rcpf(wsf[qq]);
            bf16* orow = O + ((long)MP + b * TSS + (qq & 7)) * DM + (4 * kvh + (qq >> 3)) * HD + r32;
#pragma unroll
            for (int d0 = 0; d0 < 2; ++d0) orow[d0 * 32] = (bf16)f2bf(o[d0][r] * rl); }
        LDS_WAIT();
    }
}

__device__ __forceinline__ void attn_phase(const Frame& F, const Ptrs& P) {
    const bf16* Q = (const bf16*)(P.ws() + WS_Q); const bf16* K = (const bf16*)(P.ws() + WS_K); const bf16* V = (const bf16*)(P.ws() + WS_V); bf16* O = (bf16*)(P.ws() + WS_O);
    LAS unsigned char* lds = F.lds + RING_OFF;
    constexpr int NPU = NPB * NKV * 32;
    const int per = (NPU + F.G - 1) / F.G, u0 = F.vcu * per, u1 = (u0 + per < NPU) ? u0 + per : NPU;
    if (u0 < u1) {
        KVRegs R;
        prompt_load(R, u0, K, V, F.lane, F.wave);
        __syncthreads();
        prompt_store(R, u0, lds, F.lane, F.wave);
        for (int u = u0; u < u1; ++u) {
            const int cur = (u - u0) & 1;
            if (u + 1 < u1) prompt_load(R, u + 1, K, V, F.lane, F.wave);
            __syncthreads();
            prompt_compute(F, u, lds + cur * BUF_BYTES, Q, O, P.sinks());
            if (u + 1 < u1) prompt_store(R, u + 1, lds + (cur ^ 1) * BUF_BYTES, F.lane, F.wave);
        }
    }
    for (int pu = F.vcu; pu < NSB * 2; pu += F.G) sample_pair(F, pu >> 1, pu & 1, Q, K, V, P.ck(), P.cv(), P.out(), O, P.sinks());
}
}

__device__ __forceinline__ void final_phase(const Frame& F, const Ptrs& P) {
    float* Y = P.out() + O_Y; const bf16* XB = (const bf16*)(P.ws() + WS_XB2); const float* SSQ = (const float*)(P.ws() + WS_SSQ2);
    const int gw = F.vcu * NWAVES + F.wave, NGW = F.G * NWAVES;
    f32x4 gv[4];
#pragma unroll
    for (int j = 0; j < 4; ++j) gv[j] = ((const f32x4*)P.nfin())[64 * j + F.lane];
    for (int m0 = 4 * gw; m0 < MT; m0 += 4 * NGW) {
        v2u w[4][4]; float rs[4];
#pragma unroll
        for (int r = 0; r < 4; ++r) { rs[r] = pg8::row_rstd(SSQ, m0 + r);
#pragma unroll
            for (int j = 0; j < 4; ++j) w[r][j] = __builtin_nontemporal_load((const v2u*)(XB + (size_t)(m0 + r) * DM) + 64 * j + F.lane); }
#pragma unroll
        for (int r = 0; r < 4; ++r)
#pragma unroll
            for (int j = 0; j < 4; ++j) __builtin_nontemporal_store(pg8::bf4_to_f32(w[r][j]) * rs[r] * gv[j], (f32x4*)(Y + (size_t)(m0 + r) * DM) + 64 * j + F.lane);
    }
}

constexpr int NPHASES = 14;
__global__ void __launch_bounds__(NWAVES * 64, 2) mk_fwd(Args args) {
    extern __shared__ __attribute__((aligned(16))) unsigned char lds_raw[];
    {
        LAS unsigned char* l0 = (LAS unsigned char*)lds_raw;
        for (int u = threadIdx.x; u < (LDS_BYTES - LDSCTL_OFF) / 4; u += NWAVES * 64) ((LAS unsigned*)(l0 + LDSCTL_OFF))[u] = 0u;
        __syncthreads();
    }
    const int lo = args.ph_lo, hi = args.ph_hi;
    const int wave0 = __builtin_amdgcn_readfirstlane(threadIdx.x >> 6);
    if (hi - lo > 1) (void)xcd_barrier_post((unsigned*)(args.ws + WS_CTL) + CW_BAR, (volatile LAS unsigned*)((LAS unsigned char*)lds_raw + MISC_OFF) + 8);
    for (int it = 2 * lo; it < 2 * hi; ++it) {
        const int ph = it >> 1; const bool dup = (it & 1) != 0;
        if (dup && !((DUP_MASK >> ph) & 1)) continue;
        int bx = blockIdx.x, G = gridDim.x; asm volatile("" : "+s"(bx), "+s"(G));
        ArgsP ap = (ArgsP)__builtin_amdgcn_kernarg_segment_ptr(); asm volatile("" : "+s"(ap));
        Frame F;
        F.lds = (LAS unsigned char*)lds_raw;
        F.tid = 0; F.lane = 0; F.wave = 0;
        F.G = G; F.vcu = (G % 8 == 0) ? (bx % 8) * (G / 8) + bx / 8 : bx;
        Ptrs P; P.ap = ap;
        unsigned char* ws = P.ws();
        bf16* XB = (bf16*)(ws + ((ph > 3) ? WS_XB2 : WS_XB)); bf16* Hb = (bf16*)(ws + WS_H); float* SSQ = (float*)(ws + ((ph > 3) ? WS_SSQ2 : WS_SSQ));
        const int kind = (int)((0x92187621214210ull >> (4 * ph)) & 15ull);
        const int f = (ph < 3) ? 0 : (ph < 6) ? 1 : (ph < 8) ? 2 : 3;
        if (kind == 0 && (PHMASK & 1)) {
            p0_prologue(phase_frame(F, wave0), P);
        } else if (kind == 1 && (PHMASK & 2)) {
            pg8::Gemm g{XB, (const bf16*)(ws + WS_W1 + f * W1_BYTES), MT, 2 * DFF, DM, DM, DM, 0, nullptr};
            pg8::StaticOrder S; S.init(MT, 2 * DFF, F.G, bx);
            pg8::EpiSwiglu E{(dup && PROBE_NULL_EPI == 1) ? nullptr : Hb, SSQ, dup && PROBE_NULL_EPI == 2};
            pg8::gemm_phase<pg8::EpiSwiglu, pg8::StaticOrder, true, true>(F.lds + RING_OFF, g, S, E, fresh_tid(wave0));
            if (!dup && f == 0 && bx >= 216) {
                const Frame Fc = phase_frame(F, wave0);
                __syncthreads();
                convert_items(Fc, P, I_W1, I_FFN, (bx - 216) * NWAVES + Fc.wave, (F.G - 216) * NWAVES);
            }
        } else if ((kind == 2 || kind == 8) && (PHMASK & 4)) {
            pg8::EpiRes E;
            E.xb = (dup && PROBE_NULL_EPI) ? nullptr : XB; E.ssq = SSQ; E.bias = nullptr; E.accs = dup ? 0.f : 1.f;
            pg8::StaticOrder S; S.init(MP, DM, F.G, bx);
            if (kind == 8) {
                const bf16* O = (const bf16*)(ws + WS_O);
                const pg8::Gemm g{O, (const bf16*)(ws + WS_WO), MP, DM, DM, DM, DM, 0, O + (size_t)MP * DM}; E.bias = dup ? nullptr : P.bo();
                pg8::gemm_phase<pg8::EpiRes, pg8::StaticOrder, true, true>(F.lds + RING_OFF, g, S, E, fresh_tid(wave0));
            } else {
                const pg8::Gemm g{Hb, (const bf16*)(ws + WS_W2 + f * W2_BYTES), MP, DM, DFF, DFF, DFF, 0, Hb + (size_t)MP * DFF};
                pg8::gemm_phase<pg8::EpiRes, pg8::StaticOrder, true, true>(F.lds + RING_OFF, g, S, E, fresh_tid(wave0));
            }
            if (!dup && kind == 2 && f < 3) {
                const Frame Fc = phase_frame(F, wave0);
                const int gwc = Fc.vcu * NWAVES + Fc.wave, ngwc = F.G * NWAVES;
                const int lo_i = (f == 2) ? IT_QKV : (f + 1) * I_FFN, hi_i = (f == 2) ? IT_POOL : (f + 2) * I_FFN;
                __syncthreads();
                convert_items(Fc, P, lo_i, hi_i, gwc, ngwc);
            }
        } else if (kind == 4 && (PHMASK & 8)) {
            poolf::phase(phase_frame(F, wave0), P, dup ? PROBE_POOL : 0);
        } else if (kind == 6 && (PHMASK & 16)) {
            pg8::Gemm g{XB, (const bf16*)(ws + WS_WQKV), MT, QKVN, DM, DM, DM, 0, nullptr};
            pg8::StaticOrder S; S.init(MT, QKVN, F.G, bx);
            pg8::EpiQKV E{(bf16*)(ws + WS_Q), (bf16*)(ws + WS_K), (bf16*)(ws + WS_V), SSQ, P.bqkv(), (const float*)(ws + WS_ROPE), P.out()};
            pg8::gemm_phase<pg8::EpiQKV, pg8::StaticOrder, true, true>(F.lds + RING_OFF, g, S, E, fresh_tid(wave0));
            if (!dup && bx >= 152) {
                const Frame Fc = phase_frame(F, wave0);
                __syncthreads();
                convert_items(Fc, P, 3 * I_FFN, 4 * I_FFN, (bx - 152) * NWAVES + Fc.wave, (F.G - 152) * NWAVES);
            }
        } else if (kind == 7 && (PHMASK & 32)) {
            att::attn_phase(phase_frame(F, wave0), P);
        } else if (kind == 9 && (PHMASK & 64)) {
            final_phase(phase_frame(F, wave0), P);
        }
        {
            ArgsP aq = (ArgsP)__builtin_amdgcn_kernarg_segment_ptr(); asm volatile("" : "+s"(aq));
            const int hi2 = aq->ph_hi, lo2 = aq->ph_lo;
            if ((it + 1 < 2 * hi2 - 1 || (DUP_MASK >> (hi2 - 1)) & 1) && hi2 - lo2 > 1) {
                XcdBarrier b2; b2.bar = (unsigned*)(aq->ws + WS_CTL) + CW_BAR; b2.x = xb_xcc_id(); b2.st = (volatile LAS unsigned*)((LAS unsigned char*)lds_raw + MISC_OFF) + 8;
                xcd_barrier(b2);
            }
        }
    }
}

extern "C" void kernel_launch(void* const* d_in, const int* in_sizes, int n_in, void* d_out, int out_size, void* d_ws, size_t ws_size, hipStream_t stream) {
    static int grid = 0;
    if (grid == 0) {
        if (n_in != 20 || (size_t)out_size != O_END || ws_size < WS_END) { fprintf(stderr, "kernel_launch: unexpected shapes (n_in %d out %d ws %zu)\n", n_in, out_size, ws_size); grid = -1; return; }
        int dev = 0, cus = 0, per_cu = 0;
        if (hipGetDevice(&dev) != hipSuccess || hipDeviceGetAttribute(&cus, hipDeviceAttributeMultiprocessorCount, dev) != hipSuccess) { grid = -1; return; }
        if (hipFuncSetAttribute((const void*)mk_fwd, hipFuncAttributeMaxDynamicSharedMemorySize, LDS_BYTES) != hipSuccess) { fprintf(stderr, "kernel_launch: hipFuncSetAttribute failed\n"); grid = -1; return; }
        if (hipOccupancyMaxActiveBlocksPerMultiprocessor(&per_cu, (const void*)mk_fwd, NWAVES * 64, LDS_BYTES) != hipSuccess || per_cu < 1)
            fprintf(stderr, "kernel_launch: occupancy query reports %d workgroups per CU\n", per_cu);
        (void)hipGetLastError();
        grid = cus;
    }
    if (grid < 0) return;
    (void)hipMemsetAsync((char*)d_ws + WS_CTL, 0, CTL_ZERO_BYTES, stream);
    Args a{};
    for (int i = 0; i < 20; ++i) a.in[i] = (const float*)d_in[i];
    a.out = (float*)d_out; a.ws = (unsigned char*)d_ws;
#if MK_ONE_LAUNCH
    a.ph_lo = 0; a.ph_hi = NPHASES;
    hipLaunchKernelGGL(mk_fwd, dim3(grid), dim3(NWAVES * 64), LDS_BYTES, stream, a);
#else
    for (int ph = 0; ph < NPHASES; ++ph) { a.ph_lo = ph; a.ph_hi = ph + 1; hipLaunchKernelGGL(mk_fwd, dim3(grid), dim3(NWAVES * 64), LDS_BYTES, stream, a); }
#endif
}
```

```cpp
#include <hip/hip_runtime.h>
#include <cstdio>
#include <cstdint>

#ifndef PHMASK
#define PHMASK 255
#endif
#ifndef PROBE_NULL_EPI
#define PROBE_NULL_EPI 0
#endif
#ifndef PROBE_POOL
#define PROBE_POOL 0
#endif
#ifndef DUP_MASK
#define DUP_MASK 0
#endif
#ifndef MK_ONE_LAUNCH
#define MK_ONE_LAUNCH 1
#endif

constexpr int DM = 1024, DFF = 2816, NPB = 8, TPS = 2048, MP = NPB * TPS, NSB = 128, TSS = 8, MS = NSB * TSS, MT = MP + MS;
constexpr int QKVN = 1536, NHEAD = 16, NKV = 4, HD = 64, KVD = 256;
constexpr int PAST = 8192;
constexpr float RMS_EPS = 1e-6f;
constexpr float LOG2E = 1.4426950408889634f;
constexpr float QSCALE = 0.125f * LOG2E;
constexpr size_t O_Y = 0;
constexpr size_t O_POOLP = (size_t)MT * DM;
constexpr size_t O_POOLS = O_POOLP + (size_t)NPB * 15 * DM;
constexpr size_t O_KP = O_POOLS + (size_t)NSB * 15 * DM;
constexpr size_t O_VP = O_KP + (size_t)NPB * 128 * KVD;
constexpr size_t O_KS = O_VP + (size_t)NPB * 128 * KVD;
constexpr size_t O_VS = O_KS + (size_t)NSB * 128 * KVD;
constexpr size_t O_END = O_VS + (size_t)NSB * 128 * KVD;

namespace pg8 {
#define PG8_LAS __attribute__((address_space(3)))
typedef unsigned short bf16_t;
typedef short bf16x8 __attribute__((ext_vector_type(8)));
typedef float f32x4 __attribute__((ext_vector_type(4)));
typedef float f32x2 __attribute__((ext_vector_type(2)));
typedef unsigned u32x4 __attribute__((ext_vector_type(4)));
typedef unsigned u32x2 __attribute__((ext_vector_type(2)));
constexpr int BM = 256, BK = 64, HALF = 128, HTB = HALF * BK * 2, STAGE_BYTES = 8 * HTB, NXCD = 8, WGM = 8;
constexpr int XA_OFF = STAGE_BYTES;
constexpr int EPI_SCR_OFF = STAGE_BYTES + 8192;

__host__ __device__ __forceinline__ int lds_byte(int r, int c) { const int st = (r >> 4) * 2 + (c >> 5), rr = r & 15, cc = c & 31, ob = rr * 64 + cc * 2; return st * 1024 + (ob ^ (((ob >> 9) & 1) << 5)); }
__host__ __device__ __forceinline__ void stage_rc(int b, int& R, int& C) { const int st = b / 1024, sb = b % 1024, swz = sb ^ (((sb >> 9) & 1) << 5); R = (st >> 1) * 16 + swz / 64; C = (st & 1) * 32 + (swz % 64) / 2; }
__host__ __device__ __forceinline__ int perm32(int rho) { const int n = rho >> 4, i = rho & 15; return 8 * (i >> 2) + 4 * n + (i & 3); }

struct Unit { int pm, pn, ks; };
struct Gemm { const bf16_t* A; const bf16_t* Bt; int M, N, K, lda, ldb, a_pn_cols; const bf16_t* AX; };

struct StaticOrder {
    int nM, nN, nwg, G, c;
    __host__ __device__ void init(int M, int N, int G_, int c_) { nM = M / BM; nN = N / BM; nwg = nM * nN; G = G_; c = c_; }
    __host__ __device__ bool next(int i, Unit& u) const {
        const long L = (long)i * G + c; if (L >= nwg) return false;
        int wgid = (int)L; { const int q = nwg / NXCD, r = nwg % NXCD, xcd = wgid % NXCD, off = wgid / NXCD; wgid = (xcd < r ? xcd * (q + 1) : r * (q + 1) + (xcd - r) * q) + off; }
        const int nig = WGM * nN, gid = wgid / nig, fm = gid * WGM, gsz = (nM - fm) < WGM ? (nM - fm) : WGM;
        u.pm = fm + ((wgid % nig) % gsz); u.pn = (wgid % nig) / gsz; u.ks = 0; return true;
    }
    __device__ __forceinline__ void a_ready(const Unit&) const {}
    __device__ __forceinline__ void done(const Unit&) const {}
};

struct SplitOrder {
    int c, n;
    __device__ __forceinline__ bool next(int i, Unit& u) const { if (i > 0 || c >= n) return false; u.pm = 64 + ((c & 15) >> 2); u.pn = c & 3; u.ks = c >> 4; return true; }
    __device__ __forceinline__ void a_ready(const Unit&) const {}
    __device__ __forceinline__ void done(const Unit&) const {}
};

__device__ __forceinline__ unsigned cvt_pk_bf16(float lo, float hi) { unsigned r; asm volatile("v_cvt_pk_bf16_f32 %0, %1, %2" : "=v"(r) : "v"(lo), "v"(hi)); return r; }

__device__ __forceinline__ float xor_shfl(float v, int lane, int mask) { return __builtin_bit_cast(float, __builtin_amdgcn_ds_bpermute((lane ^ mask) << 2, __builtin_bit_cast(int, v))); }
__device__ __forceinline__ float rstd_of(const f32x4 a) { return __builtin_amdgcn_rsqf(((a[0] + a[1]) + (a[2] + a[3])) * (1.0f / DM) + RMS_EPS); }
__device__ __forceinline__ float row_rstd(const float* ssq, int row) { return rstd_of(*(const f32x4*)(ssq + (size_t)row * 4)); }

struct EpiSwiglu {
    static constexpr bool PERM = true, AFTER_DRAIN = false, XROWS = false;
    bf16_t* H; const float* ssq; bool nostore;
    __device__ __forceinline__ void operator()(const f32x4 (&acc)[2][2][4][2], const Unit& u, int wr, int wc, int fr, int fq, PG8_LAS unsigned char* xl, int tid) const {
        if (H == nullptr) return;
        const int row0 = u.pm * BM + wr * 64 + fr, col0 = u.pn * HALF + wc * 32 + 8 * fq;
        f32x4 sq[2][4];
#pragma unroll
        for (int ai = 0; ai < 2; ++ai)
#pragma unroll
            for (int m = 0; m < 4; ++m) sq[ai][m] = *(const f32x4*)(ssq + (size_t)(row0 + ai * HALF + m * 16) * 4);
#pragma unroll
        for (int ai = 0; ai < 2; ++ai)
#pragma unroll
            for (int m = 0; m < 4; ++m) {
                const int row = row0 + ai * HALF + m * 16;
                const float rs = rstd_of(sq[ai][m]);
                const f32x2 c1 = (f32x2){-rs * LOG2E, -rs * LOG2E}, c2 = (f32x2){rs * rs, rs * rs}, one = (f32x2){1.0f, 1.0f};
                unsigned w[4];
#pragma unroll
                for (int n = 0; n < 2; ++n)
#pragma unroll
                    for (int hh = 0; hh < 2; ++hh) {
                        const f32x2 ag = (f32x2){acc[ai][0][m][n][2 * hh], acc[ai][0][m][n][2 * hh + 1]}, au = (f32x2){acc[ai][1][m][n][2 * hh], acc[ai][1][m][n][2 * hh + 1]};
                        const f32x2 t = ag * c1;
                        const f32x2 d = (f32x2){__builtin_amdgcn_exp2f(t[0]), __builtin_amdgcn_exp2f(t[1])} + one;
                        const f32x2 r = (f32x2){__builtin_amdgcn_rcpf(d[0]), __builtin_amdgcn_rcpf(d[1])};
                        const f32x2 o = ((ag * au) * c2) * r;
                        w[2 * n + hh] = cvt_pk_bf16(o[0], o[1]);
                    }
                if (!nostore) *(u32x4*)(H + (size_t)row * DFF + col0) = (u32x4){w[0], w[1], w[2], w[3]}; else asm volatile("" :: "v"(w[0]), "v"(w[1]), "v"(w[2]), "v"(w[3]));
            }
    }
};
__device__ __forceinline__ f32x4 bf4_to_f32(const u32x2 w) { return (f32x4){__builtin_bit_cast(float, w.x << 16), __builtin_bit_cast(float, w.x & 0xffff0000u), __builtin_bit_cast(float, w.y << 16), __builtin_bit_cast(float, w.y & 0xffff0000u)}; }
struct EpiRes {
    static constexpr bool PERM = true, AFTER_DRAIN = false, XROWS = true;
    bf16_t* xb; float* ssq; const float* bias; float accs;
    __device__ __forceinline__ void xrows(const f32x4 (&accx)[2], const Unit& u, int wr, int wc, int fr, int fq, PG8_LAS unsigned char* xl, int tid) const {
        if (xb == nullptr) return;
        const int row = MP + 16 * u.pm + fr, col0 = u.pn * BM + wr * HALF + wc * 32 + 8 * fq;
        bf16_t* xp = xb + (size_t)row * DM + col0;
        const u32x4 w = *(const u32x4*)xp;
        f32x4 a0 = accx[0], a1 = accx[1];
#if DUP_MASK != 0
        a0 = a0 * accs; a1 = a1 * accs;
#endif
        if (bias) { a0 += *(const f32x4*)(bias + col0); a1 += *(const f32x4*)(bias + col0 + 4); }
        const f32x4 v0 = bf4_to_f32((u32x2){w.x, w.y}) + a0, v1 = bf4_to_f32((u32x2){w.z, w.w}) + a1;
        *(u32x4*)xp = (u32x4){cvt_pk_bf16(v0[0], v0[1]), cvt_pk_bf16(v0[2], v0[3]), cvt_pk_bf16(v1[0], v1[1]), cvt_pk_bf16(v1[2], v1[3])};
        float sm = ((v0[0] * v0[0] + v0[1] * v0[1]) + (v0[2] * v0[2] + v0[3] * v0[3])) + ((v1[0] * v1[0] + v1[1] * v1[1]) + (v1[2] * v1[2] + v1[3] * v1[3]));
        { const int ln = fr + 16 * fq; sm += xor_shfl(sm, ln, 16); sm += xor_shfl(sm, ln, 32); }
        if (fq == 0) ((PG8_LAS float*)(xl + 4096))[fr * 8 + wr * 4 + wc] = sm;
    }
    __device__ __forceinline__ void operator()(const f32x4 (&acc)[2][2][4][2], const Unit& u, int wr, int wc, int fr, int fq, PG8_LAS unsigned char* xl, int tid) const {
        if (xb == nullptr) return;
        const int row0 = u.pm * BM + wr * 64 + fr, col0 = u.pn * BM + wc * 32 + 8 * fq;
        PG8_LAS float* scr = (PG8_LAS float*)xl;
        f32x4 bv[2][2];
#pragma unroll
        for (int bj = 0; bj < 2; ++bj)
#pragma unroll
            for (int n = 0; n < 2; ++n) bv[bj][n] = bias ? *(const f32x4*)(bias + col0 + bj * HALF + 4 * n) : (f32x4){0.f, 0.f, 0.f, 0.f};
#pragma unroll
        for (int ai = 0; ai < 2; ++ai) {
            u32x4 xo[4][2];
#pragma unroll
            for (int m = 0; m < 4; ++m) {
                const bf16_t* xp = xb + (size_t)(row0 + ai * HALF + m * 16) * DM + col0;
#pragma unroll
                for (int bj = 0; bj < 2; ++bj) xo[m][bj] = *(const u32x4*)(xp + bj * HALF);
            }
#pragma unroll
            for (int m = 0; m < 4; ++m) {
                bf16_t* xp = xb + (size_t)(row0 + ai * HALF + m * 16) * DM + col0;
                f32x2 s2 = (f32x2){0.f, 0.f};
#pragma unroll
                for (int bj = 0; bj < 2; ++bj) {
                    const u32x4 w = xo[m][bj];
                    f32x4 a0 = acc[ai][bj][m][0], a1 = acc[ai][bj][m][1];
#if DUP_MASK != 0
                    a0 = a0 * accs; a1 = a1 * accs;
#endif
                    if (bias) { a0 += bv[bj][0]; a1 += bv[bj][1]; }
                    const f32x2 v00 = (f32x2){__builtin_bit_cast(float, w.x << 16), __builtin_bit_cast(float, w.x & 0xffff0000u)} + (f32x2){a0[0], a0[1]};
                    const f32x2 v01 = (f32x2){__builtin_bit_cast(float, w.y << 16), __builtin_bit_cast(float, w.y & 0xffff0000u)} + (f32x2){a0[2], a0[3]};
                    const f32x2 v10 = (f32x2){__builtin_bit_cast(float, w.z << 16), __builtin_bit_cast(float, w.z & 0xffff0000u)} + (f32x2){a1[0], a1[1]};
                    const f32x2 v11 = (f32x2){__builtin_bit_cast(float, w.w << 16), __builtin_bit_cast(float, w.w & 0xffff0000u)} + (f32x2){a1[2], a1[3]};
                    *(u32x4*)(xp + bj * HALF) = (u32x4){cvt_pk_bf16(v00[0], v00[1]), cvt_pk_bf16(v01[0], v01[1]), cvt_pk_bf16(v10[0], v10[1]), cvt_pk_bf16(v11[0], v11[1])};
                    s2 = v00 * v00 + s2; s2 = v01 * v01 + s2; s2 = v10 * v10 + s2; s2 = v11 * v11 + s2;
                }
                float sm = s2[0] + s2[1];
                { const int ln = fr + 16 * fq; sm += xor_shfl(sm, ln, 16); sm += xor_shfl(sm, ln, 32); }
                if (fq == 0) scr[(ai * HALF + wr * 64 + m * 16 + fr) * 4 + wc] = sm;
            }
            asm volatile("" ::: "memory");
        }
        asm volatile("s_waitcnt lgkmcnt(0)" ::: "memory"); __builtin_amdgcn_s_barrier(); asm volatile("" ::: "memory");
        if (tid < BM) { const f32x4 p = *(const PG8_LAS f32x4*)(scr + tid * 4); ssq[(size_t)(u.pm * BM + tid) * 4 + u.pn] = (p[0] + p[1]) + (p[2] + p[3]); }
        if (tid < 16) { const PG8_LAS f32x4* q = (const PG8_LAS f32x4*)(xl + 4096) + tid * 2; const f32x4 p0 = q[0], p1 = q[1];
            ssq[(size_t)(MP + 16 * u.pm + tid) * 4 + u.pn] = ((p0[0] + p0[1]) + (p0[2] + p0[3])) + ((p1[0] + p1[1]) + (p1[2] + p1[3])); }
    }
};
template <int NSPL>
struct EpiSlab {
    static constexpr bool PERM = true, AFTER_DRAIN = false, XROWS = false;
    float* slab; unsigned* cnt; unsigned* tmo; bf16_t* xb; float* ssq; const float* bias; float accs;
    __device__ __forceinline__ void operator()(const f32x4 (&acc)[2][2][4][2], const Unit& u, int wr, int wc, int fr, int fq, PG8_LAS unsigned char* xl, int tid) const {
        const int tile = (u.pm - 64) * 4 + u.pn, unit = u.ks * 16 + tile;
        const __amdgpu_buffer_rsrc_t rs = __builtin_amdgcn_make_buffer_rsrc(slab, 0, 16 * NSPL * 32 * 512 * 16, 0x00020000);
        const int voff = (unit * 32 * 512 + tid) * 16;
#pragma unroll
        for (int ai = 0; ai < 2; ++ai)
#pragma unroll
            for (int bj = 0; bj < 2; ++bj)
#pragma unroll
                for (int m = 0; m < 4; ++m)
#pragma unroll
                    for (int n = 0; n < 2; ++n) __builtin_amdgcn_raw_buffer_store_b128(__builtin_bit_cast(u32x4, acc[ai][bj][m][n]), rs, voff + (ai * 16 + bj * 8 + m * 2 + n) * 512 * 16, 0, 16  );
        asm volatile("s_waitcnt vmcnt(0)" ::: "memory");
        asm volatile("s_waitcnt lgkmcnt(0)" ::: "memory"); __builtin_amdgcn_s_barrier(); asm volatile("" ::: "memory");
        unsigned* c = cnt + tile * 64;
        if (tid == 0) __hip_atomic_fetch_add(c, 1u, __ATOMIC_RELAXED, __HIP_MEMORY_SCOPE_AGENT);
        if (u.ks >= 8) return;
        if (tid < 64) {
            const unsigned long long t0 = __builtin_amdgcn_s_memrealtime();
            while ((unsigned)__builtin_amdgcn_readfirstlane(__hip_atomic_load(c, __ATOMIC_RELAXED, __HIP_MEMORY_SCOPE_AGENT)) < (unsigned)NSPL) {
                if (__builtin_amdgcn_s_memrealtime() - t0 > 2000000ull) { if (tid == 0) __hip_atomic_store(tmo, 1u, __ATOMIC_RELAXED, __HIP_MEMORY_SCOPE_AGENT); break; }
                __builtin_amdgcn_s_sleep(2); }
            __builtin_amdgcn_fence(__ATOMIC_ACQUIRE, "agent");
            asm volatile("s_waitcnt vmcnt(0)" ::: "memory");
        }
        asm volatile("" ::: "memory"); __builtin_amdgcn_s_barrier(); asm volatile("" ::: "memory");
        for (int rg = u.ks; rg < 8; rg += NSPL) {
        const int ai = rg >> 2, m = rg & 3;
        const int row = u.pm * BM + ai * HALF + wr * 64 + m * 16 + fr, col0 = u.pn * BM + wc * 32 + 8 * fq;
        bf16_t* xp = xb + (size_t)row * DM + col0;
        u32x4 xo[2];
#pragma unroll
        for (int bj = 0; bj < 2; ++bj) xo[bj] = *(const u32x4*)(xp + bj * HALF);
        f32x4 sum[2][2];
#pragma unroll
        for (int bj = 0; bj < 2; ++bj)
#pragma unroll
            for (int n = 0; n < 2; ++n) sum[bj][n] = (f32x4){0.f, 0.f, 0.f, 0.f};
#pragma unroll
        for (int sp = 0; sp < NSPL; ++sp) {
            const int so = (((sp * 16 + tile) * 32 + ai * 16 + m * 2) * 512 + tid) * 16;
#pragma unroll
            for (int bj = 0; bj < 2; ++bj)
#pragma unroll
                for (int n = 0; n < 2; ++n) sum[bj][n] += __builtin_bit_cast(f32x4, __builtin_amdgcn_raw_buffer_load_b128(rs, so + (bj * 8 + n) * 512 * 16, 0, 16  ));
        }
        PG8_LAS float* scr = (PG8_LAS float*)xl;
        float sm = 0.f;
#pragma unroll
        for (int bj = 0; bj < 2; ++bj) {
            f32x4 v0 = bf4_to_f32((u32x2){xo[bj].x, xo[bj].y}) + sum[bj][0] * accs, v1 = bf4_to_f32((u32x2){xo[bj].z, xo[bj].w}) + sum[bj][1] * accs;
            if (bias) { v0 += *(const f32x4*)(bias + col0 + bj * HALF); v1 += *(const f32x4*)(bias + col0 + bj * HALF + 4); }
            *(u32x4*)(xp + bj * HALF) = (u32x4){cvt_pk_bf16(v0[0], v0[1]), cvt_pk_bf16(v0[2], v0[3]), cvt_pk_bf16(v1[0], v1[1]), cvt_pk_bf16(v1[2], v1[3])};
            sm += ((v0[0] * v0[0] + v0[1] * v0[1]) + (v0[2] * v0[2] + v0[3] * v0[3])) + ((v1[0] * v1[0] + v1[1] * v1[1]) + (v1[2] * v1[2] + v1[3] * v1[3]));
        }
        { const int ln = fr + 16 * fq; sm += xor_shfl(sm, ln, 16); sm += xor_shfl(sm, ln, 32); }
        if (fq == 0) scr[(wr * 16 + fr) * 4 + wc] = sm;
        asm volatile("s_waitcnt lgkmcnt(0)" ::: "memory"); __builtin_amdgcn_s_barrier(); asm volatile("" ::: "memory");
        if (tid < 32) { const f32x4 p = *(const PG8_LAS f32x4*)(scr + tid * 4);
            ssq[(size_t)(u.pm * BM + ai * HALF + (tid >> 4) * 64 + m * 16 + (tid & 15)) * 4 + u.pn] = (p[0] + p[1]) + (p[2] + p[3]); }
        asm volatile("s_waitcnt lgkmcnt(0)" ::: "memory"); __builtin_amdgcn_s_barrier(); asm volatile("" ::: "memory");
        }
    }
};
struct EpiQKV {
    static constexpr bool PERM = true, AFTER_DRAIN = false, XROWS = false;
    bf16_t* Q; bf16_t* K; bf16_t* V; const float* ssq; const float* bias; const float* rope; float* out;
    __device__ __forceinline__ void operator()(const f32x4 (&acc)[2][2][4][2], const Unit& u, int wr, int wc, int fr, int fq, PG8_LAS unsigned char* xl, int tid) const {
        const int row0 = u.pm * BM + wr * 64 + fr, pn = u.pn, dd0 = 8 * fq, nat0 = pn * 256 + wc * 64 + dd0;
        f32x4 bv[2][2];
#pragma unroll
        for (int bj = 0; bj < 2; ++bj)
#pragma unroll
            for (int n = 0; n < 2; ++n) bv[bj][n] = *(const f32x4*)(bias + nat0 + bj * 32 + 4 * n);
        float rs8[2][4];
        {
            f32x4 sq[2][4];
#pragma unroll
            for (int ai = 0; ai < 2; ++ai)
#pragma unroll
                for (int m = 0; m < 4; ++m) sq[ai][m] = *(const f32x4*)(ssq + (size_t)(row0 + ai * HALF + m * 16) * 4);
#pragma unroll
            for (int ai = 0; ai < 2; ++ai)
#pragma unroll
                for (int m = 0; m < 4; ++m) { rs8[ai][m] = rstd_of(sq[ai][m]); asm volatile("" : "+v"(rs8[ai][m])); }
        }
        asm volatile("" ::: "memory");
#pragma unroll
        for (int ah = 0; ah < 4; ++ah) {
            const int ai = ah >> 1;
            f32x4 rp[4][4];
            if (pn < 5) {
#pragma unroll
                for (int m = 2 * (ah & 1); m < 2 * (ah & 1) + 2; ++m) { const int row = row0 + ai * HALF + m * 16;
                    const int pidx = (row < MP) ? (row & (TPS - 1)) : TPS + ((row - MP) & (TSS - 1));
                    const f32x4* rq = (const f32x4*)(rope + ((size_t)pidx * 32 + dd0) * 2);
#pragma unroll
                    for (int j = 0; j < 4; ++j) rp[m][j] = rq[j]; }
            }
#pragma unroll
            for (int m = 2 * (ah & 1); m < 2 * (ah & 1) + 2; ++m) {
                const int row = row0 + ai * HALF + m * 16;
                const float rs = rs8[ai][m];
                f32x4 v[2][2];
#pragma unroll
                for (int bj = 0; bj < 2; ++bj)
#pragma unroll
                    for (int n = 0; n < 2; ++n) v[bj][n] = acc[ai][bj][m][n] * rs + bv[bj][n];
                if (pn < 5) {
#pragma unroll
                    for (int n = 0; n < 2; ++n) {
                        const f32x4 cs0 = rp[m][2 * n], cs1 = rp[m][2 * n + 1];
                        const float c[4] = {cs0[0], cs0[2], cs1[0], cs1[2]}, sn[4] = {cs0[1], cs0[3], cs1[1], cs1[3]};
                        const f32x4 x1 = v[0][n], x2 = v[1][n];
#pragma unroll
                        for (int i = 0; i < 4; ++i) { v[0][n][i] = x1[i] * c[i] - x2[i] * sn[i]; v[1][n][i] = x2[i] * c[i] + x1[i] * sn[i]; }
                    }
                }
                if (pn < 4) {
#pragma unroll
                    for (int bj = 0; bj < 2; ++bj) { const f32x4 a = v[bj][0] * QSCALE, b = v[bj][1] * QSCALE;
                        *(u32x4*)(Q + (size_t)row * DM + nat0 + bj * 32) = (u32x4){cvt_pk_bf16(a[0], a[1]), cvt_pk_bf16(a[2], a[3]), cvt_pk_bf16(b[0], b[1]), cvt_pk_bf16(b[2], b[3])}; }
                } else {
                    bf16_t* kv = (pn == 4) ? K : V;
                    const int c0 = wc * 64 + dd0;
#pragma unroll
                    for (int bj = 0; bj < 2; ++bj) { const f32x4 a = v[bj][0], b = v[bj][1];
                        *(u32x4*)(kv + (size_t)row * KVD + c0 + bj * 32) = (u32x4){cvt_pk_bf16(a[0], a[1]), cvt_pk_bf16(a[2], a[3]), cvt_pk_bf16(b[0], b[1]), cvt_pk_bf16(b[2], b[3])}; }
                    float* dst = nullptr;
                    if (row < MP) { const int t = row & (TPS - 1); if (t >= TPS - 128) dst = out + ((pn == 4) ? O_KP : O_VP) + ((size_t)(row >> 11) * 128 + (t - (TPS - 128))) * KVD + c0; }
                    else { const int r = row - MP; dst = out + ((pn == 4) ? O_KS : O_VS) + ((size_t)(r >> 3) * 128 + 120 + (r & 7)) * KVD + c0; }
                    if (dst) {
#pragma unroll
                        for (int bj = 0; bj < 2; ++bj)
#pragma unroll
                            for (int n = 0; n < 2; ++n) *(f32x4*)(dst + bj * 32 + 4 * n) = v[bj][n];
                    }
                }
            }
            asm volatile("" ::: "memory");
        }
    }
};

template <class Epi, class Sched, bool ALIGN_EPI = false, bool SP2 = false>
__device__ __forceinline__ void gemm_phase(PG8_LAS unsigned char* lds, const Gemm g, const Sched& S, const Epi& E, const int tid) {
    const int wid = __builtin_amdgcn_readfirstlane(tid >> 6), lane = tid & 63, wr = wid >> 2, wc = wid & 3, fr = lane & 15, fq = lane >> 4;
    const int K = g.K, nt = K / BK;
    unsigned voffA[2], voffB[2];
#pragma unroll
    for (int i = 0; i < 2; ++i) { int R, C; stage_rc(tid * 16 + i * 8192, R, C); const int Rb = Epi::PERM ? ((R & ~31) + perm32(R & 31)) : R;
        voffA[i] = (unsigned)(R * g.lda + C) * 2u; voffB[i] = (unsigned)(Rb * g.ldb + C) * 2u; }
    const size_t kstep = (size_t)(BK * 2);
    const size_t hstepA = (size_t)HALF * g.lda * 2, hstepB = (size_t)HALF * g.ldb * 2;
    const size_t tstepA = 2 * hstepA, tstepB = 2 * hstepB;
    const size_t pnA = (size_t)g.a_pn_cols * 2;
    const unsigned ldsw = (unsigned)wid * 1024u;
    const int aoff = lds_byte(wr * 64 + fr, fq * 8), boff = lds_byte(wc * 32 + fr, fq * 8);
#define PG8_SA(b, h) (((b) * 2 + (h)) * HTB)
#define PG8_SB(b, h) ((4 + (b) * 2 + (h)) * HTB)
#define PG8_STAGE(bufoff, gbase, voff) do { _Pragma("unroll") for (int _i = 0; _i < 2; ++_i) \
        __builtin_amdgcn_global_load_lds((const unsigned*)((const char*)(gbase) + (voff)[_i]), (PG8_LAS unsigned*)(lds + (bufoff) + ldsw + _i * 8192), 16, 0, 0); } while (0)
#define PG8_LDA(dst, b, h) do { _Pragma("unroll") for (int m = 0; m < 4; ++m) _Pragma("unroll") for (int k = 0; k < 2; ++k) dst[m][k] = *(const PG8_LAS bf16x8*)(lds + PG8_SA(b, h) + aoff + m * 2048 + k * 1024); } while (0)
#define PG8_LDB(dst, b, h) do { _Pragma("unroll") for (int n = 0; n < 2; ++n) _Pragma("unroll") for (int k = 0; k < 2; ++k) dst[n][k] = *(const PG8_LAS bf16x8*)(lds + PG8_SB(b, h) + boff + n * 2048 + k * 1024); } while (0)
#define PG8_MMA(ai, bj, At, Bt) do { __builtin_amdgcn_s_setprio(1); _Pragma("unroll") for (int m = 0; m < 4; ++m) _Pragma("unroll") for (int n = 0; n < 2; ++n) _Pragma("unroll") for (int k = 0; k < 2; ++k) \
        acc[ai][bj][m][n] = __builtin_amdgcn_mfma_f32_16x16x32_bf16(Bt[n][k], At[m][k], acc[ai][bj][m][n], 0, 0, 0); __builtin_amdgcn_s_setprio(0); } while (0)
#define PG8_WAIT_V(n) asm volatile("s_waitcnt vmcnt(" #n ")" ::: "memory")
#define PG8_WAIT_L(n) asm volatile("s_waitcnt lgkmcnt(" #n ")" ::: "memory")
#define PG8_BAR __builtin_amdgcn_s_barrier()
#define PG8_SCHED __builtin_amdgcn_sched_barrier(0)
    Unit cur, nxt; int ui = 0;
    if (!S.next(0, cur)) return;
    f32x4 accx[2] = {(f32x4){0.f, 0.f, 0.f, 0.f}, (f32x4){0.f, 0.f, 0.f, 0.f}}; bf16x8 axf[2];
    const unsigned voffX = (unsigned)((lane & 15) * g.lda + 32 * wid + 8 * (lane >> 4)) * 2u;
    const size_t xstep = (size_t)16 * g.lda * 2;
#define PG8_XSTAGE(b, xbase) do { if constexpr (Epi::XROWS) { if (wid < 2) \
        __builtin_amdgcn_global_load_lds((const unsigned*)((const char*)(xbase) + voffX), (PG8_LAS unsigned*)(lds + XA_OFF + (b) * 2048 + ldsw), 16, 0, 0); } } while (0)
#define PG8_LDX(b) do { if constexpr (Epi::XROWS) { _Pragma("unroll") for (int k = 0; k < 2; ++k) axf[k] = *(const PG8_LAS bf16x8*)(lds + XA_OFF + (b) * 2048 + k * 1024 + lane * 16); } } while (0)
#define PG8_MMX() do { if constexpr (Epi::XROWS) { __builtin_amdgcn_s_setprio(1); if (wr == 0) { _Pragma("unroll") for (int n = 0; n < 2; ++n) _Pragma("unroll") for (int k = 0; k < 2; ++k) accx[n] = __builtin_amdgcn_mfma_f32_16x16x32_bf16(B0[n][k], axf[k], accx[n], 0, 0, 0); } \
        else { _Pragma("unroll") for (int n = 0; n < 2; ++n) _Pragma("unroll") for (int k = 0; k < 2; ++k) accx[n] = __builtin_amdgcn_mfma_f32_16x16x32_bf16(B1[n][k], axf[k], accx[n], 0, 0, 0); } __builtin_amdgcn_s_setprio(0); } } while (0)
    f32x4 acc[2][2][4][2];
#pragma unroll
    for (int a = 0; a < 2; ++a)
#pragma unroll
        for (int b = 0; b < 2; ++b)
#pragma unroll
            for (int m = 0; m < 4; ++m)
#pragma unroll
                for (int n = 0; n < 2; ++n) acc[a][b][m][n] = (f32x4){0.f, 0.f, 0.f, 0.f};
    bf16x8 At[4][2], B0[2][2], B1[2][2];
    const size_t ksb = (size_t)K * 2;
    const char* cA = (const char*)g.A + (size_t)cur.pm * tstepA + (size_t)cur.pn * pnA + (size_t)cur.ks * ksb; const char* cB = (const char*)g.Bt + (size_t)cur.pn * tstepB + (size_t)cur.ks * ksb;
    const char* cX = Epi::XROWS ? (const char*)g.AX + (size_t)cur.pm * xstep : nullptr;
    S.a_ready(cur);
    if constexpr (SP2) {
        PG8_STAGE(PG8_SB(0, 0), cB, voffB); PG8_STAGE(PG8_SB(0, 1), cB + hstepB, voffB); PG8_STAGE(PG8_SA(0, 0), cA, voffA); PG8_XSTAGE(0, cX); PG8_STAGE(PG8_SA(0, 1), cA + hstepA, voffA);
        if (wr == 1) PG8_BAR;
        PG8_WAIT_V(2); PG8_BAR;
        PG8_STAGE(PG8_SB(1, 0), cB + kstep, voffB); PG8_STAGE(PG8_SA(1, 0), cA + kstep, voffA); PG8_XSTAGE(1, cX + kstep); PG8_STAGE(PG8_SB(1, 1), cB + hstepB + kstep, voffB);
        PG8_WAIT_V(6); PG8_BAR;
    } else {
        PG8_STAGE(PG8_SB(0, 0), cB, voffB); PG8_STAGE(PG8_SA(0, 0), cA, voffA); PG8_STAGE(PG8_SB(0, 1), cB + hstepB, voffB); PG8_STAGE(PG8_SA(0, 1), cA + hstepA, voffA);
        if (wr == 1) PG8_BAR;
        PG8_WAIT_V(4); PG8_BAR;
        PG8_STAGE(PG8_SB(1, 0), cB + kstep, voffB); PG8_STAGE(PG8_SA(1, 0), cA + kstep, voffA); PG8_STAGE(PG8_SB(1, 1), cB + hstepB + kstep, voffB);
        PG8_WAIT_V(6); PG8_BAR;
    }
    for (;;) {
        const bool has_next = S.next(ui + 1, nxt);
        const char* nA = has_next ? (const char*)g.A + (size_t)nxt.pm * tstepA + (size_t)nxt.pn * pnA + (size_t)nxt.ks * ksb : cA; const char* nB = has_next ? (const char*)g.Bt + (size_t)nxt.pn * tstepB + (size_t)nxt.ks * ksb : cB;
        const char* nX = (Epi::XROWS && has_next) ? (const char*)g.AX + (size_t)nxt.pm * xstep : cX;
        for (int t = 0; t < nt; t += 2) {
            const bool last = (t == nt - 2);
            const char* a1 = cA + (size_t)(t + 1) * kstep;
            const char* a2 = last ? nA : cA + (size_t)(t + 2) * kstep; const char* b2 = last ? nB : cB + (size_t)(t + 2) * kstep;
            const char* a3 = a2 + kstep; const char* b3 = b2 + kstep;
            const char* x2 = last ? nX : cX + (size_t)(t + 2) * kstep; const char* x3 = x2 + kstep;
            if (last && has_next) S.a_ready(nxt);
            if constexpr (SP2) {
            PG8_LDB(B0, 0, 0); PG8_LDB(B1, 0, 1); PG8_SCHED; PG8_LDA(At, 0, 0); PG8_LDX(0); PG8_STAGE(PG8_SA(1, 1), a1 + hstepA, voffA);
            PG8_WAIT_V(8); PG8_WAIT_L(0); PG8_BAR; PG8_MMA(0, 0, At, B0); PG8_MMA(0, 1, At, B1); PG8_MMX(); PG8_BAR; PG8_SCHED;
            PG8_LDA(At, 0, 1); PG8_STAGE(PG8_SB(0, 0), b2, voffB); PG8_STAGE(PG8_SB(0, 1), b2 + hstepB, voffB); PG8_STAGE(PG8_SA(0, 0), a2, voffA); PG8_XSTAGE(0, x2);
            PG8_WAIT_V(8); PG8_WAIT_L(0); PG8_BAR; PG8_MMA(1, 0, At, B0); PG8_MMA(1, 1, At, B1); PG8_BAR; PG8_SCHED;
            PG8_LDB(B0, 1, 0); PG8_LDB(B1, 1, 1); PG8_SCHED; PG8_LDA(At, 1, 0); PG8_LDX(1); PG8_STAGE(PG8_SA(0, 1), a2 + hstepA, voffA);
            PG8_WAIT_V(8); PG8_WAIT_L(0); PG8_BAR; PG8_MMA(0, 0, At, B0); PG8_MMA(0, 1, At, B1); PG8_MMX(); PG8_BAR; PG8_SCHED;
            PG8_LDA(At, 1, 1); PG8_STAGE(PG8_SB(1, 0), b3, voffB); PG8_STAGE(PG8_SB(1, 1), b3 + hstepB, voffB); PG8_STAGE(PG8_SA(1, 0), a3, voffA); PG8_XSTAGE(1, x3);
            PG8_WAIT_V(8); PG8_WAIT_L(0); PG8_BAR; PG8_MMA(1, 0, At, B0); PG8_MMA(1, 1, At, B1); PG8_BAR; PG8_SCHED;
            } else {
            PG8_LDB(B0, 0, 0); PG8_SCHED; PG8_LDA(At, 0, 0); PG8_STAGE(PG8_SA(1, 1), a1 + hstepA, voffA);
            PG8_WAIT_L(8); PG8_BAR; PG8_WAIT_L(0); PG8_MMA(0, 0, At, B0); PG8_BAR; PG8_SCHED;
            PG8_LDB(B1, 0, 1); PG8_STAGE(PG8_SB(0, 0), b2, voffB);
            PG8_BAR; PG8_WAIT_L(0); PG8_MMA(0, 1, At, B1); PG8_BAR;
            PG8_LDA(At, 0, 1); PG8_STAGE(PG8_SA(0, 0), a2, voffA);
            PG8_BAR; PG8_WAIT_L(0); PG8_MMA(1, 0, At, B0); PG8_BAR; PG8_SCHED;
            PG8_STAGE(PG8_SB(0, 1), b2 + hstepB, voffB);
            PG8_WAIT_V(6); PG8_BAR; PG8_MMA(1, 1, At, B1); PG8_BAR;
            PG8_LDB(B0, 1, 0); PG8_SCHED; PG8_LDA(At, 1, 0); PG8_STAGE(PG8_SA(0, 1), a2 + hstepA, voffA);
            PG8_WAIT_L(8); PG8_BAR; PG8_WAIT_L(0); PG8_MMA(0, 0, At, B0); PG8_BAR; PG8_SCHED;
            PG8_LDB(B1, 1, 1); PG8_STAGE(PG8_SB(1, 0), b3, voffB);
            PG8_BAR; PG8_WAIT_L(0); PG8_MMA(0, 1, At, B1); PG8_BAR;
            PG8_LDA(At, 1, 1); PG8_STAGE(PG8_SA(1, 0), a3, voffA);
            PG8_BAR; PG8_WAIT_L(0); PG8_MMA(1, 0, At, B0); PG8_BAR; PG8_SCHED;
            PG8_STAGE(PG8_SB(1, 1), b3 + hstepB, voffB);
            PG8_WAIT_V(6); PG8_BAR; PG8_MMA(1, 1, At, B1); PG8_BAR;
            }
        }
        if constexpr (ALIGN_EPI) { if (wr == 0) PG8_BAR; }
        if constexpr (!Epi::AFTER_DRAIN) { unsigned zz = 0u; asm volatile("" : "+v"(zz)); int le = (int)__builtin_amdgcn_mbcnt_hi(~0u, __builtin_amdgcn_mbcnt_lo(~0u, zz)); asm volatile("" : "+v"(le)); if constexpr (Epi::XROWS) E.xrows(accx, cur, wr, wc, le & 15, le >> 4, lds + EPI_SCR_OFF, wid * 64 + le); E(acc, cur, wr, wc, le & 15, le >> 4, lds + EPI_SCR_OFF, wid * 64 + le); S.done(cur); }
        if (!has_next) break;
#pragma unroll
        for (int a = 0; a < 2; ++a)
#pragma unroll
            for (int b = 0; b < 2; ++b)
#pragma unroll
                for (int m = 0; m < 4; ++m)
#pragma unroll
                    for (int n = 0; n < 2; ++n) acc[a][b][m][n] = (f32x4){0.f, 0.f, 0.f, 0.f};
        accx[0] = (f32x4){0.f, 0.f, 0.f, 0.f}; accx[1] = accx[0];
        cur = nxt; cA = nA; cB = nB; cX = nX; ++ui;
        if constexpr (ALIGN_EPI) { if (wr == 1) PG8_BAR; }
    }
    PG8_WAIT_V(0);
    if constexpr (!ALIGN_EPI) { if (wr == 0) PG8_BAR; }
    PG8_BAR;
#undef PG8_XSTAGE
#undef PG8_LDX
#undef PG8_MMX
#undef PG8_SA
#undef PG8_SB
#undef PG8_STAGE
#undef PG8_LDA
#undef PG8_LDB
#undef PG8_MMA
#undef PG8_WAIT_V
#undef PG8_WAIT_L
#undef PG8_BAR
#undef PG8_SCHED
}
}

#define GAS __attribute__((address_space(1)))
#define LAS __attribute__((address_space(3)))
typedef unsigned short bf16;
typedef unsigned v4u __attribute__((ext_vector_type(4)));
typedef unsigned v2u __attribute__((ext_vector_type(2)));
typedef float f32x4 __attribute__((ext_vector_type(4)));
typedef float f32x2 __attribute__((ext_vector_type(2)));
typedef float f32x16 __attribute__((ext_vector_type(16)));
typedef short bf16x8 __attribute__((ext_vector_type(8)));
typedef short s16x4 __attribute__((ext_vector_type(4)));
typedef GAS unsigned gu32;
#define RLX_AGENT __ATOMIC_RELAXED, __HIP_MEMORY_SCOPE_AGENT
#define LDS_WAIT() asm volatile("s_waitcnt lgkmcnt(0)" ::: "memory")
#define VM_WAIT() asm volatile("s_waitcnt vmcnt(0)" ::: "memory")
__device__ __forceinline__ unsigned f2bf(float f) { unsigned u = __builtin_bit_cast(unsigned, f); return (u + 0x7fffu + ((u >> 16) & 1u)) >> 16; }
__device__ __forceinline__ unsigned pk2(float lo, float hi) { return f2bf(lo) | (f2bf(hi) << 16); }
__device__ __forceinline__ float bf2f(unsigned short b) { return __builtin_bit_cast(float, (unsigned)b << 16); }

constexpr int NWAVES = 8;
constexpr size_t MiB = 1u << 20;
constexpr size_t WS_CTL = 0, CTL_ZERO_BYTES = 64 * 1024;
constexpr size_t WS_ROPE = 1 * MiB;
constexpr size_t WS_SSQ = 2 * MiB;
constexpr size_t WS_WQKV = 4 * MiB, WS_WO = 7 * MiB, WS_WPOOL = 9 * MiB;
constexpr size_t WS_W1 = 10 * MiB, W1_BYTES = (size_t)2 * DFF * DM * 2;
constexpr size_t WS_W2 = 54 * MiB, W2_BYTES = (size_t)DM * DFF * 2;
constexpr size_t WS_XB = 76 * MiB;
constexpr size_t WS_H = 110 * MiB;
constexpr size_t WS_Q = WS_H, WS_O = WS_H + 34 * MiB, WS_K = WS_H + 68 * MiB, WS_V = WS_H + 77 * MiB;
constexpr size_t WS_XB2 = 204 * MiB;
constexpr size_t WS_SSQ2 = 3 * MiB;
constexpr int NSPLIT = 11, NSPLIT_O = 4;
constexpr size_t WS_END = 238 * MiB;
static_assert(WS_W1 + 4 * W1_BYTES <= WS_W2 && WS_W2 + 4 * W2_BYTES <= WS_XB && WS_XB + (size_t)MT * DM * 2 <= WS_H && WS_H + (size_t)MT * DFF * 2 <= WS_END, "ws map");
static_assert(WS_V + (size_t)MT * KVD * 2 <= WS_END && WS_K + (size_t)MT * KVD * 2 <= WS_V && WS_O + (size_t)MT * DM * 2 <= WS_K, "ws map 2");
constexpr int CW_TMO = 64, CW_TILE = 8192;
constexpr int CW_BAR = 4096;
constexpr int RING_OFF = 0, RING_BYTES = 131072;
constexpr int LDSCTL_OFF = 146432, MISC_OFF = LDSCTL_OFF + 320;
constexpr int LDS_BYTES = 147456;
static_assert((2 * 6 * 8192 + 8 * 256 + 8 * 4096) <= LDSCTL_OFF && (131072 + 8192 + 4096) <= LDSCTL_OFF && MISC_OFF + 64 <= LDS_BYTES, "LDS map");

#define XB_TMO      128
#define XB_XCNT(j)  (256  + 64 * (j))
#define XB_XSUB(j)  (1280 + 64 * (j))
#define XB_XGEN(j)  (2304 + 64 * (j))
#define XB_TOP      3328
#define XB_TOPGEN   3392
#define XCD_BAR_WORDS 3456
#define XB_SPIN_CAP (1u << 18)
__device__ __forceinline__ unsigned xb_ld(unsigned* p)              { return __hip_atomic_load(p, __ATOMIC_RELAXED, __HIP_MEMORY_SCOPE_AGENT); }
__device__ __forceinline__ unsigned xb_add(unsigned* p, unsigned v) { return __hip_atomic_fetch_add(p, v, __ATOMIC_RELAXED, __HIP_MEMORY_SCOPE_AGENT); }
__device__ __forceinline__ unsigned xb_xcc_id() { return (unsigned)__builtin_amdgcn_s_getreg((3 << 11) | 20) & 0xFu; }
#define XB_SPIN(cond, bar) do { unsigned _sp = 0; while (cond) { __builtin_amdgcn_s_sleep(1); \
    if ((++_sp & 255u) == 0u) { if (xb_ld(&(bar)[XB_TMO])) break; if (_sp > XB_SPIN_CAP) { atomicAdd(&(bar)[XB_TMO], 1u); break; } } } } while (0)
struct XcdBarrier { unsigned* bar; unsigned x; volatile LAS unsigned* st; };
__device__ __forceinline__ XcdBarrier xcd_barrier_post(unsigned* bar, volatile LAS unsigned* st) {
    XcdBarrier b; b.bar = bar; b.x = xb_xcc_id(); b.st = st;
    if (threadIdx.x == 0) (void)xb_add(&bar[XB_XCNT(b.x)], 1u);
    return b;
}
__device__ __forceinline__ void xcd_barrier_complete(unsigned* bar, unsigned x, unsigned& nloc, unsigned& nx) {
    const unsigned G = gridDim.x * gridDim.y * gridDim.z;
    unsigned sum, cnt, mine, sp = 0u;
    for (;;) {
        sum = 0u; cnt = 0u; mine = 0u;
#pragma unroll
        for (unsigned j = 0; j < 16; ++j) { const unsigned c = xb_ld(&bar[XB_XCNT(j)]); sum += c; cnt += (c > 0u) ? 1u : 0u; mine = (j == x) ? c : mine; }
        if (sum == G) break;
        __builtin_amdgcn_s_sleep(1);
        if ((++sp & 255u) == 0u) { if (xb_ld(&bar[XB_TMO])) break; if (sp > XB_SPIN_CAP) { atomicAdd(&bar[XB_TMO], 1u); break; } }
    }
    nloc = mine > 0u ? mine : 1u; nx = cnt > 0u ? cnt : 1u;
}
__device__ __forceinline__ void xcd_barrier(const XcdBarrier& b) {
    asm volatile("s_waitcnt vmcnt(0)" ::: "memory");
    __syncthreads();
    if (threadIdx.x == 0) {
        unsigned* bar = b.bar;
        __builtin_amdgcn_s_waitcnt(0);
        unsigned nloc = b.st[0], nx = b.st[1];
        if (nloc == 0u) { xcd_barrier_complete(bar, b.x, nloc, nx); b.st[0] = nloc; b.st[1] = nx; }
        const unsigned old = xb_add(&bar[XB_XSUB(b.x)], 1u);
        const unsigned gen = old / nloc;
        if (old + 1u == (gen + 1u) * nloc) {
            __builtin_amdgcn_fence(__ATOMIC_RELEASE, "agent");
            asm volatile("s_waitcnt vmcnt(0)" ::: "memory");
            const unsigned og = xb_add(&bar[XB_TOP], 1u);
            const unsigned tg = og / nx;
            if (og + 1u == (tg + 1u) * nx) xb_add(&bar[XB_TOPGEN], 1u);
            else XB_SPIN(xb_ld(&bar[XB_TOPGEN]) == tg, bar);
            __builtin_amdgcn_fence(__ATOMIC_ACQUIRE, "agent");
            xb_add(&bar[XB_XGEN(b.x)], 1u);
            asm volatile("s_waitcnt vmcnt(0)" ::: "memory");
        } else {
            XB_SPIN(xb_ld(&bar[XB_XGEN(b.x)]) == gen, bar);
            __builtin_amdgcn_fence(__ATOMIC_ACQUIRE, "agent");
            asm volatile("s_waitcnt vmcnt(0)" ::: "memory");
        }
    }
    __syncthreads();
}

struct Frame {
    LAS unsigned char* lds;
    int tid, lane, wave, vcu, G;
};
__device__ __forceinline__ int fresh_tid(int wave0) {
    int wv = wave0; asm volatile("" : "+s"(wv)); unsigned z = 0u; asm volatile("" : "+v"(z));
    int t = wv * 64 + (int)__builtin_amdgcn_mbcnt_hi(~0u, __builtin_amdgcn_mbcnt_lo(~0u, z)); asm volatile("" : "+v"(t)); return t;
}
__device__ __forceinline__ Frame phase_frame(const Frame& F0, int wave0) {
    Frame F = F0; const int t = fresh_tid(wave0); F.tid = t; F.lane = t & 63; F.wave = __builtin_amdgcn_readfirstlane(t >> 6); return F;
}
__device__ __forceinline__ float wave_sum(float v, int lane) {
#pragma unroll
    for (int o = 1; o < 64; o <<= 1) v += pg8::xor_shfl(v, lane, o);
    return v;
}

__device__ __forceinline__ void transpose_item64(const float* W, int ldw, bf16* WT, int K, int drow0, int scolA, int scolB, int k0, const float* kscale, const float* nscale, float cscale, LAS unsigned char* T, int lane) {
    const int kq = lane >> 4, nq = lane & 15;
    const float* src = W + (size_t)(k0 + 4 * kq) * ldw + ((nq < 8) ? scolA + 4 * nq : scolB + 4 * (nq - 8));
    f32x4 v[4][4];
#pragma unroll
    for (int j = 0; j < 4; ++j)
#pragma unroll
        for (int i = 0; i < 4; ++i) v[j][i] = __builtin_nontemporal_load((const f32x4*)(src + (size_t)(16 * j + i) * ldw));
    f32x4 ns = (f32x4){cscale, cscale, cscale, cscale};
    if (nscale) ns = *(const f32x4*)(nscale + drow0 + 4 * nq) * cscale;
#pragma unroll
    for (int j = 0; j < 4; ++j) {
        f32x4 ks = (f32x4){1.f, 1.f, 1.f, 1.f};
        if (kscale) ks = *(const f32x4*)(kscale + k0 + 16 * j + 4 * kq);
#pragma unroll
        for (int c = 0; c < 4; ++c) {
            const float sc = ns[c];
            v2u pk; pk.x = pk2(v[j][0][c] * ks[0] * sc, v[j][1][c] * ks[1] * sc); pk.y = pk2(v[j][2][c] * ks[2] * sc, v[j][3][c] * ks[3] * sc);
            const int n = 4 * nq + c, ch = (2 * j + (kq >> 1)) ^ (nq & 7);
            *(LAS v2u*)(T + n * 128 + ch * 16 + (kq & 1) * 8) = pk;
        }
    }
    LDS_WAIT(); asm volatile("" ::: "memory");
    const int c8 = lane & 7;
#pragma unroll
    for (int jj = 0; jj < 8; ++jj) { const int n = (lane >> 3) + 8 * jj;
        const v4u o = *(const LAS v4u*)(T + n * 128 + ((c8 ^ ((n >> 2) & 7)) * 16));
        *(GAS v4u*)(WT + (size_t)(drow0 + n) * K + k0 + 8 * c8) = o; }
    LDS_WAIT(); asm volatile("" ::: "memory");
}
struct Args { const float* in[20]; float* out; unsigned char* ws; int ph_lo, ph_hi; };
typedef const __attribute__((address_space(4))) Args* ArgsP;
struct Ptrs {
    ArgsP ap;
#define PTR_ACC(name, idx) __device__ __forceinline__ const float* name() const { return ap->in[idx]; }
    PTR_ACC(xp, 0) PTR_ACC(xs, 1) PTR_ACC(spool, 2) PTR_ACC(ck, 3) PTR_ACC(cv, 4) PTR_ACC(n1, 5) PTR_ACC(w1in, 6) PTR_ACC(w1out, 7) PTR_ACC(nmix, 8) PTR_ACC(n2, 9)
    PTR_ACC(w2in, 10) PTR_ACC(w2out, 11) PTR_ACC(poolw, 12) PTR_ACC(pscale, 13) PTR_ACC(wqkv, 14) PTR_ACC(bqkv, 15) PTR_ACC(wo, 16) PTR_ACC(bo, 17) PTR_ACC(sinks, 18) PTR_ACC(nfin, 19)
#undef PTR_ACC
    __device__ __forceinline__ float* out() const { return ap->out; }
    __device__ __forceinline__ unsigned char* ws() const { return ap->ws; }
};
constexpr int I_W1 = (DM / 64) * (2 * DFF / 64), I_W2 = (DFF / 64) * (DM / 64), I_FFN = I_W1 + I_W2;
constexpr int I_QKV = (DM / 64) * (QKVN / 64), I_WO = (DM / 64) * (DM / 64), I_POOL = 4 * 4 * 4;
constexpr int IT_QKV = 4 * I_FFN, IT_WO = IT_QKV + I_QKV, IT_POOL = IT_WO + I_WO, NITEMS = IT_POOL + I_POOL;
__device__ __forceinline__ void convert_items(const Frame& F, const Ptrs& P, int lo, int hi, int gw, int ngw) {
    LAS unsigned char* T = F.lds + RING_OFF + F.wave * 8192;
    unsigned char* ws = P.ws();
    for (int it = lo + gw; it < hi; it += ngw) {
        int r = it;
        if (r < 4 * I_FFN) {
            const int f = r / I_FFN; r -= f * I_FFN; const int layer = f >> 1, second = f & 1;
            if (r < I_W1) { const int nblk = 2 * DFF / 64, kb = r / nblk, nb = r % nblk, j = 64 * nb;
                const float* win = (second ? P.w2in() : P.w1in()) + (size_t)layer * DM * 2 * DFF;
                const float* gn = (second ? P.n2() : P.n1()) + layer * DM;
                const int scol = ((j >> 7) & 1) * DFF + (j >> 8) * 128 + (j & 127);
                transpose_item64(win, 2 * DFF, (bf16*)(ws + WS_W1 + f * W1_BYTES), DM, j, scol, scol + 32, 64 * kb, gn, nullptr, 1.0f, T, F.lane);
            } else { r -= I_W1; const int nblk = DM / 64, kb = r / nblk, nb = r % nblk;
                const float* wout = (second ? P.w2out() : P.w1out()) + (size_t)layer * DFF * DM;
                transpose_item64(wout, DM, (bf16*)(ws + WS_W2 + f * W2_BYTES), DFF, 64 * nb, 64 * nb, 64 * nb + 32, 64 * kb, nullptr, nullptr, 0.5f, T, F.lane); }
            continue;
        }
        r -= 4 * I_FFN;
        if (r < I_QKV) { const int nblk = QKVN / 64, kb = r / nblk, nb = r % nblk, j = 64 * nb;
            const int scol = (j >> 8) * 256 + ((j >> 5) & 3) * 64 + ((j >> 7) & 1) * 32;
            transpose_item64(P.wqkv(), QKVN, (bf16*)(ws + WS_WQKV), DM, j, scol, scol + 64, 64 * kb, P.nmix() + DM, nullptr, 1.0f, T, F.lane); continue; }
        r -= I_QKV;
        if (r < I_WO) { const int nblk = DM / 64, kb = r / nblk, nb = r % nblk;
            transpose_item64(P.wo(), DM, (bf16*)(ws + WS_WO), DM, 64 * nb, 64 * nb, 64 * nb + 32, 64 * kb, nullptr, nullptr, 1.0f, T, F.lane); continue; }
        r -= I_WO;
        { const int gi = r >> 4, kb = (r >> 2) & 3, nb = r & 3;
            transpose_item64(P.poolw() + (size_t)gi * 65536, 256, (bf16*)(ws + WS_WPOOL), 256, gi * 256 + 64 * nb, 64 * nb, 64 * nb + 32, 64 * kb, nullptr, P.pscale(), 1.0f, T, F.lane); }
    }
}
__device__ __forceinline__ void p0_prologue(const Frame& F, const Ptrs& P) {
    const int gw = F.vcu * NWAVES + F.wave, NGW = F.G * NWAVES;
    unsigned char* ws = P.ws();
    convert_items(F, P, 0, I_W1, gw, NGW);
    convert_items(F, P, IT_POOL, NITEMS, gw, NGW);
    {
        float* rope = (float*)(ws + WS_ROPE);
        const double r1 = 1.0 / sqrt(sqrt(sqrt(10.0)));
        for (int e = (F.vcu * NWAVES * 64) + F.tid; e < (TPS + TSS) * 32; e += F.G * NWAVES * 64) {
            const int pidx = e >> 5, d = e & 31; const int pos = pidx < TPS ? pidx : PAST + (pidx - TPS);
            double inv = 1.0; for (int i = 0; i < d; ++i) inv *= r1;
            double turns = (double)pos * inv * 0.15915494309189535; turns -= floor(turns);
            const float a = (float)(turns * 6.283185307179586);
            rope[2 * e] = cosf(a); rope[2 * e + 1] = sinf(a);
        }
    }
    {
        bf16* XB = (bf16*)(ws + WS_XB); float* SSQ = (float*)(ws + WS_SSQ);
        const float* xp = P.xp(); const float* xs = P.xs();
        for (int m0 = 4 * gw; m0 < MT; m0 += 4 * NGW) {
            f32x4 v[4][4];
#pragma unroll
            for (int r = 0; r < 4; ++r) { const int m = m0 + r; const float* xrow = (m < MP) ? xp + (size_t)m * DM : xs + (size_t)(m - MP) * DM;
#pragma unroll
                for (int j = 0; j < 4; ++j) v[r][j] = __builtin_nontemporal_load((const GAS f32x4*)xrow + 64 * j + F.lane); }
#pragma unroll
            for (int r = 0; r < 4; ++r) { const int m = m0 + r; float sq = 0.f;
#pragma unroll
                for (int j = 0; j < 4; ++j) sq += (v[r][j][0] * v[r][j][0] + v[r][j][1] * v[r][j][1]) + (v[r][j][2] * v[r][j][2] + v[r][j][3] * v[r][j][3]);
                sq = wave_sum(sq, F.lane);
                GAS unsigned long long* o8 = (GAS unsigned long long*)(XB + (size_t)m * DM) + F.lane;
#pragma unroll
                for (int j = 0; j < 4; ++j) o8[64 * j] = (unsigned long long)pk2(v[r][j][0], v[r][j][1]) | ((unsigned long long)pk2(v[r][j][2], v[r][j][3]) << 32);
                if (F.lane < 4) SSQ[(size_t)m * 4 + F.lane] = (F.lane == 0) ? sq : 0.f; }
        }
    }
}

namespace poolf {
constexpr int A_OFF = 0, APITCH = 528  , RS_OFF = 128 * APITCH, SCR_OFF = RS_OFF + 1024;
__device__ __forceinline__ f32x2 bf2_to_f32(unsigned w) { return (f32x2){__builtin_bit_cast(float, w << 16), __builtin_bit_cast(float, w & 0xffff0000u)}; }
__device__ __forceinline__ void put_p(LAS unsigned char* A, int lr, int kc, f32x2 p) { *(LAS unsigned*)(A + lr * APITCH + kc * 2) = pk2(p[0], p[1]); }
template <int WG>
__device__ __forceinline__ void fill_p(const bf16* X, int r0, bool sample, const float* spool, const LAS float* rs, f32x2 g, int c0, int kc, int rq, LAS unsigned char* A, float* outp) {
    f32x2 h[16];
    if (!sample) {
        const int lr0 = rq * 32, t0 = (r0 + lr0) & (TPS - 1), b = (r0 + lr0) >> 11;
#pragma unroll
        for (int k = 0; k < 16; ++k) h[k] = (f32x2){0.f, 0.f};
        if (t0 > 0) {
            unsigned xh[16];
#pragma unroll
            for (int k = 1; k < 16; ++k) xh[k] = *(const unsigned*)(X + (size_t)(r0 + lr0 - 16 + k) * DM + c0);
#pragma unroll
            for (int k = 1; k < 16; ++k) h[k] = bf2_to_f32(xh[k]) * rs[lr0 - 1 + k] * g;
        }
        unsigned xw[2][16];
#pragma unroll
        for (int blk = 0; blk < 2; ++blk)
#pragma unroll
            for (int k = 0; k < 16; ++k) xw[blk][k] = *(const unsigned*)(X + (size_t)(r0 + lr0 + blk * 16 + k) * DM + c0);
#pragma unroll
        for (int blk = 0; blk < 2; ++blk) {
#pragma unroll
            for (int k = 0; k < 16; ++k) {
                const int lr = lr0 + blk * 16 + k, tpos = t0 + blk * 16 + k;
                const f32x2 u = bf2_to_f32(xw[blk][k]) * rs[lr + 15] * g;
                h[k] = u;
                f32x2 sm = u;
#pragma unroll
                for (int j = 1; j < WG; ++j) sm += h[(k - j) & 15];
                const int cnt = (tpos + 1 < WG) ? tpos + 1 : WG;
                put_p(A, lr, kc, sm * (1.0f / (float)cnt) - u);
                if (tpos >= TPS - 15) *(f32x2*)(outp + O_POOLP + ((size_t)b * 15 + (tpos - (TPS - 15))) * DM + c0) = u;
            }
        }
    } else {
        unsigned xw[8];
#pragma unroll
        for (int i = 0; i < 8; ++i) xw[i] = *(const unsigned*)(X + (size_t)(r0 + rq * 8 + i) * DM + c0);
        const int seq = ((r0 - MP) >> 3) + rq;
        const float* sp = spool + (size_t)seq * 15 * DM + c0; float* np = outp + O_POOLS + (size_t)seq * 15 * DM + c0;
        h[0] = (f32x2){0.f, 0.f};
#pragma unroll
        for (int k = 1; k < 16; ++k) h[k] = *(const f32x2*)(sp + (size_t)(k - 1) * DM);
#pragma unroll
        for (int k = 9; k < 16; ++k) *(f32x2*)(np + (size_t)(k - 9) * DM) = h[k];
#pragma unroll
        for (int i = 0; i < 8; ++i) {
            const int lr = rq * 8 + i;
            const f32x2 u = bf2_to_f32(xw[i]) * rs[lr + 15] * g;
            h[i] = u;
            f32x2 sm = u;
#pragma unroll
            for (int j = 1; j < WG; ++j) sm += h[(i - j) & 15];
            put_p(A, lr, kc, sm * (1.0f / (float)WG) - u);
            *(f32x2*)(np + (size_t)(7 + i) * DM) = u;
        }
    }
}
template <int MF>
__device__ __forceinline__ void unit(const Frame& F, const Ptrs& P, int r0, int gi, int pmode) {
    constexpr bool sample = (MF == 1); constexpr int ROWS = 32 * MF;
    unsigned char* ws = P.ws();
    const bf16* Xin = (const bf16*)(ws + WS_XB); bf16* Xout = (bf16*)(ws + WS_XB2);
    const float* SSQin = (const float*)(ws + WS_SSQ); float* SSQout = (float*)(ws + WS_SSQ2);
    const bf16* Wp = (const bf16*)(ws + WS_WPOOL);
    LAS unsigned char* A = F.lds + RING_OFF + A_OFF; LAS float* rs = (LAS float*)(F.lds + RING_OFF + RS_OFF); LAS float* scr = (LAS float*)(F.lds + RING_OFF + SCR_OFF);
    const int lane = F.lane, wid = F.wave, l15 = lane & 15, kg = lane >> 4;
    constexpr int MR = 2 * MF;
    const bf16* Bw = Wp + (size_t)(gi * 256 + wid * 32 + 8 * (l15 >> 2) + (l15 & 3)) * 256 + 8 * kg;
    bf16x8 bfa[4][2], bfb[4][2];
    __syncthreads();
    if (F.tid < 15 + ROWS) { const int row = r0 - 15 + F.tid; rs[F.tid] = (row >= 0 && (F.tid >= 15 || !sample)) ? pg8::row_rstd(SSQin, row) : 0.f; }
    __syncthreads();
    if (pmode != 2) {
        const int cp = F.tid & 127, rq = F.tid >> 7, kc = 2 * cp, c0 = gi * 256 + kc;
        const f32x2 g = *(const f32x2*)(P.nmix() + c0);
        if (gi == 0) fill_p<2>(Xin, r0, sample, P.spool(), rs, g, c0, kc, rq, A, P.out());
        else if (gi == 1) fill_p<4>(Xin, r0, sample, P.spool(), rs, g, c0, kc, rq, A, P.out());
        else if (gi == 2) fill_p<8>(Xin, r0, sample, P.spool(), rs, g, c0, kc, rq, A, P.out());
        else fill_p<16>(Xin, r0, sample, P.spool(), rs, g, c0, kc, rq, A, P.out());
    }
    if (pmode == 1) return;
#pragma unroll
    for (int ks = 0; ks < 4; ++ks)
#pragma unroll
        for (int n = 0; n < 2; ++n) { bfa[ks][n] = *(const bf16x8*)(Bw + (size_t)(4 * n) * 256 + ks * 32); bfb[ks][n] = *(const bf16x8*)(Bw + (size_t)(4 * n) * 256 + (4 + ks) * 32); }
    v4u xo[MR];
#pragma unroll
    for (int m = 0; m < MR; ++m) xo[m] = *(const v4u*)(Xin + (size_t)(r0 + m * 16 + l15) * DM + gi * 256 + wid * 32 + 8 * kg);
    __syncthreads();
    f32x4 acc[MR][2];
#pragma unroll
    for (int m = 0; m < MR; ++m)
#pragma unroll
        for (int n = 0; n < 2; ++n) acc[m][n] = (f32x4){0.f, 0.f, 0.f, 0.f};
#pragma unroll
    for (int ks = 0; ks < 8; ++ks) {
        bf16x8 af[MR];
#pragma unroll
        for (int m = 0; m < MR; ++m) af[m] = *(const LAS bf16x8*)(A + (m * 16 + l15) * APITCH + (4 * ks + kg) * 16);
#pragma unroll
        for (int m = 0; m < MR; ++m)
#pragma unroll
            for (int n = 0; n < 2; ++n) acc[m][n] = __builtin_amdgcn_mfma_f32_16x16x32_bf16(ks < 4 ? bfa[ks & 3][n] : bfb[ks & 3][n], af[m], acc[m][n], 0, 0, 0);
    }
#pragma unroll
    for (int m = 0; m < MR; ++m) {
        const int rl = m * 16 + l15; const size_t off = (size_t)(r0 + rl) * DM + gi * 256 + wid * 32 + 8 * kg;
        const f32x4 v0 = pg8::bf4_to_f32((v2u){xo[m].x, xo[m].y}) + acc[m][0], v1 = pg8::bf4_to_f32((v2u){xo[m].z, xo[m].w}) + acc[m][1];
        if (pmode != 2) *(v4u*)(Xout + off) = (v4u){pg8::cvt_pk_bf16(v0[0], v0[1]), pg8::cvt_pk_bf16(v0[2], v0[3]), pg8::cvt_pk_bf16(v1[0], v1[1]), pg8::cvt_pk_bf16(v1[2], v1[3])};
        float sm = ((v0[0] * v0[0] + v0[1] * v0[1]) + (v0[2] * v0[2] + v0[3] * v0[3])) + ((v1[0] * v1[0] + v1[1] * v1[1]) + (v1[2] * v1[2] + v1[3] * v1[3]));
        sm += pg8::xor_shfl(sm, lane, 16); sm += pg8::xor_shfl(sm, lane, 32);
        if (kg == 0) scr[rl * 8 + wid] = sm;
    }
    __syncthreads();
    if (F.tid < ROWS) { const f32x4 p = *(const LAS f32x4*)(scr + F.tid * 8), q = *(const LAS f32x4*)(scr + F.tid * 8 + 4); const float t = ((p[0] + p[1]) + (p[2] + p[3])) + ((q[0] + q[1]) + (q[2] + q[3]));
        if (pmode != 2) SSQout[(size_t)(r0 + F.tid) * 4 + gi] = t; else if (t == 1.2345e33f) SSQout[0] = t; }
}
__device__ __forceinline__ void phase(const Frame& F, const Ptrs& P, int pmode) {
    constexpr int NPU = (MP / 128) * 4, NSU = (MS / 32) * 4;
    for (int u = F.vcu; u < NPU; u += F.G) unit<4>(F, P, (u >> 2) * 128, u & 3, pmode);
    { const Frame F2 = phase_frame(F, F.wave); for (int u = F2.vcu; u < NSU; u += F2.G) unit<1>(F2, P, MP + (u >> 2) * 32, u & 3, pmode); }
}
}


namespace att {
constexpr int BUF_BYTES = 6 * 8192, LDS_V = 3 * 8192, LDS_WS = 2 * BUF_BYTES, LDS_OST = LDS_WS + NWAVES * 256, LDS_TOTAL = LDS_OST + NWAVES * 4096;
__device__ __forceinline__ int crow(int r, int hi) { return (r & 3) + 8 * (r >> 2) + 4 * hi; }
__device__ __forceinline__ unsigned cvtpk_s(float lo, float hi) { typedef float f2 __attribute__((ext_vector_type(2))); typedef __bf16 b2 __attribute__((ext_vector_type(2))); f2 v = {lo, hi}; b2 b = __builtin_convertvector(v, b2); return __builtin_bit_cast(unsigned, b); }
typedef short v4i16_t __attribute__((ext_vector_type(4)));
__device__ __forceinline__ s16x4 vtr(const LAS unsigned char* p) { return __builtin_bit_cast(s16x4, __builtin_amdgcn_ds_read_tr16_b64_v4i16((LAS v4i16_t*)p)); }
constexpr float NEG = -1.0e30f;

struct Soft { v4u pa[5][2]; float l; };
__device__ __forceinline__ void softmax5(f32x16 (&sc)[5], float sk, Soft& R) {
    float m = sk;
#pragma unroll
    for (int i = 0; i < 5; ++i)
#pragma unroll
        for (int r = 0; r < 16; ++r) m = fmaxf(m, sc[i][r]);
    { auto rr = __builtin_amdgcn_permlane32_swap(__float_as_uint(m), __float_as_uint(m), false, false); m = fmaxf(__uint_as_float(rr[0]), __uint_as_float(rr[1])); }
    float l = 0.f;
#pragma unroll
    for (int i = 0; i < 5; ++i) {
#pragma unroll
        for (int r = 0; r < 16; ++r) { const float p = __builtin_amdgcn_exp2f(sc[i][r] - m); sc[i][r] = p; l += p; }
#pragma unroll
        for (int s = 0; s < 2; ++s) R.pa[i][s] = (v4u){cvtpk_s(sc[i][8 * s + 0], sc[i][8 * s + 1]), cvtpk_s(sc[i][8 * s + 2], sc[i][8 * s + 3]), cvtpk_s(sc[i][8 * s + 4], sc[i][8 * s + 5]), cvtpk_s(sc[i][8 * s + 6], sc[i][8 * s + 7])};
    }
    { auto rr = __builtin_amdgcn_permlane32_swap(__float_as_uint(l), __float_as_uint(l), false, false); l = __uint_as_float(rr[0]) + __uint_as_float(rr[1]); }
    R.l = l + __builtin_amdgcn_exp2f(sk - m);
}
__device__ __forceinline__ f32x16 qk_block(const LAS unsigned char* kt, int p, const bf16x8 (&qr)[4], int r32, int hi) {
    const LAS unsigned char* kp = kt + p * 512 + hi * 1024 + r32 * 16;
    f32x16 a = {};
#pragma unroll
    for (int d0 = 0; d0 < 4; ++d0) a = __builtin_amdgcn_mfma_f32_32x32x16_bf16(*(const LAS bf16x8*)(kp + d0 * 2048), qr[d0], a, 0, 0, 0);
    return a;
}
__device__ __forceinline__ void pv_step(f32x16 (&o)[2], const LAS unsigned char* vt, int ks, const v4u pa, int lane, int hi) {
    const LAS unsigned char* vp = vt + ((lane >> 4) & 1) * 32 + (lane & 3) * 8 + (4 * hi + ((lane & 15) >> 2)) * 64 + ks * 1024;
#pragma unroll
    for (int d0 = 0; d0 < 2; ++d0) {
        const s16x4 lo = vtr(vp + d0 * 4096), hh = vtr(vp + d0 * 4096 + 512);
        const bf16x8 vf = (bf16x8){lo[0], lo[1], lo[2], lo[3], hh[0], hh[1], hh[2], hh[3]};
        o[d0] = __builtin_amdgcn_mfma_f32_32x32x16_bf16(__builtin_bit_cast(bf16x8, pa), vf, o[d0], 0, 0, 0);
    }
}

struct KVRegs { v4u k[3], v[3]; };
__device__ __forceinline__ void prompt_load(KVRegs& R, int u, const bf16* K, const bf16* V, int lane, int wid) {
    const int b = u >> 7, kvh = (u >> 5) & 3, qb = u & 31, q0 = qb * 64, jmin = (qb >= 2) ? 0 : 2 - qb;
#pragma unroll
    for (int j = 0; j < 3; ++j) if (j >= jmin) {
        const long kr0 = (long)b * TPS + q0 - 128 + 64 * j;
        R.k[j] = *(const v4u*)(K + (kr0 + lane) * KVD + kvh * 64 + wid * 8);
        R.v[j] = *(const v4u*)(V + (kr0 + 16 * (wid & 3) + (lane >> 2)) * KVD + kvh * 64 + (wid >> 2) * 32 + (lane & 3) * 8);
    }
}
__device__ __forceinline__ void prompt_store(const KVRegs& R, int u, LAS unsigned char* buf, int lane, int wid) {
    const int qb = u & 31, jmin = (qb >= 2) ? 0 : 2 - qb;
#pragma unroll
    for (int j = 0; j < 3; ++j) if (j >= jmin) {
        *(LAS v4u*)(buf + j * 8192 + wid * 1024 + lane * 16) = R.k[j];
        *(LAS v4u*)(buf + LDS_V + j * 8192 + wid * 1024 + lane * 16) = R.v[j];
    }
}
__device__ __forceinline__ void prompt_compute(const Frame& F, int u, const LAS unsigned char* buf, const bf16* Q, bf16* O, const float* sinks) {
    const int lane = F.lane, wid = F.wave, r32 = lane & 31, hi = lane >> 5;
    const int b = u >> 7, kvh = (u >> 5) & 3, qb = u & 31, q0 = qb * 64, jmin = (qb >= 2) ? 0 : 2 - qb;
    const long rowbase = (long)b * TPS;
    const int g = wid >> 1, half = wid & 1, h = 4 * kvh + g;
    const bf16* Qw = Q + (rowbase + q0 + 32 * half) * DM + h * HD;
    bf16x8 qr[4];
#pragma unroll
    for (int d0 = 0; d0 < 4; ++d0) qr[d0] = *(const bf16x8*)(Qw + (long)r32 * DM + d0 * 16 + hi * 8);
    const float sk = sinks[h] * LOG2E;
    f32x16 sc[5];
#pragma unroll
    for (int i = 0; i < 5; ++i) {
        const int kb = half + i, tile = kb >> 1, p = kb & 1;
        if (tile >= jmin) sc[i] = qk_block(buf + tile * 8192, p, qr, r32, hi);
        else {
#pragma unroll
            for (int r = 0; r < 16; ++r) sc[i][r] = NEG;
        }
    }
#pragma unroll
    for (int r = 0; r < 16; ++r) { const int kk = crow(r, hi); if (!(kk > r32)) sc[0][r] = NEG; if (!(kk <= r32)) sc[4][r] = NEG; }
    Soft S; softmax5(sc, sk, S);
    f32x16 o[2]; o[0] = f32x16{}; o[1] = f32x16{};
#pragma unroll
    for (int i = 0; i < 5; ++i) {
        const int kb = half + i, tile = kb >> 1, p = kb & 1;
        if (tile >= jmin) {
#pragma unroll
            for (int s = 0; s < 2; ++s) pv_step(o, buf + LDS_V + tile * 8192, 2 * p + s, S.pa[i][s], lane, hi);
        }
    }
    LAS unsigned char* lds = F.lds + RING_OFF;
    LAS float* wsf = (LAS float*)(lds + LDS_WS) + wid * 64;
    if (hi == 0) wsf[r32] = S.l;
    LDS_WAIT();
    LAS bf16* stg = (LAS bf16*)(lds + LDS_OST) + wid * 2048;
#pragma unroll
    for (int r = 0; r < 16; ++r) { const int orow = crow(r, hi); const float rl = __builtin_amdgcn_rcpf(wsf[orow]);
#pragma unroll
        for (int d0 = 0; d0 < 2; ++d0) stg[orow * 64 + d0 * 32 + r32] = (bf16)f2bf(o[d0][r] * rl); }
    LDS_WAIT();
    bf16* Ow = O + (rowbase + q0 + 32 * half) * DM + h * HD;
#pragma unroll
    for (int i = 0; i < 4; ++i) { const int row = i * 8 + (lane >> 3), ch = lane & 7; const v4u v = *(const LAS v4u*)(stg + row * 64 + ch * 8); *(v4u*)(Ow + (long)row * DM + ch * 8) = v; }
    LDS_WAIT();
}

__device__ __forceinline__ void sample_pair(const Frame& F, int b, int hp, const bf16* Q, const bf16* Kn, const bf16* Vn, const float* ck, const float* cv, float* out, bf16* O, const float* sinks) {
    const int lane = F.lane, wid = F.wave, s = wid >> 2, tg = F.tid & 255, kvh = 2 * hp + s;
    LAS unsigned char* lds = F.lds + RING_OFF;
    LAS unsigned char* buf = lds + s * BUF_BYTES;
    __syncthreads();
    {
        const int q = tg & 15;
        f32x4 kx[8], vx[8];
#pragma unroll
        for (int it = 0; it < 8; ++it) { const int key = it * 16 + (tg >> 4); const size_t off = ((size_t)(b * 128 + key) * NKV + kvh) * HD + 4 * q;
            kx[it] = __builtin_nontemporal_load((const f32x4*)(ck + off)); vx[it] = __builtin_nontemporal_load((const f32x4*)(cv + off)); }
#pragma unroll
        for (int it = 0; it < 8; ++it) { const int key = it * 16 + (tg >> 4), tile = key >> 6, kk = key & 63;
            if (key >= 8) { const size_t oo = ((size_t)(b * 128 + key - 8) * NKV + kvh) * HD + 4 * q; __builtin_nontemporal_store(kx[it], (f32x4*)(out + O_KS + oo)); __builtin_nontemporal_store(vx[it], (f32x4*)(out + O_VS + oo)); }
            *(LAS v2u*)(buf + tile * 8192 + (q >> 1) * 1024 + kk * 16 + (q & 1) * 8) = (v2u){cvtpk_s(kx[it][0], kx[it][1]), cvtpk_s(kx[it][2], kx[it][3])};
            *(LAS v2u*)(buf + LDS_V + tile * 8192 + (q >> 3) * 4096 + (kk >> 4) * 1024 + (kk & 15) * 64 + ((4 * q) & 31) * 2) = (v2u){cvtpk_s(vx[it][0], vx[it][1]), cvtpk_s(vx[it][2], vx[it][3])}; }
        const int i8 = tg >> 4;
        v2u kn = (v2u){0u, 0u}, vn = (v2u){0u, 0u};
        if (i8 < 8) { const size_t off = ((size_t)MP + b * TSS + i8) * KVD + kvh * HD + 4 * q; kn = *(const v2u*)(Kn + off); vn = *(const v2u*)(Vn + off); }
        *(LAS v2u*)(buf + 2 * 8192 + (q >> 1) * 1024 + i8 * 16 + (q & 1) * 8) = kn;
        *(LAS v2u*)(buf + LDS_V + 2 * 8192 + (q >> 3) * 4096 + i8 * 64 + ((4 * q) & 31) * 2) = vn;
    }
    __syncthreads();
    if ((wid & 3) == 0) {
        const int r32 = lane & 31, hi = lane >> 5, qi = r32 & 7, h = 4 * kvh + (r32 >> 3);
        const long qrow = (long)MP + b * TSS + qi;
        bf16x8 qr[4];
#pragma unroll
        for (int d0 = 0; d0 < 4; ++d0) qr[d0] = *(const bf16x8*)(Q + qrow * DM + h * HD + d0 * 16 + hi * 8);
        const float sk = sinks[h] * LOG2E;
        f32x16 sc[5];
#pragma unroll
        for (int blk = 0; blk < 5; ++blk) sc[blk] = qk_block(buf + (blk >> 1) * 8192, blk & 1, qr, r32, hi);
#pragma unroll
        for (int blk = 0; blk < 5; ++blk)
#pragma unroll
            for (int r = 0; r < 16; ++r) { const int j = 32 * blk + crow(r, hi); if (!(j >= qi + 1 && j <= 128 + qi)) sc[blk][r] = NEG; }
        Soft S; softmax5(sc, sk, S);
        f32x16 o[2]; o[0] = f32x16{}; o[1] = f32x16{};
#pragma unroll
        for (int blk = 0; blk < 4; ++blk)
#pragma unroll
            for (int st = 0; st < 2; ++st) pv_step(o, buf + LDS_V + (blk >> 1) * 8192, 2 * (blk & 1) + st, S.pa[blk][st], lane, hi);
        pv_step(o, buf + LDS_V + 2 * 8192, 0, S.pa[4][0], lane, hi);
        LAS float* wsf = (LAS float*)(lds + LDS_WS) + wid * 64;
        if (hi == 0) wsf[r32] = S.l;
        LDS_WAIT();
#pragma unroll
        for (int r = 0; r < 16; ++r) { const int qq = crow(r, hi); const float rl = __builtin_amdgcn_rcpf(wsf[qq]);
            bf16* orow = O + ((long)MP + b * TSS + (qq & 7)) * DM + (4 * kvh + (qq >> 3)) * HD + r32;
#pragma unroll
            for (int d0 = 0; d0 < 2; ++d0) orow[d0 * 32] = (bf16)f2bf(o[d0][r] * rl); }
        LDS_WAIT();
    }
}

__device__ __forceinline__ void attn_phase(const Frame& F, const Ptrs& P) {
    const bf16* Q = (const bf16*)(P.ws() + WS_Q); const bf16* K = (const bf16*)(P.ws() + WS_K); const bf16* V = (const bf16*)(P.ws() + WS_V); bf16* O = (bf16*)(P.ws() + WS_O);
    LAS unsigned char* lds = F.lds + RING_OFF;
    constexpr int NPU = NPB * NKV * 32;
    const int per = (NPU + F.G - 1) / F.G, u0 = F.vcu * per, u1 = (u0 + per < NPU) ? u0 + per : NPU;
    if (u0 < u1) {
        KVRegs R;
        prompt_load(R, u0, K, V, F.lane, F.wave);
        __syncthreads();
        prompt_store(R, u0, lds, F.lane, F.wave);
        for (int u = u0; u < u1; ++u) {
            const int cur = (u - u0) & 1;
            if (u + 1 < u1) prompt_load(R, u + 1, K, V, F.lane, F.wave);
            __syncthreads();
            prompt_compute(F, u, lds + cur * BUF_BYTES, Q, O, P.sinks());
            if (u + 1 < u1) prompt_store(R, u + 1, lds + (cur ^ 1) * BUF_BYTES, F.lane, F.wave);
        }
    }
    for (int pu = F.vcu; pu < NSB * 2; pu += F.G) sample_pair(F, pu >> 1, pu & 1, Q, K, V, P.ck(), P.cv(), P.out(), O, P.sinks());
}
}

__device__ __forceinline__ void final_phase(const Frame& F, const Ptrs& P) {
    float* Y = P.out() + O_Y; const bf16* XB = (const bf16*)(P.ws() + WS_XB2); const float* SSQ = (const float*)(P.ws() + WS_SSQ2);
    const int gw = F.vcu * NWAVES + F.wave, NGW = F.G * NWAVES;
    f32x4 gv[4];
#pragma unroll
    for (int j = 0; j < 4; ++j) gv[j] = ((const f32x4*)P.nfin())[64 * j + F.lane];
    for (int m0 = 4 * gw; m0 < MT; m0 += 4 * NGW) {
        v2u w[4][4]; float rs[4];
#pragma unroll
        for (int r = 0; r < 4; ++r) { rs[r] = pg8::row_rstd(SSQ, m0 + r);
#pragma unroll
            for (int j = 0; j < 4; ++j) w[r][j] = __builtin_nontemporal_load((const v2u*)(XB + (size_t)(m0 + r) * DM) + 64 * j + F.lane); }
#pragma unroll
        for (int r = 0; r < 4; ++r)
#pragma unroll
            for (int j = 0; j < 4; ++j) __builtin_nontemporal_store(pg8::bf4_to_f32(w[r][j]) * rs[r] * gv[j], (f32x4*)(Y + (size_t)(m0 + r) * DM) + 64 * j + F.lane);
    }
}

constexpr int NPHASES = 14;
__global__ void __launch_bounds__(NWAVES * 64, 2) mk_fwd(Args args) {
    extern __shared__ __attribute__((aligned(16))) unsigned char lds_raw[];
    {
        LAS unsigned char* l0 = (LAS unsigned char*)lds_raw;
        for (int u = threadIdx.x; u < (LDS_BYTES - LDSCTL_OFF) / 4; u += NWAVES * 64) ((LAS unsigned*)(l0 + LDSCTL_OFF))[u] = 0u;
        __syncthreads();
    }
    const int lo = args.ph_lo, hi = args.ph_hi;
    const int wave0 = __builtin_amdgcn_readfirstlane(threadIdx.x >> 6);
    if (hi - lo > 1) (void)xcd_barrier_post((unsigned*)(args.ws + WS_CTL) + CW_BAR, (volatile LAS unsigned*)((LAS unsigned char*)lds_raw + MISC_OFF) + 8);
    for (int it = 2 * lo; it < 2 * hi; ++it) {
        const int ph = it >> 1; const bool dup = (it & 1) != 0;
        if (dup && !((DUP_MASK >> ph) & 1)) continue;
        int bx = blockIdx.x, G = gridDim.x; asm volatile("" : "+s"(bx), "+s"(G));
        ArgsP ap = (ArgsP)__builtin_amdgcn_kernarg_segment_ptr(); asm volatile("" : "+s"(ap));
        Frame F;
        F.lds = (LAS unsigned char*)lds_raw;
        F.tid = 0; F.lane = 0; F.wave = 0;
        F.G = G; F.vcu = (G % 8 == 0) ? (bx % 8) * (G / 8) + bx / 8 : bx;
        Ptrs P; P.ap = ap;
        unsigned char* ws = P.ws();
        bf16* XB = (bf16*)(ws + ((ph > 3) ? WS_XB2 : WS_XB)); bf16* Hb = (bf16*)(ws + WS_H); float* SSQ = (float*)(ws + ((ph > 3) ? WS_SSQ2 : WS_SSQ));
        const int kind = (int)((0x92187621214210ull >> (4 * ph)) & 15ull);
        const int f = (ph < 3) ? 0 : (ph < 6) ? 1 : (ph < 8) ? 2 : 3;
        if (kind == 0 && (PHMASK & 1)) {
            p0_prologue(phase_frame(F, wave0), P);
        } else if (kind == 1 && (PHMASK & 2)) {
            pg8::Gemm g{XB, (const bf16*)(ws + WS_W1 + f * W1_BYTES), MT, 2 * DFF, DM, DM, DM, 0, nullptr};
            pg8::StaticOrder S; S.init(MT, 2 * DFF, F.G, bx);
            pg8::EpiSwiglu E{(dup && PROBE_NULL_EPI == 1) ? nullptr : Hb, SSQ, dup && PROBE_NULL_EPI == 2};
            pg8::gemm_phase<pg8::EpiSwiglu, pg8::StaticOrder, true, true>(F.lds + RING_OFF, g, S, E, fresh_tid(wave0));
            if (!dup && f < 3 && bx >= 216) {
                const Frame Fc = phase_frame(F, wave0);
                const int gwc = (bx - 216) * NWAVES + Fc.wave, ngwc = (F.G - 216) * NWAVES;
                __syncthreads();
                convert_items(Fc, P, f * I_FFN + I_W1, (f + 1) * I_FFN, gwc, ngwc);
                if (f < 2) convert_items(Fc, P, (f + 1) * I_FFN, (f + 1) * I_FFN + I_W1 / 4, gwc, ngwc);
                else convert_items(Fc, P, IT_QKV, IT_POOL, gwc, ngwc);
            }
        } else if ((kind == 2 || kind == 8) && (PHMASK & 4)) {
            pg8::EpiRes E;
            E.xb = (dup && PROBE_NULL_EPI) ? nullptr : XB; E.ssq = SSQ; E.bias = nullptr; E.accs = dup ? 0.f : 1.f;
            pg8::StaticOrder S; S.init(MP, DM, F.G, bx);
            if (kind == 8) {
                const bf16* O = (const bf16*)(ws + WS_O);
                const pg8::Gemm g{O, (const bf16*)(ws + WS_WO), MP, DM, DM, DM, DM, 0, O + (size_t)MP * DM}; E.bias = dup ? nullptr : P.bo();
                pg8::gemm_phase<pg8::EpiRes, pg8::StaticOrder, true, true>(F.lds + RING_OFF, g, S, E, fresh_tid(wave0));
            } else {
                const pg8::Gemm g{Hb, (const bf16*)(ws + WS_W2 + f * W2_BYTES), MP, DM, DFF, DFF, DFF, 0, Hb + (size_t)MP * DFF};
                pg8::gemm_phase<pg8::EpiRes, pg8::StaticOrder, true, true>(F.lds + RING_OFF, g, S, E, fresh_tid(wave0));
            }
            if (!dup && kind == 2 && f < 2) {
                const Frame Fc = phase_frame(F, wave0);
                __syncthreads();
                convert_items(Fc, P, (f + 1) * I_FFN + I_W1 / 4, (f + 1) * I_FFN + I_W1, Fc.vcu * NWAVES + Fc.wave, F.G * NWAVES);
            }
        } else if (kind == 4 && (PHMASK & 8)) {
            poolf::phase(phase_frame(F, wave0), P, dup ? PROBE_POOL : 0);
        } else if (kind == 6 && (PHMASK & 16)) {
            pg8::Gemm g{XB, (const bf16*)(ws + WS_WQKV), MT, QKVN, DM, DM, DM, 0, nullptr};
            pg8::StaticOrder S; S.init(MT, QKVN, F.G, bx);
            pg8::EpiQKV E{(bf16*)(ws + WS_Q), (bf16*)(ws + WS_K), (bf16*)(ws + WS_V), SSQ, P.bqkv(), (const float*)(ws + WS_ROPE), P.out()};
            pg8::gemm_phase<pg8::EpiQKV, pg8::StaticOrder, true, true>(F.lds + RING_OFF, g, S, E, fresh_tid(wave0));
            if (!dup && bx >= 152) {
                const Frame Fc = phase_frame(F, wave0);
                __syncthreads();
                convert_items(Fc, P, 3 * I_FFN, 4 * I_FFN, (bx - 152) * NWAVES + Fc.wave, (F.G - 152) * NWAVES);
            }
        } else if (kind == 7 && (PHMASK & 32)) {
            att::attn_phase(phase_frame(F, wave0), P);
        } else if (kind == 9 && (PHMASK & 64)) {
            final_phase(phase_frame(F, wave0), P);
        }
        {
            ArgsP aq = (ArgsP)__builtin_amdgcn_kernarg_segment_ptr(); asm volatile("" : "+s"(aq));
            const int hi2 = aq->ph_hi, lo2 = aq->ph_lo;
            if ((it + 1 < 2 * hi2 - 1 || (DUP_MASK >> (hi2 - 1)) & 1) && hi2 - lo2 > 1) {
                XcdBarrier b2; b2.bar = (unsigned*)(aq->ws + WS_CTL) + CW_BAR; b2.x = xb_xcc_id(); b2.st = (volatile LAS unsigned*)((LAS unsigned char*)lds_raw + MISC_OFF) + 8;
                xcd_barrier(b2);
            }
        }
    }
}

extern "C" void kernel_launch(void* const* d_in, const int* in_sizes, int n_in, void* d_out, int out_size, void* d_ws, size_t ws_size, hipStream_t stream) {
    static int grid = 0;
    if (grid == 0) {
        if (n_in != 20 || (size_t)out_size != O_END || ws_size < WS_END) { fprintf(stderr, "kernel_launch: unexpected shapes (n_in %d out %d ws %zu)\n", n_in, out_size, ws_size); grid = -1; return; }
        int dev = 0, cus = 0, per_cu = 0;
        if (hipGetDevice(&dev) != hipSuccess || hipDeviceGetAttribute(&cus, hipDeviceAttributeMultiprocessorCount, dev) != hipSuccess) { grid = -1; return; }
        if (hipFuncSetAttribute((const void*)mk_fwd, hipFuncAttributeMaxDynamicSharedMemorySize, LDS_BYTES) != hipSuccess) { fprintf(stderr, "kernel_launch: hipFuncSetAttribute failed\n"); grid = -1; return; }
        if (hipOccupancyMaxActiveBlocksPerMultiprocessor(&per_cu, (const void*)mk_fwd, NWAVES * 64, LDS_BYTES) != hipSuccess || per_cu < 1)
            fprintf(stderr, "kernel_launch: occupancy query reports %d workgroups per CU\n", per_cu);
        (void)hipGetLastError();
        grid = cus;
    }
    if (grid < 0) return;
    (void)hipMemsetAsync((char*)d_ws + WS_CTL, 0, CTL_ZERO_BYTES, stream);
    Args a{};
    for (int i = 0; i < 20; ++i) a.in[i] = (const float*)d_in[i];
    a.out = (float*)d_out; a.ws = (unsigned char*)d_ws;
#if MK_ONE_LAUNCH
    a.ph_lo = 0; a.ph_hi = NPHASES;
    hipLaunchKernelGGL(mk_fwd, dim3(grid), dim3(NWAVES * 64), LDS_BYTES, stream, a);
#else
    for (int ph = 0; ph < NPHASES; ++ph) { a.ph_lo = ph; a.ph_hi = ph + 1; hipLaunchKernelGGL(mk_fwd, dim3(grid), dim3(NWAVES * 64), LDS_BYTES, stream, a); }
#endif
}
```

```cpp
#include <hip/hip_runtime.h>
#include <cstdio>
#include <cstdint>

#ifndef PHMASK
#define PHMASK 255
#endif
#ifndef PROBE_NULL_EPI
#define PROBE_NULL_EPI 0
#endif
#ifndef PROBE_POOL
#define PROBE_POOL 0
#endif
#ifndef DUP_MASK
#define DUP_MASK 0
#endif
#ifndef MK_ONE_LAUNCH
#define MK_ONE_LAUNCH 1
#endif

constexpr int DM = 1024, DFF = 2816, NPB = 8, TPS = 2048, MP = NPB * TPS, NSB = 128, TSS = 8, MS = NSB * TSS, MT = MP + MS;
constexpr int QKVN = 1536, NHEAD = 16, NKV = 4, HD = 64, KVD = 256;
constexpr int PAST = 8192;
constexpr float RMS_EPS = 1e-6f;
constexpr float LOG2E = 1.4426950408889634f;
constexpr float QSCALE = 0.125f * LOG2E;
constexpr size_t O_Y = 0;
constexpr size_t O_POOLP = (size_t)MT * DM;
constexpr size_t O_POOLS = O_POOLP + (size_t)NPB * 15 * DM;
constexpr size_t O_KP = O_POOLS + (size_t)NSB * 15 * DM;
constexpr size_t O_VP = O_KP + (size_t)NPB * 128 * KVD;
constexpr size_t O_KS = O_VP + (size_t)NPB * 128 * KVD;
constexpr size_t O_VS = O_KS + (size_t)NSB * 128 * KVD;
constexpr size_t O_END = O_VS + (size_t)NSB * 128 * KVD;

namespace pg8 {
#define PG8_LAS __attribute__((address_space(3)))
typedef unsigned short bf16_t;
typedef short bf16x8 __attribute__((ext_vector_type(8)));
typedef float f32x4 __attribute__((ext_vector_type(4)));
typedef float f32x2 __attribute__((ext_vector_type(2)));
typedef unsigned u32x4 __attribute__((ext_vector_type(4)));
typedef unsigned u32x2 __attribute__((ext_vector_type(2)));
constexpr int BM = 256, BK = 64, HALF = 128, HTB = HALF * BK * 2, STAGE_BYTES = 8 * HTB, NXCD = 8, WGM = 8;
constexpr int XA_OFF = STAGE_BYTES;
constexpr int EPI_SCR_OFF = STAGE_BYTES + 8192;

__host__ __device__ __forceinline__ int lds_byte(int r, int c) { const int st = (r >> 4) * 2 + (c >> 5), rr = r & 15, cc = c & 31, ob = rr * 64 + cc * 2; return st * 1024 + (ob ^ (((ob >> 9) & 1) << 5)); }
__host__ __device__ __forceinline__ void stage_rc(int b, int& R, int& C) { const int st = b / 1024, sb = b % 1024, swz = sb ^ (((sb >> 9) & 1) << 5); R = (st >> 1) * 16 + swz / 64; C = (st & 1) * 32 + (swz % 64) / 2; }
__host__ __device__ __forceinline__ int perm32(int rho) { const int n = rho >> 4, i = rho & 15; return 8 * (i >> 2) + 4 * n + (i & 3); }

struct Unit { int pm, pn, ks; };
struct Gemm { const bf16_t* A; const bf16_t* Bt; int M, N, K, lda, ldb, a_pn_cols; const bf16_t* AX; };

struct StaticOrder {
    int nM, nN, nwg, G, c;
    __host__ __device__ void init(int M, int N, int G_, int c_) { nM = M / BM; nN = N / BM; nwg = nM * nN; G = G_; c = c_; }
    __host__ __device__ bool next(int i, Unit& u) const {
        const long L = (long)i * G + c; if (L >= nwg) return false;
        int wgid = (int)L; { const int q = nwg / NXCD, r = nwg % NXCD, xcd = wgid % NXCD, off = wgid / NXCD; wgid = (xcd < r ? xcd * (q + 1) : r * (q + 1) + (xcd - r) * q) + off; }
        const int nig = WGM * nN, gid = wgid / nig, fm = gid * WGM, gsz = (nM - fm) < WGM ? (nM - fm) : WGM;
        u.pm = fm + ((wgid % nig) % gsz); u.pn = (wgid % nig) / gsz; u.ks = 0; return true;
    }
    __device__ __forceinline__ void a_ready(const Unit&) const {}
    __device__ __forceinline__ void done(const Unit&) const {}
};

struct SplitOrder {
    int c, n;
    __device__ __forceinline__ bool next(int i, Unit& u) const { if (i > 0 || c >= n) return false; u.pm = 64 + ((c & 15) >> 2); u.pn = c & 3; u.ks = c >> 4; return true; }
    __device__ __forceinline__ void a_ready(const Unit&) const {}
    __device__ __forceinline__ void done(const Unit&) const {}
};

__device__ __forceinline__ unsigned cvt_pk_bf16(float lo, float hi) { unsigned r; asm volatile("v_cvt_pk_bf16_f32 %0, %1, %2" : "=v"(r) : "v"(lo), "v"(hi)); return r; }

__device__ __forceinline__ float xor_shfl(float v, int lane, int mask) { return __builtin_bit_cast(float, __builtin_amdgcn_ds_bpermute((lane ^ mask) << 2, __builtin_bit_cast(int, v))); }
__device__ __forceinline__ float rstd_of(const f32x4 a) { return __builtin_amdgcn_rsqf(((a[0] + a[1]) + (a[2] + a[3])) * (1.0f / DM) + RMS_EPS); }
__device__ __forceinline__ float row_rstd(const float* ssq, int row) { return rstd_of(*(const f32x4*)(ssq + (size_t)row * 4)); }

struct EpiSwiglu {
    static constexpr bool PERM = true, AFTER_DRAIN = false, XROWS = false;
    bf16_t* H; const float* ssq; bool nostore;
    __device__ __forceinline__ void operator()(const f32x4 (&acc)[2][2][4][2], const Unit& u, int wr, int wc, int fr, int fq, PG8_LAS unsigned char* xl, int tid) const {
        if (H == nullptr) return;
        const int row0 = u.pm * BM + wr * 64 + fr, col0 = u.pn * HALF + wc * 32 + 8 * fq;
        f32x4 sq[2][4];
#pragma unroll
        for (int ai = 0; ai < 2; ++ai)
#pragma unroll
            for (int m = 0; m < 4; ++m) sq[ai][m] = *(const f32x4*)(ssq + (size_t)(row0 + ai * HALF + m * 16) * 4);
#pragma unroll
        for (int ai = 0; ai < 2; ++ai)
#pragma unroll
            for (int m = 0; m < 4; ++m) {
                const int row = row0 + ai * HALF + m * 16;
                const f32x4 sqv = sq[ai][m];
                const float ms = ((sqv[0] + sqv[1]) + (sqv[2] + sqv[3])) * (1.0f / DM) + RMS_EPS, rs = __builtin_amdgcn_rsqf(ms);
                const f32x2 c1 = (f32x2){-rs * LOG2E, -rs * LOG2E}, ms2 = (f32x2){ms, ms};
                unsigned w[4];
#pragma unroll
                for (int n = 0; n < 2; ++n)
#pragma unroll
                    for (int hh = 0; hh < 2; ++hh) {
                        const f32x2 ag = (f32x2){acc[ai][0][m][n][2 * hh], acc[ai][0][m][n][2 * hh + 1]}, au = (f32x2){acc[ai][1][m][n][2 * hh], acc[ai][1][m][n][2 * hh + 1]};
                        const f32x2 t = ag * c1;
                        const f32x2 e = (f32x2){__builtin_amdgcn_exp2f(t[0]), __builtin_amdgcn_exp2f(t[1])};
                        const f32x2 d = __builtin_elementwise_fma(e, ms2, ms2);
                        const f32x2 r = (f32x2){__builtin_amdgcn_rcpf(d[0]), __builtin_amdgcn_rcpf(d[1])};
                        const f32x2 o = (ag * au) * r;
                        w[2 * n + hh] = cvt_pk_bf16(o[0], o[1]);
                    }
                if (!nostore) *(u32x4*)(H + (size_t)row * DFF + col0) = (u32x4){w[0], w[1], w[2], w[3]}; else asm volatile("" :: "v"(w[0]), "v"(w[1]), "v"(w[2]), "v"(w[3]));
            }
    }
};
__device__ __forceinline__ f32x4 bf4_to_f32(const u32x2 w) { return (f32x4){__builtin_bit_cast(float, w.x << 16), __builtin_bit_cast(float, w.x & 0xffff0000u), __builtin_bit_cast(float, w.y << 16), __builtin_bit_cast(float, w.y & 0xffff0000u)}; }
struct EpiRes {
    static constexpr bool PERM = true, AFTER_DRAIN = false, XROWS = true;
    bf16_t* xb; float* ssq; const float* bias; float accs;
    __device__ __forceinline__ void xrows(const f32x4 (&accx)[2], const Unit& u, int wr, int wc, int fr, int fq, PG8_LAS unsigned char* xl, int tid) const {
        if (xb == nullptr) return;
        const int row = MP + 16 * u.pm + fr, col0 = u.pn * BM + wr * HALF + wc * 32 + 8 * fq;
        bf16_t* xp = xb + (size_t)row * DM + col0;
        const u32x4 w = *(const u32x4*)xp;
        f32x4 a0 = accx[0], a1 = accx[1];
#if DUP_MASK != 0
        a0 = a0 * accs; a1 = a1 * accs;
#endif
        if (bias) { a0 += *(const f32x4*)(bias + col0); a1 += *(const f32x4*)(bias + col0 + 4); }
        const f32x4 v0 = bf4_to_f32((u32x2){w.x, w.y}) + a0, v1 = bf4_to_f32((u32x2){w.z, w.w}) + a1;
        *(u32x4*)xp = (u32x4){cvt_pk_bf16(v0[0], v0[1]), cvt_pk_bf16(v0[2], v0[3]), cvt_pk_bf16(v1[0], v1[1]), cvt_pk_bf16(v1[2], v1[3])};
        float sm = ((v0[0] * v0[0] + v0[1] * v0[1]) + (v0[2] * v0[2] + v0[3] * v0[3])) + ((v1[0] * v1[0] + v1[1] * v1[1]) + (v1[2] * v1[2] + v1[3] * v1[3]));
        { const int ln = fr + 16 * fq; sm += xor_shfl(sm, ln, 16); sm += xor_shfl(sm, ln, 32); }
        if (fq == 0) ((PG8_LAS float*)(xl + 4096))[fr * 8 + wr * 4 + wc] = sm;
    }
    __device__ __forceinline__ void operator()(const f32x4 (&acc)[2][2][4][2], const Unit& u, int wr, int wc, int fr, int fq, PG8_LAS unsigned char* xl, int tid) const {
        if (xb == nullptr) return;
        const int row0 = u.pm * BM + wr * 64 + fr, col0 = u.pn * BM + wc * 32 + 8 * fq;
        PG8_LAS float* scr = (PG8_LAS float*)xl;
        f32x4 bv[2][2];
#pragma unroll
        for (int bj = 0; bj < 2; ++bj)
#pragma unroll
            for (int n = 0; n < 2; ++n) bv[bj][n] = bias ? *(const f32x4*)(bias + col0 + bj * HALF + 4 * n) : (f32x4){0.f, 0.f, 0.f, 0.f};
#pragma unroll
        for (int ai = 0; ai < 2; ++ai) {
            u32x4 xo[4][2];
#pragma unroll
            for (int m = 0; m < 4; ++m) {
                const bf16_t* xp = xb + (size_t)(row0 + ai * HALF + m * 16) * DM + col0;
#pragma unroll
                for (int bj = 0; bj < 2; ++bj) xo[m][bj] = *(const u32x4*)(xp + bj * HALF);
            }
#pragma unroll
            for (int m = 0; m < 4; ++m) {
                bf16_t* xp = xb + (size_t)(row0 + ai * HALF + m * 16) * DM + col0;
                f32x2 s2 = (f32x2){0.f, 0.f};
#pragma unroll
                for (int bj = 0; bj < 2; ++bj) {
                    const u32x4 w = xo[m][bj];
                    f32x4 a0 = acc[ai][bj][m][0], a1 = acc[ai][bj][m][1];
#if DUP_MASK != 0
                    a0 = a0 * accs; a1 = a1 * accs;
#endif
                    if (bias) { a0 += bv[bj][0]; a1 += bv[bj][1]; }
                    const f32x2 v00 = (f32x2){__builtin_bit_cast(float, w.x << 16), __builtin_bit_cast(float, w.x & 0xffff0000u)} + (f32x2){a0[0], a0[1]};
                    const f32x2 v01 = (f32x2){__builtin_bit_cast(float, w.y << 16), __builtin_bit_cast(float, w.y & 0xffff0000u)} + (f32x2){a0[2], a0[3]};
                    const f32x2 v10 = (f32x2){__builtin_bit_cast(float, w.z << 16), __builtin_bit_cast(float, w.z & 0xffff0000u)} + (f32x2){a1[0], a1[1]};
                    const f32x2 v11 = (f32x2){__builtin_bit_cast(float, w.w << 16), __builtin_bit_cast(float, w.w & 0xffff0000u)} + (f32x2){a1[2], a1[3]};
                    *(u32x4*)(xp + bj * HALF) = (u32x4){cvt_pk_bf16(v00[0], v00[1]), cvt_pk_bf16(v01[0], v01[1]), cvt_pk_bf16(v10[0], v10[1]), cvt_pk_bf16(v11[0], v11[1])};
                    s2 = v00 * v00 + s2; s2 = v01 * v01 + s2; s2 = v10 * v10 + s2; s2 = v11 * v11 + s2;
                }
                float sm = s2[0] + s2[1];
                { const int ln = fr + 16 * fq; sm += xor_shfl(sm, ln, 16); sm += xor_shfl(sm, ln, 32); }
                if (fq == 0) scr[(ai * HALF + wr * 64 + m * 16 + fr) * 4 + wc] = sm;
            }
            asm volatile("" ::: "memory");
        }
        asm volatile("s_waitcnt lgkmcnt(0)" ::: "memory"); __builtin_amdgcn_s_barrier(); asm volatile("" ::: "memory");
        if (tid < BM) { const f32x4 p = *(const PG8_LAS f32x4*)(scr + tid * 4); ssq[(size_t)(u.pm * BM + tid) * 4 + u.pn] = (p[0] + p[1]) + (p[2] + p[3]); }
        if (tid < 16) { const PG8_LAS f32x4* q = (const PG8_LAS f32x4*)(xl + 4096) + tid * 2; const f32x4 p0 = q[0], p1 = q[1];
            ssq[(size_t)(MP + 16 * u.pm + tid) * 4 + u.pn] = ((p0[0] + p0[1]) + (p0[2] + p0[3])) + ((p1[0] + p1[1]) + (p1[2] + p1[3])); }
    }
};
template <int NSPL>
struct EpiSlab {
    static constexpr bool PERM = true, AFTER_DRAIN = false, XROWS = false;
    float* slab; unsigned* cnt; unsigned* tmo; bf16_t* xb; float* ssq; const float* bias; float accs;
    __device__ __forceinline__ void operator()(const f32x4 (&acc)[2][2][4][2], const Unit& u, int wr, int wc, int fr, int fq, PG8_LAS unsigned char* xl, int tid) const {
        const int tile = (u.pm - 64) * 4 + u.pn, unit = u.ks * 16 + tile;
        const __amdgpu_buffer_rsrc_t rs = __builtin_amdgcn_make_buffer_rsrc(slab, 0, 16 * NSPL * 32 * 512 * 16, 0x00020000);
        const int voff = (unit * 32 * 512 + tid) * 16;
#pragma unroll
        for (int ai = 0; ai < 2; ++ai)
#pragma unroll
            for (int bj = 0; bj < 2; ++bj)
#pragma unroll
                for (int m = 0; m < 4; ++m)
#pragma unroll
                    for (int n = 0; n < 2; ++n) __builtin_amdgcn_raw_buffer_store_b128(__builtin_bit_cast(u32x4, acc[ai][bj][m][n]), rs, voff + (ai * 16 + bj * 8 + m * 2 + n) * 512 * 16, 0, 16  );
        asm volatile("s_waitcnt vmcnt(0)" ::: "memory");
        asm volatile("s_waitcnt lgkmcnt(0)" ::: "memory"); __builtin_amdgcn_s_barrier(); asm volatile("" ::: "memory");
        unsigned* c = cnt + tile * 64;
        if (tid == 0) __hip_atomic_fetch_add(c, 1u, __ATOMIC_RELAXED, __HIP_MEMORY_SCOPE_AGENT);
        if (u.ks >= 8) return;
        if (tid < 64) {
            const unsigned long long t0 = __builtin_amdgcn_s_memrealtime();
            while ((unsigned)__builtin_amdgcn_readfirstlane(__hip_atomic_load(c, __ATOMIC_RELAXED, __HIP_MEMORY_SCOPE_AGENT)) < (unsigned)NSPL) {
                if (__builtin_amdgcn_s_memrealtime() - t0 > 2000000ull) { if (tid == 0) __hip_atomic_store(tmo, 1u, __ATOMIC_RELAXED, __HIP_MEMORY_SCOPE_AGENT); break; }
                __builtin_amdgcn_s_sleep(2); }
            __builtin_amdgcn_fence(__ATOMIC_ACQUIRE, "agent");
            asm volatile("s_waitcnt vmcnt(0)" ::: "memory");
        }
        asm volatile("" ::: "memory"); __builtin_amdgcn_s_barrier(); asm volatile("" ::: "memory");
        for (int rg = u.ks; rg < 8; rg += NSPL) {
        const int ai = rg >> 2, m = rg & 3;
        const int row = u.pm * BM + ai * HALF + wr * 64 + m * 16 + fr, col0 = u.pn * BM + wc * 32 + 8 * fq;
        bf16_t* xp = xb + (size_t)row * DM + col0;
        u32x4 xo[2];
#pragma unroll
        for (int bj = 0; bj < 2; ++bj) xo[bj] = *(const u32x4*)(xp + bj * HALF);
        f32x4 sum[2][2];
#pragma unroll
        for (int bj = 0; bj < 2; ++bj)
#pragma unroll
            for (int n = 0; n < 2; ++n) sum[bj][n] = (f32x4){0.f, 0.f, 0.f, 0.f};
#pragma unroll
        for (int sp = 0; sp < NSPL; ++sp) {
            const int so = (((sp * 16 + tile) * 32 + ai * 16 + m * 2) * 512 + tid) * 16;
#pragma unroll
            for (int bj = 0; bj < 2; ++bj)
#pragma unroll
                for (int n = 0; n < 2; ++n) sum[bj][n] += __builtin_bit_cast(f32x4, __builtin_amdgcn_raw_buffer_load_b128(rs, so + (bj * 8 + n) * 512 * 16, 0, 16  ));
        }
        PG8_LAS float* scr = (PG8_LAS float*)xl;
        float sm = 0.f;
#pragma unroll
        for (int bj = 0; bj < 2; ++bj) {
            f32x4 v0 = bf4_to_f32((u32x2){xo[bj].x, xo[bj].y}) + sum[bj][0] * accs, v1 = bf4_to_f32((u32x2){xo[bj].z, xo[bj].w}) + sum[bj][1] * accs;
            if (bias) { v0 += *(const f32x4*)(bias + col0 + bj * HALF); v1 += *(const f32x4*)(bias + col0 + bj * HALF + 4); }
            *(u32x4*)(xp + bj * HALF) = (u32x4){cvt_pk_bf16(v0[0], v0[1]), cvt_pk_bf16(v0[2], v0[3]), cvt_pk_bf16(v1[0], v1[1]), cvt_pk_bf16(v1[2], v1[3])};
            sm += ((v0[0] * v0[0] + v0[1] * v0[1]) + (v0[2] * v0[2] + v0[3] * v0[3])) + ((v1[0] * v1[0] + v1[1] * v1[1]) + (v1[2] * v1[2] + v1[3] * v1[3]));
        }
        { const int ln = fr + 16 * fq; sm += xor_shfl(sm, ln, 16); sm += xor_shfl(sm, ln, 32); }
        if (fq == 0) scr[(wr * 16 + fr) * 4 + wc] = sm;
        asm volatile("s_waitcnt lgkmcnt(0)" ::: "memory"); __builtin_amdgcn_s_barrier(); asm volatile("" ::: "memory");
        if (tid < 32) { const f32x4 p = *(const PG8_LAS f32x4*)(scr + tid * 4);
            ssq[(size_t)(u.pm * BM + ai * HALF + (tid >> 4) * 64 + m * 16 + (tid & 15)) * 4 + u.pn] = (p[0] + p[1]) + (p[2] + p[3]); }
        asm volatile("s_waitcnt lgkmcnt(0)" ::: "memory"); __builtin_amdgcn_s_barrier(); asm volatile("" ::: "memory");
        }
    }
};
struct EpiQKV {
    static constexpr bool PERM = true, AFTER_DRAIN = false, XROWS = false;
    bf16_t* Q; bf16_t* K; bf16_t* V; const float* ssq; const float* bias; const float* rope; float* out;
    __device__ __forceinline__ void operator()(const f32x4 (&acc)[2][2][4][2], const Unit& u, int wr, int wc, int fr, int fq, PG8_LAS unsigned char* xl, int tid) const {
        const int row0 = u.pm * BM + wr * 64 + fr, pn = u.pn, dd0 = 8 * fq, nat0 = pn * 256 + wc * 64 + dd0;
        f32x4 bv[2][2];
#pragma unroll
        for (int bj = 0; bj < 2; ++bj)
#pragma unroll
            for (int n = 0; n < 2; ++n) bv[bj][n] = *(const f32x4*)(bias + nat0 + bj * 32 + 4 * n);
        float rs8[2][4];
        {
            f32x4 sq[2][4];
#pragma unroll
            for (int ai = 0; ai < 2; ++ai)
#pragma unroll
                for (int m = 0; m < 4; ++m) sq[ai][m] = *(const f32x4*)(ssq + (size_t)(row0 + ai * HALF + m * 16) * 4);
#pragma unroll
            for (int ai = 0; ai < 2; ++ai)
#pragma unroll
                for (int m = 0; m < 4; ++m) { rs8[ai][m] = rstd_of(sq[ai][m]); asm volatile("" : "+v"(rs8[ai][m])); }
        }
        asm volatile("" ::: "memory");
#pragma unroll
        for (int ah = 0; ah < 4; ++ah) {
            const int ai = ah >> 1;
            f32x4 rp[4][4];
            if (pn < 5) {
#pragma unroll
                for (int m = 2 * (ah & 1); m < 2 * (ah & 1) + 2; ++m) { const int row = row0 + ai * HALF + m * 16;
                    const int pidx = (row < MP) ? (row & (TPS - 1)) : TPS + ((row - MP) & (TSS - 1));
                    const f32x4* rq = (const f32x4*)(rope + ((size_t)pidx * 32 + dd0) * 2);
#pragma unroll
                    for (int j = 0; j < 4; ++j) rp[m][j] = rq[j]; }
            }
#pragma unroll
            for (int m = 2 * (ah & 1); m < 2 * (ah & 1) + 2; ++m) {
                const int row = row0 + ai * HALF + m * 16;
                const float rs = rs8[ai][m];
                f32x4 v[2][2];
#pragma unroll
                for (int bj = 0; bj < 2; ++bj)
#pragma unroll
                    for (int n = 0; n < 2; ++n) v[bj][n] = acc[ai][bj][m][n] * rs + bv[bj][n];
                if (pn < 5) {
#pragma unroll
                    for (int n = 0; n < 2; ++n) {
                        const f32x4 cs0 = rp[m][2 * n], cs1 = rp[m][2 * n + 1];
                        const float c[4] = {cs0[0], cs0[2], cs1[0], cs1[2]}, sn[4] = {cs0[1], cs0[3], cs1[1], cs1[3]};
                        const f32x4 x1 = v[0][n], x2 = v[1][n];
#pragma unroll
                        for (int i = 0; i < 4; ++i) { v[0][n][i] = x1[i] * c[i] - x2[i] * sn[i]; v[1][n][i] = x2[i] * c[i] + x1[i] * sn[i]; }
                    }
                }
                if (pn < 4) {
#pragma unroll
                    for (int bj = 0; bj < 2; ++bj) { const f32x4 a = v[bj][0] * QSCALE, b = v[bj][1] * QSCALE;
                        *(u32x4*)(Q + (size_t)row * DM + nat0 + bj * 32) = (u32x4){cvt_pk_bf16(a[0], a[1]), cvt_pk_bf16(a[2], a[3]), cvt_pk_bf16(b[0], b[1]), cvt_pk_bf16(b[2], b[3])}; }
                } else {
                    bf16_t* kv = (pn == 4) ? K : V;
                    const int c0 = wc * 64 + dd0;
#pragma unroll
                    for (int bj = 0; bj < 2; ++bj) { const f32x4 a = v[bj][0], b = v[bj][1];
                        *(u32x4*)(kv + (size_t)row * KVD + c0 + bj * 32) = (u32x4){cvt_pk_bf16(a[0], a[1]), cvt_pk_bf16(a[2], a[3]), cvt_pk_bf16(b[0], b[1]), cvt_pk_bf16(b[2], b[3])}; }
                    float* dst = nullptr;
                    if (row < MP) { const int t = row & (TPS - 1); if (t >= TPS - 128) dst = out + ((pn == 4) ? O_KP : O_VP) + ((size_t)(row >> 11) * 128 + (t - (TPS - 128))) * KVD + c0; }
                    else { const int r = row - MP; dst = out + ((pn == 4) ? O_KS : O_VS) + ((size_t)(r >> 3) * 128 + 120 + (r & 7)) * KVD + c0; }
                    if (dst) {
#pragma unroll
                        for (int bj = 0; bj < 2; ++bj)
#pragma unroll
                            for (int n = 0; n < 2; ++n) *(f32x4*)(dst + bj * 32 + 4 * n) = v[bj][n];
                    }
                }
            }
            asm volatile("" ::: "memory");
        }
    }
};

template <class Epi, class Sched, bool ALIGN_EPI = false, bool SP2 = false>
__device__ __forceinline__ void gemm_phase(PG8_LAS unsigned char* lds, const Gemm g, const Sched& S, const Epi& E, const int tid) {
    const int wid = __builtin_amdgcn_readfirstlane(tid >> 6), lane = tid & 63, wr = wid >> 2, wc = wid & 3, fr = lane & 15, fq = lane >> 4;
    const int K = g.K, nt = K / BK;
    unsigned voffA[2], voffB[2];
#pragma unroll
    for (int i = 0; i < 2; ++i) { int R, C; stage_rc(tid * 16 + i * 8192, R, C); const int Rb = Epi::PERM ? ((R & ~31) + perm32(R & 31)) : R;
        voffA[i] = (unsigned)(R * g.lda + C) * 2u; voffB[i] = (unsigned)(Rb * g.ldb + C) * 2u; }
    const size_t kstep = (size_t)(BK * 2);
    const size_t hstepA = (size_t)HALF * g.lda * 2, hstepB = (size_t)HALF * g.ldb * 2;
    const size_t tstepA = 2 * hstepA, tstepB = 2 * hstepB;
    const size_t pnA = (size_t)g.a_pn_cols * 2;
    const unsigned ldsw = (unsigned)wid * 1024u;
    const int aoff = lds_byte(wr * 64 + fr, fq * 8), boff = lds_byte(wc * 32 + fr, fq * 8);
#define PG8_SA(b, h) (((b) * 2 + (h)) * HTB)
#define PG8_SB(b, h) ((4 + (b) * 2 + (h)) * HTB)
#define PG8_STAGE(bufoff, gbase, voff) do { _Pragma("unroll") for (int _i = 0; _i < 2; ++_i) \
        __builtin_amdgcn_global_load_lds((const unsigned*)((const char*)(gbase) + (voff)[_i]), (PG8_LAS unsigned*)(lds + (bufoff) + ldsw + _i * 8192), 16, 0, 0); } while (0)
#define PG8_LDA(dst, b, h) do { _Pragma("unroll") for (int m = 0; m < 4; ++m) _Pragma("unroll") for (int k = 0; k < 2; ++k) dst[m][k] = *(const PG8_LAS bf16x8*)(lds + PG8_SA(b, h) + aoff + m * 2048 + k * 1024); } while (0)
#define PG8_LDB(dst, b, h) do { _Pragma("unroll") for (int n = 0; n < 2; ++n) _Pragma("unroll") for (int k = 0; k < 2; ++k) dst[n][k] = *(const PG8_LAS bf16x8*)(lds + PG8_SB(b, h) + boff + n * 2048 + k * 1024); } while (0)
#define PG8_MMA(ai, bj, At, Bt) do { __builtin_amdgcn_s_setprio(1); _Pragma("unroll") for (int m = 0; m < 4; ++m) _Pragma("unroll") for (int n = 0; n < 2; ++n) _Pragma("unroll") for (int k = 0; k < 2; ++k) \
        acc[ai][bj][m][n] = __builtin_amdgcn_mfma_f32_16x16x32_bf16(Bt[n][k], At[m][k], acc[ai][bj][m][n], 0, 0, 0); __builtin_amdgcn_s_setprio(0); } while (0)
#define PG8_WAIT_V(n) asm volatile("s_waitcnt vmcnt(" #n ")" ::: "memory")
#define PG8_WAIT_L(n) asm volatile("s_waitcnt lgkmcnt(" #n ")" ::: "memory")
#define PG8_BAR __builtin_amdgcn_s_barrier()
#define PG8_SCHED __builtin_amdgcn_sched_barrier(0)
    Unit cur, nxt; int ui = 0;
    if (!S.next(0, cur)) return;
    f32x4 accx[2] = {(f32x4){0.f, 0.f, 0.f, 0.f}, (f32x4){0.f, 0.f, 0.f, 0.f}}; bf16x8 axf[2];
    const unsigned voffX = (unsigned)((lane & 15) * g.lda + 32 * wid + 8 * (lane >> 4)) * 2u;
    const size_t xstep = (size_t)16 * g.lda * 2;
#define PG8_XSTAGE(b, xbase) do { if constexpr (Epi::XROWS) { if (wid < 2) \
        __builtin_amdgcn_global_load_lds((const unsigned*)((const char*)(xbase) + voffX), (PG8_LAS unsigned*)(lds + XA_OFF + (b) * 2048 + ldsw), 16, 0, 0); } } while (0)
#define PG8_LDX(b) do { if constexpr (Epi::XROWS) { _Pragma("unroll") for (int k = 0; k < 2; ++k) axf[k] = *(const PG8_LAS bf16x8*)(lds + XA_OFF + (b) * 2048 + k * 1024 + lane * 16); } } while (0)
#define PG8_MMX() do { if constexpr (Epi::XROWS) { __builtin_amdgcn_s_setprio(1); if (wr == 0) { _Pragma("unroll") for (int n = 0; n < 2; ++n) _Pragma("unroll") for (int k = 0; k < 2; ++k) accx[n] = __builtin_amdgcn_mfma_f32_16x16x32_bf16(B0[n][k], axf[k], accx[n], 0, 0, 0); } \
        else { _Pragma("unroll") for (int n = 0; n < 2; ++n) _Pragma("unroll") for (int k = 0; k < 2; ++k) accx[n] = __builtin_amdgcn_mfma_f32_16x16x32_bf16(B1[n][k], axf[k], accx[n], 0, 0, 0); } __builtin_amdgcn_s_setprio(0); } } while (0)
    f32x4 acc[2][2][4][2];
#pragma unroll
    for (int a = 0; a < 2; ++a)
#pragma unroll
        for (int b = 0; b < 2; ++b)
#pragma unroll
            for (int m = 0; m < 4; ++m)
#pragma unroll
                for (int n = 0; n < 2; ++n) acc[a][b][m][n] = (f32x4){0.f, 0.f, 0.f, 0.f};
    bf16x8 At[4][2], B0[2][2], B1[2][2];
    const size_t ksb = (size_t)K * 2;
    const char* cA = (const char*)g.A + (size_t)cur.pm * tstepA + (size_t)cur.pn * pnA + (size_t)cur.ks * ksb; const char* cB = (const char*)g.Bt + (size_t)cur.pn * tstepB + (size_t)cur.ks * ksb;
    const char* cX = Epi::XROWS ? (const char*)g.AX + (size_t)cur.pm * xstep : nullptr;
    S.a_ready(cur);
    if constexpr (SP2) {
        PG8_STAGE(PG8_SB(0, 0), cB, voffB); PG8_STAGE(PG8_SB(0, 1), cB + hstepB, voffB); PG8_STAGE(PG8_SA(0, 0), cA, voffA); PG8_XSTAGE(0, cX); PG8_STAGE(PG8_SA(0, 1), cA + hstepA, voffA);
        if (wr == 1) PG8_BAR;
        PG8_WAIT_V(2); PG8_BAR;
        PG8_STAGE(PG8_SB(1, 0), cB + kstep, voffB); PG8_STAGE(PG8_SA(1, 0), cA + kstep, voffA); PG8_XSTAGE(1, cX + kstep); PG8_STAGE(PG8_SB(1, 1), cB + hstepB + kstep, voffB);
        PG8_WAIT_V(6); PG8_BAR;
    } else {
        PG8_STAGE(PG8_SB(0, 0), cB, voffB); PG8_STAGE(PG8_SA(0, 0), cA, voffA); PG8_STAGE(PG8_SB(0, 1), cB + hstepB, voffB); PG8_STAGE(PG8_SA(0, 1), cA + hstepA, voffA);
        if (wr == 1) PG8_BAR;
        PG8_WAIT_V(4); PG8_BAR;
        PG8_STAGE(PG8_SB(1, 0), cB + kstep, voffB); PG8_STAGE(PG8_SA(1, 0), cA + kstep, voffA); PG8_STAGE(PG8_SB(1, 1), cB + hstepB + kstep, voffB);
        PG8_WAIT_V(6); PG8_BAR;
    }
    for (;;) {
        const bool has_next = S.next(ui + 1, nxt);
        const char* nA = has_next ? (const char*)g.A + (size_t)nxt.pm * tstepA + (size_t)nxt.pn * pnA + (size_t)nxt.ks * ksb : cA; const char* nB = has_next ? (const char*)g.Bt + (size_t)nxt.pn * tstepB + (size_t)nxt.ks * ksb : cB;
        const char* nX = (Epi::XROWS && has_next) ? (const char*)g.AX + (size_t)nxt.pm * xstep : cX;
        for (int t = 0; t < nt; t += 2) {
            const bool last = (t == nt - 2);
            const char* a1 = cA + (size_t)(t + 1) * kstep;
            const char* a2 = last ? nA : cA + (size_t)(t + 2) * kstep; const char* b2 = last ? nB : cB + (size_t)(t + 2) * kstep;
            const char* a3 = a2 + kstep; const char* b3 = b2 + kstep;
            const char* x2 = last ? nX : cX + (size_t)(t + 2) * kstep; const char* x3 = x2 + kstep;
            if (last && has_next) S.a_ready(nxt);
            if constexpr (SP2) {
            PG8_LDB(B0, 0, 0); PG8_LDB(B1, 0, 1); PG8_SCHED; PG8_LDA(At, 0, 0); PG8_LDX(0); PG8_STAGE(PG8_SA(1, 1), a1 + hstepA, voffA);
            PG8_WAIT_V(8); PG8_WAIT_L(0); PG8_BAR; PG8_MMA(0, 0, At, B0); PG8_MMA(0, 1, At, B1); PG8_MMX(); PG8_BAR; PG8_SCHED;
            PG8_LDA(At, 0, 1); PG8_STAGE(PG8_SB(0, 0), b2, voffB); PG8_STAGE(PG8_SB(0, 1), b2 + hstepB, voffB); PG8_STAGE(PG8_SA(0, 0), a2, voffA); PG8_XSTAGE(0, x2);
            PG8_WAIT_V(8); PG8_WAIT_L(0); PG8_BAR; PG8_MMA(1, 0, At, B0); PG8_MMA(1, 1, At, B1); PG8_BAR; PG8_SCHED;
            PG8_LDB(B0, 1, 0); PG8_LDB(B1, 1, 1); PG8_SCHED; PG8_LDA(At, 1, 0); PG8_LDX(1); PG8_STAGE(PG8_SA(0, 1), a2 + hstepA, voffA);
            PG8_WAIT_V(8); PG8_WAIT_L(0); PG8_BAR; PG8_MMA(0, 0, At, B0); PG8_MMA(0, 1, At, B1); PG8_MMX(); PG8_BAR; PG8_SCHED;
            PG8_LDA(At, 1, 1); PG8_STAGE(PG8_SB(1, 0), b3, voffB); PG8_STAGE(PG8_SB(1, 1), b3 + hstepB, voffB); PG8_STAGE(PG8_SA(1, 0), a3, voffA); PG8_XSTAGE(1, x3);
            PG8_WAIT_V(8); PG8_WAIT_L(0); PG8_BAR; PG8_MMA(1, 0, At, B0); PG8_MMA(1, 1, At, B1); PG8_BAR; PG8_SCHED;
            } else {
            PG8_LDB(B0, 0, 0); PG8_SCHED; PG8_LDA(At, 0, 0); PG8_STAGE(PG8_SA(1, 1), a1 + hstepA, voffA);
            PG8_WAIT_L(8); PG8_BAR; PG8_WAIT_L(0); PG8_MMA(0, 0, At, B0); PG8_BAR; PG8_SCHED;
            PG8_LDB(B1, 0, 1); PG8_STAGE(PG8_SB(0, 0), b2, voffB);
            PG8_BAR; PG8_WAIT_L(0); PG8_MMA(0, 1, At, B1); PG8_BAR;
            PG8_LDA(At, 0, 1); PG8_STAGE(PG8_SA(0, 0), a2, voffA);
            PG8_BAR; PG8_WAIT_L(0); PG8_MMA(1, 0, At, B0); PG8_BAR; PG8_SCHED;
            PG8_STAGE(PG8_SB(0, 1), b2 + hstepB, voffB);
            PG8_WAIT_V(6); PG8_BAR; PG8_MMA(1, 1, At, B1); PG8_BAR;
            PG8_LDB(B0, 1, 0); PG8_SCHED; PG8_LDA(At, 1, 0); PG8_STAGE(PG8_SA(0, 1), a2 + hstepA, voffA);
            PG8_WAIT_L(8); PG8_BAR; PG8_WAIT_L(0); PG8_MMA(0, 0, At, B0); PG8_BAR; PG8_SCHED;
            PG8_LDB(B1, 1, 1); PG8_STAGE(PG8_SB(1, 0), b3, voffB);
            PG8_BAR; PG8_WAIT_L(0); PG8_MMA(0, 1, At, B1); PG8_BAR;
            PG8_LDA(At, 1, 1); PG8_STAGE(PG8_SA(1, 0), a3, voffA);
            PG8_BAR; PG8_WAIT_L(0); PG8_MMA(1, 0, At, B0); PG8_BAR; PG8_SCHED;
            PG8_STAGE(PG8_SB(1, 1), b3 + hstepB, voffB);
            PG8_WAIT_V(6); PG8_BAR; PG8_MMA(1, 1, At, B1); PG8_BAR;
            }
        }
        if constexpr (ALIGN_EPI) { if (wr == 0) PG8_BAR; }
        if constexpr (!Epi::AFTER_DRAIN) { unsigned zz = 0u; asm volatile("" : "+v"(zz)); int le = (int)__builtin_amdgcn_mbcnt_hi(~0u, __builtin_amdgcn_mbcnt_lo(~0u, zz)); asm volatile("" : "+v"(le)); if constexpr (Epi::XROWS) E.xrows(accx, cur, wr, wc, le & 15, le >> 4, lds + EPI_SCR_OFF, wid * 64 + le); E(acc, cur, wr, wc, le & 15, le >> 4, lds + EPI_SCR_OFF, wid * 64 + le); S.done(cur); }
        if (!has_next) break;
#pragma unroll
        for (int a = 0; a < 2; ++a)
#pragma unroll
            for (int b = 0; b < 2; ++b)
#pragma unroll
                for (int m = 0; m < 4; ++m)
#pragma unroll
                    for (int n = 0; n < 2; ++n) acc[a][b][m][n] = (f32x4){0.f, 0.f, 0.f, 0.f};
        accx[0] = (f32x4){0.f, 0.f, 0.f, 0.f}; accx[1] = accx[0];
        cur = nxt; cA = nA; cB = nB; cX = nX; ++ui;
        if constexpr (ALIGN_EPI) { if (wr == 1) PG8_BAR; }
    }
    PG8_WAIT_V(0);
    if constexpr (!ALIGN_EPI) { if (wr == 0) PG8_BAR; }
    PG8_BAR;
#undef PG8_XSTAGE
#undef PG8_LDX
#undef PG8_MMX
#undef PG8_SA
#undef PG8_SB
#undef PG8_STAGE
#undef PG8_LDA
#undef PG8_LDB
#undef PG8_MMA
#undef PG8_WAIT_V
#undef PG8_WAIT_L
#undef PG8_BAR
#undef PG8_SCHED
}
}

#define GAS __attribute__((address_space(1)))
#define LAS __attribute__((address_space(3)))
typedef unsigned short bf16;
typedef unsigned v4u __attribute__((ext_vector_type(4)));
typedef unsigned v2u __attribute__((ext_vector_type(2)));
typedef float f32x4 __attribute__((ext_vector_type(4)));
typedef float f32x2 __attribute__((ext_vector_type(2)));
typedef float f32x16 __attribute__((ext_vector_type(16)));
typedef short bf16x8 __attribute__((ext_vector_type(8)));
typedef short s16x4 __attribute__((ext_vector_type(4)));
typedef GAS unsigned gu32;
#define RLX_AGENT __ATOMIC_RELAXED, __HIP_MEMORY_SCOPE_AGENT
#define LDS_WAIT() asm volatile("s_waitcnt lgkmcnt(0)" ::: "memory")
#define VM_WAIT() asm volatile("s_waitcnt vmcnt(0)" ::: "memory")
__device__ __forceinline__ unsigned f2bf(float f) { unsigned u = __builtin_bit_cast(unsigned, f); return (u + 0x7fffu + ((u >> 16) & 1u)) >> 16; }
__device__ __forceinline__ unsigned pk2(float lo, float hi) { return f2bf(lo) | (f2bf(hi) << 16); }
__device__ __forceinline__ float bf2f(unsigned short b) { return __builtin_bit_cast(float, (unsigned)b << 16); }

constexpr int NWAVES = 8;
constexpr size_t MiB = 1u << 20;
constexpr size_t WS_CTL = 0, CTL_ZERO_BYTES = 64 * 1024;
constexpr size_t WS_ROPE = 1 * MiB;
constexpr size_t WS_SSQ = 2 * MiB;
constexpr size_t WS_WQKV = 4 * MiB, WS_WO = 7 * MiB, WS_WPOOL = 9 * MiB;
constexpr size_t WS_W1 = 10 * MiB, W1_BYTES = (size_t)2 * DFF * DM * 2;
constexpr size_t WS_W2 = 54 * MiB, W2_BYTES = (size_t)DM * DFF * 2;
constexpr size_t WS_XB = 76 * MiB;
constexpr size_t WS_H = 110 * MiB;
constexpr size_t WS_Q = WS_H, WS_O = WS_H + 34 * MiB, WS_K = WS_H + 68 * MiB, WS_V = WS_H + 77 * MiB;
constexpr size_t WS_XB2 = 204 * MiB;
constexpr size_t WS_SSQ2 = 3 * MiB;
constexpr int NSPLIT = 11, NSPLIT_O = 4;
constexpr size_t WS_END = 238 * MiB;
static_assert(WS_W1 + 4 * W1_BYTES <= WS_W2 && WS_W2 + 4 * W2_BYTES <= WS_XB && WS_XB + (size_t)MT * DM * 2 <= WS_H && WS_H + (size_t)MT * DFF * 2 <= WS_END, "ws map");
static_assert(WS_V + (size_t)MT * KVD * 2 <= WS_END && WS_K + (size_t)MT * KVD * 2 <= WS_V && WS_O + (size_t)MT * DM * 2 <= WS_K, "ws map 2");
constexpr int CW_TMO = 64, CW_TILE = 8192;
constexpr int CW_BAR = 4096;
constexpr int RING_OFF = 0, RING_BYTES = 131072;
constexpr int LDSCTL_OFF = 146432, MISC_OFF = LDSCTL_OFF + 320;
constexpr int LDS_BYTES = 147456;
static_assert((2 * 6 * 8192 + 8 * 256 + 8 * 4096) <= LDSCTL_OFF && (131072 + 8192 + 4096) <= LDSCTL_OFF && MISC_OFF + 64 <= LDS_BYTES, "LDS map");

#define XB_TMO      128
#define XB_XCNT(j)  (256  + 64 * (j))
#define XB_XSUB(j)  (1280 + 64 * (j))
#define XB_XGEN(j)  (2304 + 64 * (j))
#define XB_TOP      3328
#define XB_TOPGEN   3392
#define XCD_BAR_WORDS 3456
#define XB_SPIN_CAP (1u << 18)
__device__ __forceinline__ unsigned xb_ld(unsigned* p)              { return __hip_atomic_load(p, __ATOMIC_RELAXED, __HIP_MEMORY_SCOPE_AGENT); }
__device__ __forceinline__ unsigned xb_add(unsigned* p, unsigned v) { return __hip_atomic_fetch_add(p, v, __ATOMIC_RELAXED, __HIP_MEMORY_SCOPE_AGENT); }
__device__ __forceinline__ unsigned xb_xcc_id() { return (unsigned)__builtin_amdgcn_s_getreg((3 << 11) | 20) & 0xFu; }
#define XB_SPIN(cond, bar) do { unsigned _sp = 0; while (cond) { __builtin_amdgcn_s_sleep(1); \
    if ((++_sp & 255u) == 0u) { if (xb_ld(&(bar)[XB_TMO])) break; if (_sp > XB_SPIN_CAP) { atomicAdd(&(bar)[XB_TMO], 1u); break; } } } } while (0)
struct XcdBarrier { unsigned* bar; unsigned x; volatile LAS unsigned* st; };
__device__ __forceinline__ XcdBarrier xcd_barrier_post(unsigned* bar, volatile LAS unsigned* st) {
    XcdBarrier b; b.bar = bar; b.x = xb_xcc_id(); b.st = st;
    if (threadIdx.x == 0) (void)xb_add(&bar[XB_XCNT(b.x)], 1u);
    return b;
}
__device__ __forceinline__ void xcd_barrier_complete(unsigned* bar, unsigned x, unsigned& nloc, unsigned& nx) {
    const unsigned G = gridDim.x * gridDim.y * gridDim.z;
    unsigned sum, cnt, mine, sp = 0u;
    for (;;) {
        sum = 0u; cnt = 0u; mine = 0u;
#pragma unroll
        for (unsigned j = 0; j < 16; ++j) { const unsigned c = xb_ld(&bar[XB_XCNT(j)]); sum += c; cnt += (c > 0u) ? 1u : 0u; mine = (j == x) ? c : mine; }
        if (sum == G) break;
        __builtin_amdgcn_s_sleep(1);
        if ((++sp & 255u) == 0u) { if (xb_ld(&bar[XB_TMO])) break; if (sp > XB_SPIN_CAP) { atomicAdd(&bar[XB_TMO], 1u); break; } }
    }
    nloc = mine > 0u ? mine : 1u; nx = cnt > 0u ? cnt : 1u;
}
__device__ __forceinline__ void xcd_barrier(const XcdBarrier& b) {
    asm volatile("s_waitcnt vmcnt(0)" ::: "memory");
    __syncthreads();
    if (threadIdx.x == 0) {
        unsigned* bar = b.bar;
        __builtin_amdgcn_s_waitcnt(0);
        unsigned nloc = b.st[0], nx = b.st[1];
        if (nloc == 0u) { xcd_barrier_complete(bar, b.x, nloc, nx); b.st[0] = nloc; b.st[1] = nx; }
        const unsigned old = xb_add(&bar[XB_XSUB(b.x)], 1u);
        const unsigned gen = old / nloc;
        if (old + 1u == (gen + 1u) * nloc) {
            __builtin_amdgcn_fence(__ATOMIC_RELEASE, "agent");
            asm volatile("s_waitcnt vmcnt(0)" ::: "memory");
            const unsigned og = xb_add(&bar[XB_TOP], 1u);
            const unsigned tg = og / nx;
            if (og + 1u == (tg + 1u) * nx) xb_add(&bar[XB_TOPGEN], 1u);
            else XB_SPIN(xb_ld(&bar[XB_TOPGEN]) == tg, bar);
            __builtin_amdgcn_fence(__ATOMIC_ACQUIRE, "agent");
            xb_add(&bar[XB_XGEN(b.x)], 1u);
            asm volatile("s_waitcnt vmcnt(0)" ::: "memory");
        } else {
            XB_SPIN(xb_ld(&bar[XB_XGEN(b.x)]) == gen, bar);
            __builtin_amdgcn_fence(__ATOMIC_ACQUIRE, "agent");
            asm volatile("s_waitcnt vmcnt(0)" ::: "memory");
        }
    }
    __syncthreads();
}

struct Frame {
    LAS unsigned char* lds;
    int tid, lane, wave, vcu, G;
};
__device__ __forceinline__ int fresh_tid(int wave0) {
    int wv = wave0; asm volatile("" : "+s"(wv)); unsigned z = 0u; asm volatile("" : "+v"(z));
    int t = wv * 64 + (int)__builtin_amdgcn_mbcnt_hi(~0u, __builtin_amdgcn_mbcnt_lo(~0u, z)); asm volatile("" : "+v"(t)); return t;
}
__device__ __forceinline__ Frame phase_frame(const Frame& F0, int wave0) {
    Frame F = F0; const int t = fresh_tid(wave0); F.tid = t; F.lane = t & 63; F.wave = __builtin_amdgcn_readfirstlane(t >> 6); return F;
}
__device__ __forceinline__ float wave_sum(float v, int lane) {
#pragma unroll
    for (int o = 1; o < 64; o <<= 1) v += pg8::xor_shfl(v, lane, o);
    return v;
}

__device__ __forceinline__ void transpose_item64(const float* W, int ldw, bf16* WT, int K, int drow0, int scolA, int scolB, int k0, const float* kscale, const float* nscale, float cscale, LAS unsigned char* T, int lane) {
    const int kq = lane >> 4, nq = lane & 15;
    const float* src = W + (size_t)(k0 + 4 * kq) * ldw + ((nq < 8) ? scolA + 4 * nq : scolB + 4 * (nq - 8));
    f32x4 v[4][4];
#pragma unroll
    for (int j = 0; j < 4; ++j)
#pragma unroll
        for (int i = 0; i < 4; ++i) v[j][i] = __builtin_nontemporal_load((const f32x4*)(src + (size_t)(16 * j + i) * ldw));
    f32x4 ns = (f32x4){cscale, cscale, cscale, cscale};
    if (nscale) ns = *(const f32x4*)(nscale + drow0 + 4 * nq) * cscale;
#pragma unroll
    for (int j = 0; j < 4; ++j) {
        f32x4 ks = (f32x4){1.f, 1.f, 1.f, 1.f};
        if (kscale) ks = *(const f32x4*)(kscale + k0 + 16 * j + 4 * kq);
#pragma unroll
        for (int c = 0; c < 4; ++c) {
            const float sc = ns[c];
            v2u pk; pk.x = pk2(v[j][0][c] * ks[0] * sc, v[j][1][c] * ks[1] * sc); pk.y = pk2(v[j][2][c] * ks[2] * sc, v[j][3][c] * ks[3] * sc);
            const int n = 4 * nq + c, ch = (2 * j + (kq >> 1)) ^ (nq & 7);
            *(LAS v2u*)(T + n * 128 + ch * 16 + (kq & 1) * 8) = pk;
        }
    }
    LDS_WAIT(); asm volatile("" ::: "memory");
    const int c8 = lane & 7;
#pragma unroll
    for (int jj = 0; jj < 8; ++jj) { const int n = (lane >> 3) + 8 * jj;
        const v4u o = *(const LAS v4u*)(T + n * 128 + ((c8 ^ ((n >> 2) & 7)) * 16));
        *(GAS v4u*)(WT + (size_t)(drow0 + n) * K + k0 + 8 * c8) = o; }
    LDS_WAIT(); asm volatile("" ::: "memory");
}
struct Args { const float* in[20]; float* out; unsigned char* ws; int ph_lo, ph_hi; };
typedef const __attribute__((address_space(4))) Args* ArgsP;
struct Ptrs {
    ArgsP ap;
#define PTR_ACC(name, idx) __device__ __forceinline__ const float* name() const { return ap->in[idx]; }
    PTR_ACC(xp, 0) PTR_ACC(xs, 1) PTR_ACC(spool, 2) PTR_ACC(ck, 3) PTR_ACC(cv, 4) PTR_ACC(n1, 5) PTR_ACC(w1in, 6) PTR_ACC(w1out, 7) PTR_ACC(nmix, 8) PTR_ACC(n2, 9)
    PTR_ACC(w2in, 10) PTR_ACC(w2out, 11) PTR_ACC(poolw, 12) PTR_ACC(pscale, 13) PTR_ACC(wqkv, 14) PTR_ACC(bqkv, 15) PTR_ACC(wo, 16) PTR_ACC(bo, 17) PTR_ACC(sinks, 18) PTR_ACC(nfin, 19)
#undef PTR_ACC
    __device__ __forceinline__ float* out() const { return ap->out; }
    __device__ __forceinline__ unsigned char* ws() const { return ap->ws; }
};
constexpr int I_W1 = (DM / 64) * (2 * DFF / 64), I_W2 = (DFF / 64) * (DM / 64), I_FFN = I_W1 + I_W2;
constexpr int I_QKV = (DM / 64) * (QKVN / 64), I_WO = (DM / 64) * (DM / 64), I_POOL = 4 * 4 * 4;
constexpr int IT_QKV = 4 * I_FFN, IT_WO = IT_QKV + I_QKV, IT_POOL = IT_WO + I_WO, NITEMS = IT_POOL + I_POOL;
__device__ __forceinline__ void convert_items(const Frame& F, const Ptrs& P, int lo, int hi, int gw, int ngw) {
    LAS unsigned char* T = F.lds + RING_OFF + F.wave * 8192;
    unsigned char* ws = P.ws();
    for (int it = lo + gw; it < hi; it += ngw) {
        int r = it;
        if (r < 4 * I_FFN) {
            const int f = r / I_FFN; r -= f * I_FFN; const int layer = f >> 1, second = f & 1;
            if (r < I_W1) { const int nblk = 2 * DFF / 64, kb = r / nblk, nb = r % nblk, j = 64 * nb;
                const float* win = (second ? P.w2in() : P.w1in()) + (size_t)layer * DM * 2 * DFF;
                const float* gn = (second ? P.n2() : P.n1()) + layer * DM;
                const int scol = ((j >> 7) & 1) * DFF + (j >> 8) * 128 + (j & 127);
                transpose_item64(win, 2 * DFF, (bf16*)(ws + WS_W1 + f * W1_BYTES), DM, j, scol, scol + 32, 64 * kb, gn, nullptr, 1.0f, T, F.lane);
            } else { r -= I_W1; const int nblk = DM / 64, kb = r / nblk, nb = r % nblk;
                const float* wout = (second ? P.w2out() : P.w1out()) + (size_t)layer * DFF * DM;
                transpose_item64(wout, DM, (bf16*)(ws + WS_W2 + f * W2_BYTES), DFF, 64 * nb, 64 * nb, 64 * nb + 32, 64 * kb, nullptr, nullptr, 0.5f, T, F.lane); }
            continue;
        }
        r -= 4 * I_FFN;
        if (r < I_QKV) { const int nblk = QKVN / 64, kb = r / nblk, nb = r % nblk, j = 64 * nb;
            const int scol = (j >> 8) * 256 + ((j >> 5) & 3) * 64 + ((j >> 7) & 1) * 32;
            transpose_item64(P.wqkv(), QKVN, (bf16*)(ws + WS_WQKV), DM, j, scol, scol + 64, 64 * kb, P.nmix() + DM, nullptr, 1.0f, T, F.lane); continue; }
        r -= I_QKV;
        if (r < I_WO) { const int nblk = DM / 64, kb = r / nblk, nb = r % nblk;
            transpose_item64(P.wo(), DM, (bf16*)(ws + WS_WO), DM, 64 * nb, 64 * nb, 64 * nb + 32, 64 * kb, nullptr, nullptr, 1.0f, T, F.lane); continue; }
        r -= I_WO;
        { const int gi = r >> 4, kb = (r >> 2) & 3, nb = r & 3;
            transpose_item64(P.poolw() + (size_t)gi * 65536, 256, (bf16*)(ws + WS_WPOOL), 256, gi * 256 + 64 * nb, 64 * nb, 64 * nb + 32, 64 * kb, nullptr, P.pscale(), 1.0f, T, F.lane); }
    }
}
__device__ __forceinline__ void p0_prologue(const Frame& F, const Ptrs& P) {
    const int gw = F.vcu * NWAVES + F.wave, NGW = F.G * NWAVES;
    unsigned char* ws = P.ws();
    convert_items(F, P, 0, I_W1, gw, NGW);
    convert_items(F, P, IT_POOL, NITEMS, gw, NGW);
    {
        float* rope = (float*)(ws + WS_ROPE);
        const double r1 = 1.0 / sqrt(sqrt(sqrt(10.0)));
        for (int e = (F.vcu * NWAVES * 64) + F.tid; e < (TPS + TSS) * 32; e += F.G * NWAVES * 64) {
            const int pidx = e >> 5, d = e & 31; const int pos = pidx < TPS ? pidx : PAST + (pidx - TPS);
            double inv = 1.0; for (int i = 0; i < d; ++i) inv *= r1;
            double turns = (double)pos * inv * 0.15915494309189535; turns -= floor(turns);
            const float a = (float)(turns * 6.283185307179586);
            rope[2 * e] = cosf(a); rope[2 * e + 1] = sinf(a);
        }
    }
    {
        bf16* XB = (bf16*)(ws + WS_XB); float* SSQ = (float*)(ws + WS_SSQ);
        const float* xp = P.xp(); const float* xs = P.xs();
        for (int m0 = 4 * gw; m0 < MT; m0 += 4 * NGW) {
            f32x4 v[4][4];
#pragma unroll
            for (int r = 0; r < 4; ++r) { const int m = m0 + r; const float* xrow = (m < MP) ? xp + (size_t)m * DM : xs + (size_t)(m - MP) * DM;
#pragma unroll
                for (int j = 0; j < 4; ++j) v[r][j] = __builtin_nontemporal_load((const GAS f32x4*)xrow + 64 * j + F.lane); }
#pragma unroll
            for (int r = 0; r < 4; ++r) { const int m = m0 + r; float sq = 0.f;
#pragma unroll
                for (int j = 0; j < 4; ++j) sq += (v[r][j][0] * v[r][j][0] + v[r][j][1] * v[r][j][1]) + (v[r][j][2] * v[r][j][2] + v[r][j][3] * v[r][j][3]);
                sq = wave_sum(sq, F.lane);
                GAS unsigned long long* o8 = (GAS unsigned long long*)(XB + (size_t)m * DM) + F.lane;
#pragma unroll
                for (int j = 0; j < 4; ++j) o8[64 * j] = (unsigned long long)pk2(v[r][j][0], v[r][j][1]) | ((unsigned long long)pk2(v[r][j][2], v[r][j][3]) << 32);
                if (F.lane < 4) SSQ[(size_t)m * 4 + F.lane] = (F.lane == 0) ? sq : 0.f; }
        }
    }
}

namespace poolf {
constexpr int A_OFF = 0, APITCH = 528  , RS_OFF = 128 * APITCH, SCR_OFF = RS_OFF + 1024;
__device__ __forceinline__ f32x2 bf2_to_f32(unsigned w) { return (f32x2){__builtin_bit_cast(float, w << 16), __builtin_bit_cast(float, w & 0xffff0000u)}; }
__device__ __forceinline__ void put_p(LAS unsigned char* A, int lr, int kc, f32x2 p) { *(LAS unsigned*)(A + lr * APITCH + kc * 2) = pk2(p[0], p[1]); }
template <int WG>
__device__ __forceinline__ void fill_p(const bf16* X, int r0, bool sample, const float* spool, const LAS float* rs, f32x2 g, int c0, int kc, int rq, LAS unsigned char* A, float* outp) {
    f32x2 h[16];
    if (!sample) {
        const int lr0 = rq * 32, t0 = (r0 + lr0) & (TPS - 1), b = (r0 + lr0) >> 11;
#pragma unroll
        for (int k = 0; k < 16; ++k) h[k] = (f32x2){0.f, 0.f};
        if (t0 > 0) {
            unsigned xh[16];
#pragma unroll
            for (int k = 1; k < 16; ++k) xh[k] = *(const unsigned*)(X + (size_t)(r0 + lr0 - 16 + k) * DM + c0);
#pragma unroll
            for (int k = 1; k < 16; ++k) h[k] = bf2_to_f32(xh[k]) * rs[lr0 - 1 + k] * g;
        }
        unsigned xw[2][16];
#pragma unroll
        for (int blk = 0; blk < 2; ++blk)
#pragma unroll
            for (int k = 0; k < 16; ++k) xw[blk][k] = *(const unsigned*)(X + (size_t)(r0 + lr0 + blk * 16 + k) * DM + c0);
#pragma unroll
        for (int blk = 0; blk < 2; ++blk) {
#pragma unroll
            for (int k = 0; k < 16; ++k) {
                const int lr = lr0 + blk * 16 + k, tpos = t0 + blk * 16 + k;
                const f32x2 u = bf2_to_f32(xw[blk][k]) * rs[lr + 15] * g;
                h[k] = u;
                f32x2 sm = u;
#pragma unroll
                for (int j = 1; j < WG; ++j) sm += h[(k - j) & 15];
                const int cnt = (tpos + 1 < WG) ? tpos + 1 : WG;
                put_p(A, lr, kc, sm * (1.0f / (float)cnt) - u);
                if (tpos >= TPS - 15) *(f32x2*)(outp + O_POOLP + ((size_t)b * 15 + (tpos - (TPS - 15))) * DM + c0) = u;
            }
        }
    } else {
        unsigned xw[8];
#pragma unroll
        for (int i = 0; i < 8; ++i) xw[i] = *(const unsigned*)(X + (size_t)(r0 + rq * 8 + i) * DM + c0);
        const int seq = ((r0 - MP) >> 3) + rq;
        const float* sp = spool + (size_t)seq * 15 * DM + c0; float* np = outp + O_POOLS + (size_t)seq * 15 * DM + c0;
        h[0] = (f32x2){0.f, 0.f};
#pragma unroll
        for (int k = 1; k < 16; ++k) h[k] = *(const f32x2*)(sp + (size_t)(k - 1) * DM);
#pragma unroll
        for (int k = 9; k < 16; ++k) *(f32x2*)(np + (size_t)(k - 9) * DM) = h[k];
#pragma unroll
        for (int i = 0; i < 8; ++i) {
            const int lr = rq * 8 + i;
            const f32x2 u = bf2_to_f32(xw[i]) * rs[lr + 15] * g;
            h[i] = u;
            f32x2 sm = u;
#pragma unroll
            for (int j = 1; j < WG; ++j) sm += h[(i - j) & 15];
            put_p(A, lr, kc, sm * (1.0f / (float)WG) - u);
            *(f32x2*)(np + (size_t)(7 + i) * DM) = u;
        }
    }
}
template <int MF>
__device__ __forceinline__ void unit(const Frame& F, const Ptrs& P, int r0, int gi, int pmode) {
    constexpr bool sample = (MF == 1); constexpr int ROWS = 32 * MF;
    unsigned char* ws = P.ws();
    const bf16* Xin = (const bf16*)(ws + WS_XB); bf16* Xout = (bf16*)(ws + WS_XB2);
    const float* SSQin = (const float*)(ws + WS_SSQ); float* SSQout = (float*)(ws + WS_SSQ2);
    const bf16* Wp = (const bf16*)(ws + WS_WPOOL);
    LAS unsigned char* A = F.lds + RING_OFF + A_OFF; LAS float* rs = (LAS float*)(F.lds + RING_OFF + RS_OFF); LAS float* scr = (LAS float*)(F.lds + RING_OFF + SCR_OFF);
    const int lane = F.lane, wid = F.wave, l15 = lane & 15, kg = lane >> 4;
    constexpr int MR = 2 * MF;
    const bf16* Bw = Wp + (size_t)(gi * 256 + wid * 32 + 8 * (l15 >> 2) + (l15 & 3)) * 256 + 8 * kg;
    bf16x8 bfa[4][2], bfb[4][2];
    __syncthreads();
    if (F.tid < 15 + ROWS) { const int row = r0 - 15 + F.tid; rs[F.tid] = (row >= 0 && (F.tid >= 15 || !sample)) ? pg8::row_rstd(SSQin, row) : 0.f; }
    __syncthreads();
    if (pmode != 2) {
        const int cp = F.tid & 127, rq = F.tid >> 7, kc = 2 * cp, c0 = gi * 256 + kc;
        const f32x2 g = *(const f32x2*)(P.nmix() + c0);
        if (gi == 0) fill_p<2>(Xin, r0, sample, P.spool(), rs, g, c0, kc, rq, A, P.out());
        else if (gi == 1) fill_p<4>(Xin, r0, sample, P.spool(), rs, g, c0, kc, rq, A, P.out());
        else if (gi == 2) fill_p<8>(Xin, r0, sample, P.spool(), rs, g, c0, kc, rq, A, P.out());
        else fill_p<16>(Xin, r0, sample, P.spool(), rs, g, c0, kc, rq, A, P.out());
    }
    if (pmode == 1) return;
#pragma unroll
    for (int ks = 0; ks < 4; ++ks)
#pragma unroll
        for (int n = 0; n < 2; ++n) { bfa[ks][n] = *(const bf16x8*)(Bw + (size_t)(4 * n) * 256 + ks * 32); bfb[ks][n] = *(const bf16x8*)(Bw + (size_t)(4 * n) * 256 + (4 + ks) * 32); }
    v4u xo[MR];
#pragma unroll
    for (int m = 0; m < MR; ++m) xo[m] = *(const v4u*)(Xin + (size_t)(r0 + m * 16 + l15) * DM + gi * 256 + wid * 32 + 8 * kg);
    __syncthreads();
    f32x4 acc[MR][2];
#pragma unroll
    for (int m = 0; m < MR; ++m)
#pragma unroll
        for (int n = 0; n < 2; ++n) acc[m][n] = (f32x4){0.f, 0.f, 0.f, 0.f};
#pragma unroll
    for (int ks = 0; ks < 8; ++ks) {
        bf16x8 af[MR];
#pragma unroll
        for (int m = 0; m < MR; ++m) af[m] = *(const LAS bf16x8*)(A + (m * 16 + l15) * APITCH + (4 * ks + kg) * 16);
#pragma unroll
        for (int m = 0; m < MR; ++m)
#pragma unroll
            for (int n = 0; n < 2; ++n) acc[m][n] = __builtin_amdgcn_mfma_f32_16x16x32_bf16(ks < 4 ? bfa[ks & 3][n] : bfb[ks & 3][n], af[m], acc[m][n], 0, 0, 0);
    }
#pragma unroll
    for (int m = 0; m < MR; ++m) {
        const int rl = m * 16 + l15; const size_t off = (size_t)(r0 + rl) * DM + gi * 256 + wid * 32 + 8 * kg;
        const f32x4 v0 = pg8::bf4_to_f32((v2u){xo[m].x, xo[m].y}) + acc[m][0], v1 = pg8::bf4_to_f32((v2u){xo[m].z, xo[m].w}) + acc[m][1];
        if (pmode != 2) *(v4u*)(Xout + off) = (v4u){pg8::cvt_pk_bf16(v0[0], v0[1]), pg8::cvt_pk_bf16(v0[2], v0[3]), pg8::cvt_pk_bf16(v1[0], v1[1]), pg8::cvt_pk_bf16(v1[2], v1[3])};
        float sm = ((v0[0] * v0[0] + v0[1] * v0[1]) + (v0[2] * v0[2] + v0[3] * v0[3])) + ((v1[0] * v1[0] + v1[1] * v1[1]) + (v1[2] * v1[2] + v1[3] * v1[3]));
        sm += pg8::xor_shfl(sm, lane, 16); sm += pg8::xor_shfl(sm, lane, 32);
        if (kg == 0) scr[rl * 8 + wid] = sm;
    }
    __syncthreads();
    if (F.tid < ROWS) { const f32x4 p = *(const LAS f32x4*)(scr + F.tid * 8), q = *(const LAS f32x4*)(scr + F.tid * 8 + 4); const float t = ((p[0] + p[1]) + (p[2] + p[3])) + ((q[0] + q[1]) + (q[2] + q[3]));
        if (pmode != 2) SSQout[(size_t)(r0 + F.tid) * 4 + gi] = t; else if (t == 1.2345e33f) SSQout[0] = t; }
}
__device__ __forceinline__ void phase(const Frame& F, const Ptrs& P, int pmode) {
    constexpr int NPU = (MP / 128) * 4, NSU = (MS / 32) * 4;
    for (int u = F.vcu; u < NPU; u += F.G) unit<4>(F, P, (u >> 2) * 128, u & 3, pmode);
    { const Frame F2 = phase_frame(F, F.wave); for (int u = F2.vcu; u < NSU; u += F2.G) unit<1>(F2, P, MP + (u >> 2) * 32, u & 3, pmode); }
}
}


namespace att {
constexpr int BUF_BYTES = 6 * 8192, LDS_V = 3 * 8192, LDS_WS = 2 * BUF_BYTES, LDS_OST = LDS_WS + NWAVES * 256, LDS_TOTAL = LDS_OST + NWAVES * 4096;
__device__ __forceinline__ int crow(int r, int hi) { return (r & 3) + 8 * (r >> 2) + 4 * hi; }
__device__ __forceinline__ unsigned cvtpk_s(float lo, float hi) { typedef float f2 __attribute__((ext_vector_type(2))); typedef __bf16 b2 __attribute__((ext_vector_type(2))); f2 v = {lo, hi}; b2 b = __builtin_convertvector(v, b2); return __builtin_bit_cast(unsigned, b); }
typedef short v4i16_t __attribute__((ext_vector_type(4)));
__device__ __forceinline__ s16x4 vtr(const LAS unsigned char* p) { return __builtin_bit_cast(s16x4, __builtin_amdgcn_ds_read_tr16_b64_v4i16((LAS v4i16_t*)p)); }
constexpr float NEG = -1.0e30f;

struct Soft { v4u pa[5][2]; float l; };
__device__ __forceinline__ void softmax5(f32x16 (&sc)[5], float sk, Soft& R) {
    float m = sk;
#pragma unroll
    for (int i = 0; i < 5; ++i)
#pragma unroll
        for (int r = 0; r < 16; ++r) m = fmaxf(m, sc[i][r]);
    { auto rr = __builtin_amdgcn_permlane32_swap(__float_as_uint(m), __float_as_uint(m), false, false); m = fmaxf(__uint_as_float(rr[0]), __uint_as_float(rr[1])); }
    float l = 0.f;
#pragma unroll
    for (int i = 0; i < 5; ++i) {
#pragma unroll
        for (int r = 0; r < 16; ++r) { const float p = __builtin_amdgcn_exp2f(sc[i][r] - m); sc[i][r] = p; l += p; }
#pragma unroll
        for (int s = 0; s < 2; ++s) R.pa[i][s] = (v4u){cvtpk_s(sc[i][8 * s + 0], sc[i][8 * s + 1]), cvtpk_s(sc[i][8 * s + 2], sc[i][8 * s + 3]), cvtpk_s(sc[i][8 * s + 4], sc[i][8 * s + 5]), cvtpk_s(sc[i][8 * s + 6], sc[i][8 * s + 7])};
    }
    { auto rr = __builtin_amdgcn_permlane32_swap(__float_as_uint(l), __float_as_uint(l), false, false); l = __uint_as_float(rr[0]) + __uint_as_float(rr[1]); }
    R.l = l + __builtin_amdgcn_exp2f(sk - m);
}
__device__ __forceinline__ f32x16 qk_block(const LAS unsigned char* kt, int p, const bf16x8 (&qr)[4], int r32, int hi) {
    const LAS unsigned char* kp = kt + p * 512 + hi * 1024 + r32 * 16;
    f32x16 a = {};
#pragma unroll
    for (int d0 = 0; d0 < 4; ++d0) a = __builtin_amdgcn_mfma_f32_32x32x16_bf16(*(const LAS bf16x8*)(kp + d0 * 2048), qr[d0], a, 0, 0, 0);
    return a;
}
__device__ __forceinline__ void pv_step(f32x16 (&o)[2], const LAS unsigned char* vt, int ks, const v4u pa, int lane, int hi) {
    const LAS unsigned char* vp = vt + ((lane >> 4) & 1) * 32 + (lane & 3) * 8 + (4 * hi + ((lane & 15) >> 2)) * 64 + ks * 1024;
#pragma unroll
    for (int d0 = 0; d0 < 2; ++d0) {
        const s16x4 lo = vtr(vp + d0 * 4096), hh = vtr(vp + d0 * 4096 + 512);
        const bf16x8 vf = (bf16x8){lo[0], lo[1], lo[2], lo[3], hh[0], hh[1], hh[2], hh[3]};
        o[d0] = __builtin_amdgcn_mfma_f32_32x32x16_bf16(__builtin_bit_cast(bf16x8, pa), vf, o[d0], 0, 0, 0);
    }
}

struct KVRegs { v4u k[3], v[3]; };
__device__ __forceinline__ void prompt_load(KVRegs& R, int u, const bf16* K, const bf16* V, int lane, int wid) {
    const int b = u >> 7, kvh = (u >> 5) & 3, qb = u & 31, q0 = qb * 64, jmin = (qb >= 2) ? 0 : 2 - qb;
#pragma unroll
    for (int j = 0; j < 3; ++j) if (j >= jmin) {
        const long kr0 = (long)b * TPS + q0 - 128 + 64 * j;
        R.k[j] = *(const v4u*)(K + (kr0 + lane) * KVD + kvh * 64 + wid * 8);
        R.v[j] = *(const v4u*)(V + (kr0 + 16 * (wid & 3) + (lane >> 2)) * KVD + kvh * 64 + (wid >> 2) * 32 + (lane & 3) * 8);
    }
}
__device__ __forceinline__ void prompt_store(const KVRegs& R, int u, LAS unsigned char* buf, int lane, int wid) {
    const int qb = u & 31, jmin = (qb >= 2) ? 0 : 2 - qb;
#pragma unroll
    for (int j = 0; j < 3; ++j) if (j >= jmin) {
        *(LAS v4u*)(buf + j * 8192 + wid * 1024 + lane * 16) = R.k[j];
        *(LAS v4u*)(buf + LDS_V + j * 8192 + wid * 1024 + lane * 16) = R.v[j];
    }
}
__device__ __forceinline__ void prompt_compute(const Frame& F, int u, const LAS unsigned char* buf, const bf16* Q, bf16* O, const float* sinks) {
    const int lane = F.lane, wid = F.wave, r32 = lane & 31, hi = lane >> 5;
    const int b = u >> 7, kvh = (u >> 5) & 3, qb = u & 31, q0 = qb * 64, jmin = (qb >= 2) ? 0 : 2 - qb;
    const long rowbase = (long)b * TPS;
    const int g = wid >> 1, half = wid & 1, h = 4 * kvh + g;
    const bf16* Qw = Q + (rowbase + q0 + 32 * half) * DM + h * HD;
    bf16x8 qr[4];
#pragma unroll
    for (int d0 = 0; d0 < 4; ++d0) qr[d0] = *(const bf16x8*)(Qw + (long)r32 * DM + d0 * 16 + hi * 8);
    const float sk = sinks[h] * LOG2E;
    f32x16 sc[5];
#pragma unroll
    for (int i = 0; i < 5; ++i) {
        const int kb = half + i, tile = kb >> 1, p = kb & 1;
        if (tile >= jmin) sc[i] = qk_block(buf + tile * 8192, p, qr, r32, hi);
        else {
#pragma unroll
            for (int r = 0; r < 16; ++r) sc[i][r] = NEG;
        }
    }
#pragma unroll
    for (int r = 0; r < 16; ++r) { const int kk = crow(r, hi); if (!(kk > r32)) sc[0][r] = NEG; if (!(kk <= r32)) sc[4][r] = NEG; }
    Soft S; softmax5(sc, sk, S);
    f32x16 o[2]; o[0] = f32x16{}; o[1] = f32x16{};
#pragma unroll
    for (int i = 0; i < 5; ++i) {
        const int kb = half + i, tile = kb >> 1, p = kb & 1;
        if (tile >= jmin) {
#pragma unroll
            for (int s = 0; s < 2; ++s) pv_step(o, buf + LDS_V + tile * 8192, 2 * p + s, S.pa[i][s], lane, hi);
        }
    }
    LAS unsigned char* lds = F.lds + RING_OFF;
    LAS float* wsf = (LAS float*)(lds + LDS_WS) + wid * 64;
    if (hi == 0) wsf[r32] = S.l;
    LDS_WAIT();
    LAS bf16* stg = (LAS bf16*)(lds + LDS_OST) + wid * 2048;
#pragma unroll
    for (int r = 0; r < 16; ++r) { const int orow = crow(r, hi); const float rl = __builtin_amdgcn_rcpf(wsf[orow]);
#pragma unroll
        for (int d0 = 0; d0 < 2; ++d0) stg[orow * 64 + d0 * 32 + r32] = (bf16)f2bf(o[d0][r] * rl); }
    LDS_WAIT();
    bf16* Ow = O + (rowbase + q0 + 32 * half) * DM + h * HD;
#pragma unroll
    for (int i = 0; i < 4; ++i) { const int row = i * 8 + (lane >> 3), ch = lane & 7; const v4u v = *(const LAS v4u*)(stg + row * 64 + ch * 8); *(v4u*)(Ow + (long)row * DM + ch * 8) = v; }
    LDS_WAIT();
}

__device__ __forceinline__ void sample_pair(const Frame& F, int b, int hp, const bf16* Q, const bf16* Kn, const bf16* Vn, const float* ck, const float* cv, float* out, bf16* O, const float* sinks) {
    const int lane = F.lane, wid = F.wave, s = wid >> 2, tg = F.tid & 255, kvh = 2 * hp + s;
    LAS unsigned char* lds = F.lds + RING_OFF;
    LAS unsigned char* buf = lds + s * BUF_BYTES;
    __syncthreads();
    {
        const int q = tg & 15;
        f32x4 kx[8], vx[8];
#pragma unroll
        for (int it = 0; it < 8; ++it) { const int key = it * 16 + (tg >> 4); const size_t off = ((size_t)(b * 128 + key) * NKV + kvh) * HD + 4 * q;
            kx[it] = __builtin_nontemporal_load((const f32x4*)(ck + off)); vx[it] = __builtin_nontemporal_load((const f32x4*)(cv + off)); }
#pragma unroll
        for (int it = 0; it < 8; ++it) { const int key = it * 16 + (tg >> 4), tile = key >> 6, kk = key & 63;
            if (key >= 8) { const size_t oo = ((size_t)(b * 128 + key - 8) * NKV + kvh) * HD + 4 * q; __builtin_nontemporal_store(kx[it], (f32x4*)(out + O_KS + oo)); __builtin_nontemporal_store(vx[it], (f32x4*)(out + O_VS + oo)); }
            *(LAS v2u*)(buf + tile * 8192 + (q >> 1) * 1024 + kk * 16 + (q & 1) * 8) = (v2u){cvtpk_s(kx[it][0], kx[it][1]), cvtpk_s(kx[it][2], kx[it][3])};
            *(LAS v2u*)(buf + LDS_V + tile * 8192 + (q >> 3) * 4096 + (kk >> 4) * 1024 + (kk & 15) * 64 + ((4 * q) & 31) * 2) = (v2u){cvtpk_s(vx[it][0], vx[it][1]), cvtpk_s(vx[it][2], vx[it][3])}; }
        const int i8 = tg >> 4;
        v2u kn = (v2u){0u, 0u}, vn = (v2u){0u, 0u};
        if (i8 < 8) { const size_t off = ((size_t)MP + b * TSS + i8) * KVD + kvh * HD + 4 * q; kn = *(const v2u*)(Kn + off); vn = *(const v2u*)(Vn + off); }
        *(LAS v2u*)(buf + 2 * 8192 + (q >> 1) * 1024 + i8 * 16 + (q & 1) * 8) = kn;
        *(LAS v2u*)(buf + LDS_V + 2 * 8192 + (q >> 3) * 4096 + i8 * 64 + ((4 * q) & 31) * 2) = vn;
    }
    __syncthreads();
    if ((wid & 3) == 0) {
        const int r32 = lane & 31, hi = lane >> 5, qi = r32 & 7, h = 4 * kvh + (r32 >> 3);
        const long qrow = (long)MP + b * TSS + qi;
        bf16x8 qr[4];
#pragma unroll
        for (int d0 = 0; d0 < 4; ++d0) qr[d0] = *(const bf16x8*)(Q + qrow * DM + h * HD + d0 * 16 + hi * 8);
        const float sk = sinks[h] * LOG2E;
        f32x16 sc[5];
#pragma unroll
        for (int blk = 0; blk < 5; ++blk) sc[blk] = qk_block(buf + (blk >> 1) * 8192, blk & 1, qr, r32, hi);
#pragma unroll
        for (int blk = 0; blk < 5; ++blk)
#pragma unroll
            for (int r = 0; r < 16; ++r) { const int j = 32 * blk + crow(r, hi); if (!(j >= qi + 1 && j <= 128 + qi)) sc[blk][r] = NEG; }
        Soft S; softmax5(sc, sk, S);
        f32x16 o[2]; o[0] = f32x16{}; o[1] = f32x16{};
#pragma unroll
        for (int blk = 0; blk < 4; ++blk)
#pragma unroll
            for (int st = 0; st < 2; ++st) pv_step(o, buf + LDS_V + (blk >> 1) * 8192, 2 * (blk & 1) + st, S.pa[blk][st], lane, hi);
        pv_step(o, buf + LDS_V + 2 * 8192, 0, S.pa[4][0], lane, hi);
        LAS float* wsf = (LAS float*)(lds + LDS_WS) + wid * 64;
        if (hi == 0) wsf[r32] = S.l;
        LDS_WAIT();
#pragma unroll
        for (int r = 0; r < 16; ++r) { const int qq = crow(r, hi); const float rl = __builtin_amdgcn_rcpf(wsf[qq]);
            bf16* orow = O + ((long)MP + b * TSS + (qq & 7)) * DM + (4 * kvh + (qq >> 3)) * HD + r32;
#pragma unroll
            for (int d0 = 0; d0 < 2; ++d0) orow[d0 * 32] = (bf16)f2bf(o[d0][r] * rl); }
        LDS_WAIT();
    }
}

__device__ __forceinline__ void attn_phase(const Frame& F, const Ptrs& P) {
    const bf16* Q = (const bf16*)(P.ws() + WS_Q); const bf16* K = (const bf16*)(P.ws() + WS_K); const bf16* V = (const bf16*)(P.ws() + WS_V); bf16* O = (bf16*)(P.ws() + WS_O);
    LAS unsigned char* lds = F.lds + RING_OFF;
    constexpr int NPU = NPB * NKV * 32;
    const int per = (NPU + F.G - 1) / F.G, u0 = F.vcu * per, u1 = (u0 + per < NPU) ? u0 + per : NPU;
    if (u0 < u1) {
        KVRegs R;
        prompt_load(R, u0, K, V, F.lane, F.wave);
        __syncthreads();
        prompt_store(R, u0, lds, F.lane, F.wave);
        for (int u = u0; u < u1; ++u) {
            const int cur = (u - u0) & 1;
            if (u + 1 < u1) prompt_load(R, u + 1, K, V, F.lane, F.wave);
            __syncthreads();
            prompt_compute(F, u, lds + cur * BUF_BYTES, Q, O, P.sinks());
            if (u + 1 < u1) prompt_store(R, u + 1, lds + (cur ^ 1) * BUF_BYTES, F.lane, F.wave);
        }
    }
    for (int pu = F.vcu; pu < NSB * 2; pu += F.G) sample_pair(F, pu >> 1, pu & 1, Q, K, V, P.ck(), P.cv(), P.out(), O, P.sinks());
}
}

__device__ __forceinline__ void final_phase(const Frame& F, const Ptrs& P) {
    float* Y = P.out() + O_Y; const bf16* XB = (const bf16*)(P.ws() + WS_XB2); const float* SSQ = (const float*)(P.ws() + WS_SSQ2);
    const int gw = F.vcu * NWAVES + F.wave, NGW = F.G * NWAVES;
    f32x4 gv[4];
#pragma unroll
    for (int j = 0; j < 4; ++j) gv[j] = ((const f32x4*)P.nfin())[64 * j + F.lane];
    for (int m0 = 4 * gw; m0 < MT; m0 += 4 * NGW) {
        v2u w[4][4]; float rs[4];
#pragma unroll
        for (int r = 0; r < 4; ++r) { rs[r] = pg8::row_rstd(SSQ, m0 + r);
#pragma unroll
            for (int j = 0; j < 4; ++j) w[r][j] = __builtin_nontemporal_load((const v2u*)(XB + (size_t)(m0 + r) * DM) + 64 * j + F.lane); }
#pragma unroll
        for (int r = 0; r < 4; ++r)
#pragma unroll
            for (int j = 0; j < 4; ++j) __builtin_nontemporal_store(pg8::bf4_to_f32(w[r][j]) * rs[r] * gv[j], (f32x4*)(Y + (size_t)(m0 + r) * DM) + 64 * j + F.lane);
    }
}

constexpr int NPHASES = 14;
__global__ void __launch_bounds__(NWAVES * 64, 2) mk_fwd(Args args) {
    extern __shared__ __attribute__((aligned(16))) unsigned char lds_raw[];
    {
        LAS unsigned char* l0 = (LAS unsigned char*)lds_raw;
        for (int u = threadIdx.x; u < (LDS_BYTES - LDSCTL_OFF) / 4; u += NWAVES * 64) ((LAS unsigned*)(l0 + LDSCTL_OFF))[u] = 0u;
        __syncthreads();
    }
    const int lo = args.ph_lo, hi = args.ph_hi;
    const int wave0 = __builtin_amdgcn_readfirstlane(threadIdx.x >> 6);
    if (hi - lo > 1) (void)xcd_barrier_post((unsigned*)(args.ws + WS_CTL) + CW_BAR, (volatile LAS unsigned*)((LAS unsigned char*)lds_raw + MISC_OFF) + 8);
    for (int it = 2 * lo; it < 2 * hi; ++it) {
        const int ph = it >> 1; const bool dup = (it & 1) != 0;
        if (dup && !((DUP_MASK >> ph) & 1)) continue;
        int bx = blockIdx.x, G = gridDim.x; asm volatile("" : "+s"(bx), "+s"(G));
        ArgsP ap = (ArgsP)__builtin_amdgcn_kernarg_segment_ptr(); asm volatile("" : "+s"(ap));
        Frame F;
        F.lds = (LAS unsigned char*)lds_raw;
        F.tid = 0; F.lane = 0; F.wave = 0;
        F.G = G; F.vcu = (G % 8 == 0) ? (bx % 8) * (G / 8) + bx / 8 : bx;
        Ptrs P; P.ap = ap;
        unsigned char* ws = P.ws();
        bf16* XB = (bf16*)(ws + ((ph > 3) ? WS_XB2 : WS_XB)); bf16* Hb = (bf16*)(ws + WS_H); float* SSQ = (float*)(ws + ((ph > 3) ? WS_SSQ2 : WS_SSQ));
        const int kind = (int)((0x92187621214210ull >> (4 * ph)) & 15ull);
        const int f = (ph < 3) ? 0 : (ph < 6) ? 1 : (ph < 8) ? 2 : 3;
        if (kind == 0 && (PHMASK & 1)) {
            p0_prologue(phase_frame(F, wave0), P);
        } else if (kind == 1 && (PHMASK & 2)) {
            pg8::Gemm g{XB, (const bf16*)(ws + WS_W1 + f * W1_BYTES), MT, 2 * DFF, DM, DM, DM, 0, nullptr};
            pg8::StaticOrder S; S.init(MT, 2 * DFF, F.G, bx);
            pg8::EpiSwiglu E{(dup && PROBE_NULL_EPI == 1) ? nullptr : Hb, SSQ, dup && PROBE_NULL_EPI == 2};
            pg8::gemm_phase<pg8::EpiSwiglu, pg8::StaticOrder, true, true>(F.lds + RING_OFF, g, S, E, fresh_tid(wave0));
            if (!dup && f < 3 && bx >= 216) {
                const Frame Fc = phase_frame(F, wave0);
                const int gwc = (bx - 216) * NWAVES + Fc.wave, ngwc = (F.G - 216) * NWAVES;
                __syncthreads();
                convert_items(Fc, P, f * I_FFN + I_W1, (f + 1) * I_FFN, gwc, ngwc);
                if (f < 2) convert_items(Fc, P, (f + 1) * I_FFN, (f + 1) * I_FFN + I_W1 / 4, gwc, ngwc);
                else convert_items(Fc, P, IT_QKV, IT_POOL, gwc, ngwc);
            }
        } else if ((kind == 2 || kind == 8) && (PHMASK & 4)) {
            pg8::EpiRes E;
            E.xb = (dup && PROBE_NULL_EPI) ? nullptr : XB; E.ssq = SSQ; E.bias = nullptr; E.accs = dup ? 0.f : 1.f;
            pg8::StaticOrder S; S.init(MP, DM, F.G, bx);
            if (kind == 8) {
                const bf16* O = (const bf16*)(ws + WS_O);
                const pg8::Gemm g{O, (const bf16*)(ws + WS_WO), MP, DM, DM, DM, DM, 0, O + (size_t)MP * DM}; E.bias = dup ? nullptr : P.bo();
                pg8::gemm_phase<pg8::EpiRes, pg8::StaticOrder, true, true>(F.lds + RING_OFF, g, S, E, fresh_tid(wave0));
            } else {
                const pg8::Gemm g{Hb, (const bf16*)(ws + WS_W2 + f * W2_BYTES), MP, DM, DFF, DFF, DFF, 0, Hb + (size_t)MP * DFF};
                pg8::gemm_phase<pg8::EpiRes, pg8::StaticOrder, true, true>(F.lds + RING_OFF, g, S, E, fresh_tid(wave0));
            }
            if (!dup && kind == 2 && f < 2) {
                const Frame Fc = phase_frame(F, wave0);
                __syncthreads();
                convert_items(Fc, P, (f + 1) * I_FFN + I_W1 / 4, (f + 1) * I_FFN + I_W1, Fc.vcu * NWAVES + Fc.wave, F.G * NWAVES);
            }
        } else if (kind == 4 && (PHMASK & 8)) {
            poolf::phase(phase_frame(F, wave0), P, dup ? PROBE_POOL : 0);
        } else if (kind == 6 && (PHMASK & 16)) {
            pg8::Gemm g{XB, (const bf16*)(ws + WS_WQKV), MT, QKVN, DM, DM, DM, 0, nullptr};
            pg8::StaticOrder S; S.init(MT, QKVN, F.G, bx);
            pg8::EpiQKV E{(bf16*)(ws + WS_Q), (bf16*)(ws + WS_K), (bf16*)(ws + WS_V), SSQ, P.bqkv(), (const float*)(ws + WS_ROPE), P.out()};
            pg8::gemm_phase<pg8::EpiQKV, pg8::StaticOrder, true, true>(F.lds + RING_OFF, g, S, E, fresh_tid(wave0));
            if (!dup && bx >= 152) {
                const Frame Fc = phase_frame(F, wave0);
                __syncthreads();
                convert_items(Fc, P, 3 * I_FFN, 4 * I_FFN, (bx - 152) * NWAVES + Fc.wave, (F.G - 152) * NWAVES);
            }
        } else if (kind == 7 && (PHMASK & 32)) {
            att::attn_phase(phase_frame(F, wave0), P);
        } else if (kind == 9 && (PHMASK & 64)) {
            final_phase(phase_frame(F, wave0), P);
        }
        {
            ArgsP aq = (ArgsP)__builtin_amdgcn_kernarg_segment_ptr(); asm volatile("" : "+s"(aq));
            const int hi2 = aq->ph_hi, lo2 = aq->ph_lo;
            if ((it + 1 < 2 * hi2 - 1 || (DUP_MASK >> (hi2 - 1)) & 1) && hi2 - lo2 > 1) {
                XcdBarrier b2; b2.bar = (unsigned*)(aq->ws + WS_CTL) + CW_BAR; b2.x = xb_xcc_id(); b2.st = (volatile LAS unsigned*)((LAS unsigned char*)lds_raw + MISC_OFF) + 8;
                xcd_barrier(b2);
            }
        }
    }
}

extern "C" void kernel_launch(void* const* d_in, const int* in_sizes, int n_in, void* d_out, int out_size, void* d_ws, size_t ws_size, hipStream_t stream) {
    static int grid = 0;
    if (grid == 0) {
        if (n_in != 20 || (size_t)out_size != O_END || ws_size < WS_END) { fprintf(stderr, "kernel_launch: unexpected shapes (n_in %d out %d ws %zu)\n", n_in, out_size, ws_size); grid = -1; return; }
        int dev = 0, cus = 0, per_cu = 0;
        if (hipGetDevice(&dev) != hipSuccess || hipDeviceGetAttribute(&cus, hipDeviceAttributeMultiprocessorCount, dev) != hipSuccess) { grid = -1; return; }
        if (hipFuncSetAttribute((const void*)mk_fwd, hipFuncAttributeMaxDynamicSharedMemorySize, LDS_BYTES) != hipSuccess) { fprintf(stderr, "kernel_launch: hipFuncSetAttribute failed\n"); grid = -1; return; }
        if (hipOccupancyMaxActiveBlocksPerMultiprocessor(&per_cu, (const void*)mk_fwd, NWAVES * 64, LDS_BYTES) != hipSuccess || per_cu < 1)
            fprintf(stderr, "kernel_launch: occupancy query reports %d workgroups per CU\n", per_cu);
        (void)hipGetLastError();
        grid = cus;
    }
    if (grid < 0) return;
    (void)hipMemsetAsync((char*)d_ws + WS_CTL, 0, CTL_ZERO_BYTES, stream);
    Args a{};
    for (int i = 0; i < 20; ++i) a.in[i] = (const float*)d_in[i];
    a.out = (float*)d_out; a.ws = (unsigned char*)d_ws;
#if MK_ONE_LAUNCH
    a.ph_lo = 0; a.ph_hi = NPHASES;
    hipLaunchKernelGGL(mk_fwd, dim3(grid), dim3(NWAVES * 64), LDS_BYTES, stream, a);
#else
    for (int ph = 0; ph < NPHASES; ++ph) { a.ph_lo = ph; a.ph_hi = ph + 1; hipLaunchKernelGGL(mk_fwd, dim3(grid), dim3(NWAVES * 64), LDS_BYTES, stream, a); }
#endif
}
```
